# Optimizing an MI355X kernel written in HIP

```python
import jax, jax.numpy as jnp
from jax import lax
import numpy as np

D_MODEL = 1024
BATCH = 8
SEQ = 4096
DEPTH = 2

D_MIX = D_MODEL
N_ATTN_HEADS = 8
HEAD_DIM = 64
D_ATTN = N_ATTN_HEADS * HEAD_DIM
D_LRU = D_MIX - D_ATTN
N_LRU_BLOCKS = 8
LRU_BLOCK = D_LRU // N_LRU_BLOCKS
CONV_WIDTH = 4
LRU_C = 8.0
DILATED_PATTERNS = ((128, 1), (512, 4), (2048, 16))
N_BUCKETS = 32
MAX_DISTANCE = 2048
D_IN = 3 * D_ATTN + 2 * D_LRU
D_FF_DENSE = 2816
N_EXPERTS = 8
TOP_K = 2
D_FF_EXPERT = 3584
N_DENSE = (DEPTH + 1) // 2
N_MOE = DEPTH // 2
DEEPNORM_ALPHA = (2.0 * DEPTH) ** 0.25
DEEPNORM_BETA = (8.0 * DEPTH) ** -0.25
LN_EPS = 1e-5
RMS_EPS = 1e-6
NEG_INF = -1e30

kernel_name = 'hybrid_rglru_dilated_attn_moe'

f32 = jnp.float32


def _t5_bucket(dist):
    max_exact = N_BUCKETS // 2
    d = np.maximum(dist, 1).astype(np.float32)
    large = max_exact + (np.log(d / max_exact) / np.log(MAX_DISTANCE / max_exact)
                         * (N_BUCKETS - max_exact)).astype(np.int32)
    large = np.minimum(large, N_BUCKETS - 1)
    return np.where(dist < max_exact, dist, large).astype(np.int32)


def _dilated_window_attention(q, k, v, rel_bias, window, dilation):
    B, S, H, Dh = q.shape
    nk = window // dilation
    L = S // dilation
    nb = -(-L // nk)
    Lp = nb * nk

    def by_residue(t):
        t = t.reshape(B, L, dilation, H, Dh).transpose(0, 2, 1, 3, 4)
        return jnp.pad(t, ((0, 0), (0, 0), (0, Lp - L), (0, 0), (0, 0)))

    def kv_windows(t):
        t = jnp.pad(by_residue(t), ((0, 0), (0, 0), (nk, 0), (0, 0), (0, 0)))
        t = t.reshape(B, dilation, nb + 1, nk, H, Dh)
        return jnp.concatenate([t[:, :, :-1], t[:, :, 1:]], axis=3)

    qb = by_residue(q).reshape(B, dilation, nb, nk, H, Dh)
    kw = kv_windows(k)
    vw = kv_windows(v)

    qi = np.arange(nk)[:, None]
    kj = np.arange(2 * nk)[None, :]
    delta = qi + nk - kj
    band = (delta >= 0) & (delta <= nk)
    nonneg = (np.arange(nb)[:, None, None] > 0) | (kj >= nk)[None]
    valid = jnp.asarray(band[None] & nonneg)
    bucket = _t5_bucket(np.clip(delta, 0, nk) * dilation)
    bias = jnp.transpose(rel_bias.astype(f32)[bucket], (2, 0, 1))

    s = jnp.einsum('brnqhc,brnkhc->brnhqk', qb.astype(f32), kw.astype(f32)) * (HEAD_DIM ** -0.5) + bias
    s = jnp.where(valid[:, None], s, NEG_INF)
    lse = jax.nn.logsumexp(s, axis=-1)
    p = jnp.exp(s - lse[..., None])
    o = jnp.einsum('brnhqk,brnkhc->brnqhc', p.astype(v.dtype), vw)

    def back(t):
        t = jnp.swapaxes(t[:, :, :L], 1, 2)
        return t.reshape((B, S) + t.shape[3:])

    o = back(o.reshape(B, dilation, Lp, H, Dh))
    lse = back(jnp.swapaxes(lse, 3, 4).reshape(B, dilation, Lp, H))
    return o, lse


def _mixture_of_dilations(q, k, v, rel_bias):
    outs, lses = [], []
    for window, dilation in DILATED_PATTERNS:
        o, l = _dilated_window_attention(q, k, v, rel_bias, window, dilation)
        outs.append(o.astype(f32))
        lses.append(l)
    w = jax.nn.softmax(jnp.stack(lses), axis=0)
    return jnp.einsum('pbsh,pbshc->bshc', w, jnp.stack(outs))


def _rglru_branch(u, gate, conv_w, conv_b, w_a, b_a, w_x, b_x, lru_lambda):
    B, S, C = u.shape
    u = lax.conv_general_dilated(u, conv_w, window_strides=(1,), padding=[(CONV_WIDTH - 1, 0)],
                                 dimension_numbers=('NWC', 'WIO', 'NWC'),
                                 feature_group_count=C) + conv_b
    ub = u.reshape(B, S, N_LRU_BLOCKS, LRU_BLOCK)
    r = jax.nn.sigmoid(jnp.einsum('bsgi,gij->bsgj', ub, w_a).reshape(B, S, C) + b_a).astype(f32)
    i = jax.nn.sigmoid(jnp.einsum('bsgi,gij->bsgj', ub, w_x).reshape(B, S, C) + b_x).astype(f32)
    log_a = -LRU_C * r * jax.nn.softplus(-lru_lambda.astype(f32))
    a = jnp.exp(log_a)
    beta = jnp.sqrt(-jnp.expm1(2.0 * log_a)) * (i * u.astype(f32))

    def combine(left, right):
        a_l, b_l = left
        a_r, b_r = right
        return a_l * a_r, a_r * b_l + b_r

    _, h = lax.associative_scan(combine, (a, beta), axis=1)
    return jax.nn.gelu(gate.astype(f32)) * h


def _rms_norm(t, g):
    t = t.astype(f32)
    return t * lax.rsqrt(jnp.mean(t * t, axis=-1, keepdims=True) + RMS_EPS) * g.astype(f32)


def _layer_norm(t, g, b):
    tf = t.astype(f32)
    mu = jnp.mean(tf, axis=-1, keepdims=True)
    var = jnp.mean(jnp.square(tf - mu), axis=-1, keepdims=True)
    y = (tf - mu) * lax.rsqrt(var + LN_EPS) * g.astype(f32) + b.astype(f32)
    return y.astype(t.dtype)


def _hybrid_mixer(x, w_in, conv_w, conv_b, w_a, b_a, w_x, b_x, lru_lambda, rel_bias,
                  g_attn, g_lru, w_out):
    B, S, _ = x.shape
    p = jnp.einsum('bsd,de->bse', x, w_in)
    q, k, v, u, gate = jnp.split(p, [D_ATTN, 2 * D_ATTN, 3 * D_ATTN, 3 * D_ATTN + D_LRU], axis=-1)
    heads = lambda t: t.reshape(B, S, N_ATTN_HEADS, HEAD_DIM)
    attn = _mixture_of_dilations(heads(q), heads(k), heads(v), rel_bias).reshape(B, S, D_ATTN)
    lru = _rglru_branch(u, gate, conv_w, conv_b, w_a, b_a, w_x, b_x, lru_lambda)
    y = jnp.concatenate([_rms_norm(attn, g_attn), _rms_norm(lru, g_lru)], axis=-1).astype(x.dtype)
    return jnp.einsum('bsm,md->bsd', y, w_out)


def _swiglu(x, w_gate, w_up, w_down):
    h = jax.nn.silu(jnp.einsum('bsd,df->bsf', x, w_gate)) * jnp.einsum('bsd,df->bsf', x, w_up)
    return jnp.einsum('bsf,fd->bsd', h, w_down)


def _moe_swiglu(x, router_w, w_gate, w_up, w_down):
    logits = jnp.einsum('bsd,de->bse', x, router_w).astype(f32)
    top_val, top_idx = lax.top_k(logits, TOP_K)
    top_p = jax.nn.softmax(top_val, axis=-1)
    comb = jnp.sum(top_p[..., None] * jax.nn.one_hot(top_idx, N_EXPERTS, dtype=f32), axis=-2)
    y = jnp.zeros(x.shape, f32)
    for e in range(N_EXPERTS):
        y = y + comb[..., e:e + 1] * _swiglu(x, w_gate[e], w_up[e], w_down[e]).astype(f32)
    return y.astype(x.dtype)


def setup_inputs(seed: int = 0) -> dict:
    key = jax.random.key(seed)
    ks = jax.random.split(key, 24)
    nrm = lambda k, shape, scale: jax.random.normal(k, shape, f32) * scale
    a0 = jax.random.uniform(ks[9], (DEPTH, D_LRU), f32, minval=0.9, maxval=0.999)
    s0 = a0 ** (1.0 / LRU_C)
    return {
        'x': nrm(ks[0], (BATCH, SEQ, D_MODEL), 1.0),
        'w_in': nrm(ks[1], (DEPTH, D_MODEL, D_IN), D_MODEL ** -0.5),
        'conv_w': nrm(ks[2], (DEPTH, CONV_WIDTH, 1, D_LRU), CONV_WIDTH ** -0.5),
        'conv_b': nrm(ks[3], (DEPTH, D_LRU), 0.01),
        'w_a': nrm(ks[4], (DEPTH, N_LRU_BLOCKS, LRU_BLOCK, LRU_BLOCK), LRU_BLOCK ** -0.5),
        'b_a': nrm(ks[5], (DEPTH, D_LRU), 0.01),
        'w_x': nrm(ks[6], (DEPTH, N_LRU_BLOCKS, LRU_BLOCK, LRU_BLOCK), LRU_BLOCK ** -0.5),
        'b_x': nrm(ks[7], (DEPTH, D_LRU), 0.01),
        'lru_lambda': jnp.log(s0) - jnp.log1p(-s0),
        'rel_bias': nrm(ks[8], (N_BUCKETS, N_ATTN_HEADS), 0.5),
        'g_attn': 1.0 + nrm(ks[10], (DEPTH, D_ATTN), 0.02),
        'g_lru': 1.0 + nrm(ks[11], (DEPTH, D_LRU), 0.02),
        'w_out': nrm(ks[12], (DEPTH, D_MIX, D_MODEL), D_MIX ** -0.5 * DEEPNORM_BETA),
        'ln1_g': 1.0 + nrm(ks[13], (DEPTH, D_MODEL), 0.02),
        'ln1_b': nrm(ks[14], (DEPTH, D_MODEL), 0.01),
        'ln2_g': 1.0 + nrm(ks[15], (DEPTH, D_MODEL), 0.02),
        'ln2_b': nrm(ks[16], (DEPTH, D_MODEL), 0.01),
        'ffn_w_gate': nrm(ks[17], (N_DENSE, D_MODEL, D_FF_DENSE), D_MODEL ** -0.5),
        'ffn_w_up': nrm(ks[18], (N_DENSE, D_MODEL, D_FF_DENSE), D_MODEL ** -0.5),
        'ffn_w_down': nrm(ks[19], (N_DENSE, D_FF_DENSE, D_MODEL), D_FF_DENSE ** -0.5 * DEEPNORM_BETA),
        'router_w': nrm(ks[20], (N_MOE, D_MODEL, N_EXPERTS), D_MODEL ** -0.5),
        'moe_w_gate': nrm(ks[21], (N_MOE, N_EXPERTS, D_MODEL, D_FF_EXPERT), D_MODEL ** -0.5),
        'moe_w_up': nrm(ks[22], (N_MOE, N_EXPERTS, D_MODEL, D_FF_EXPERT), D_MODEL ** -0.5),
        'moe_w_down': nrm(ks[23], (N_MOE, N_EXPERTS, D_FF_EXPERT, D_MODEL), D_FF_EXPERT ** -0.5 * DEEPNORM_BETA),
    }


def reference(x, w_in, conv_w, conv_b, w_a, b_a, w_x, b_x, lru_lambda, rel_bias, g_attn, g_lru,
              w_out, ln1_g, ln1_b, ln2_g, ln2_b, ffn_w_gate, ffn_w_up, ffn_w_down, router_w,
              moe_w_gate, moe_w_up, moe_w_down):
    for layer in range(DEPTH):
        m = _hybrid_mixer(x, w_in[layer], conv_w[layer], conv_b[layer], w_a[layer], b_a[layer],
                          w_x[layer], b_x[layer], lru_lambda[layer], rel_bias,
                          g_attn[layer], g_lru[layer], w_out[layer])
        x = _layer_norm(DEEPNORM_ALPHA * x + m, ln1_g[layer], ln1_b[layer])
        if layer % 2 == 0:
            j = layer // 2
            f = _swiglu(x, ffn_w_gate[j], ffn_w_up[j], ffn_w_down[j])
        else:
            j = layer // 2
            f = _moe_swiglu(x, router_w[j], moe_w_gate[j], moe_w_up[j], moe_w_down[j])
        x = _layer_norm(DEEPNORM_ALPHA * x + f, ln2_g[layer], ln2_b[layer])
    return x
```

```cpp
#include <hip/hip_runtime.h>
#include <cstdio>
#include <cstdint>
#include <cmath>

namespace {
constexpr int NB_ = 8, S_ = 4096, M_ = NB_ * S_, D_ = 1024, DA_ = 512, DL_ = 512, H_ = 8;
constexpr int DFF_ = 2816, NE_ = 8, DFE_ = 3584;
constexpr int SORT_ROWS = 2 * M_ + NE_ * 256;
constexpr int NT_MAX = SORT_ROWS / 256;
constexpr float ALPHA = 1.4142135623730951f;
constexpr float LN_EPS = 1e-5f, RMS_EPS = 1e-6f;

__device__ __forceinline__ int t5_bucket(int dist) {
    if (dist < 16) return dist;
    int b = 16;
    b += dist >= 22; b += dist >= 30; b += dist >= 40; b += dist >= 54; b += dist >= 73; b += dist >= 99; b += dist >= 134; b += dist >= 182;
    b += dist >= 246; b += dist >= 332; b += dist >= 450; b += dist >= 609; b += dist >= 825; b += dist >= 1117; b += dist >= 1513;
    return b;
}
__device__ __forceinline__ float wave_sum(float v) {
#pragma unroll
    for (int o = 1; o < 64; o <<= 1) v += __shfl_xor(v, o);
    return v;
}

struct GemmArgs {
    const float* A; int lda; const int* arow;
    const float* B; const float* B2; int ldb;
    long long b_estride; const int* tile_expert;
    int M, N, K;
    float* C; int ldc; const float* R; int ldr; float alpha;
    int split_cols; long long split_stride;
};
template <int MODE>
__global__ __launch_bounds__(256) void gemm_f32(GemmArgs g) {
    __shared__ __attribute__((aligned(16))) float As[16][132];
    __shared__ __attribute__((aligned(16))) float Bs[16][128];
    __shared__ __attribute__((aligned(16))) float Bs2[MODE == 2 ? 16 : 1][128];
    const int tid = threadIdx.x, tx = tid & 15, ty = tid >> 4;
    const int m0 = blockIdx.y * 128, n0 = blockIdx.x * 128;
    const float* Bp = g.B; const float* B2p = g.B2;
    if (g.tile_expert) { const int e = g.tile_expert[m0 >> 8]; if (e < 0) return; Bp += (size_t)e * g.b_estride; if (MODE == 2) B2p += (size_t)e * g.b_estride; }
    float acc[8][8]; float acc2[MODE == 2 ? 8 : 1][8];
#pragma unroll
    for (int i = 0; i < 8; ++i)
#pragma unroll
        for (int j = 0; j < 8; ++j) { acc[i][j] = 0.f; if (MODE == 2) acc2[i][j] = 0.f; }
    const int ar = tid >> 1, ak = (tid & 1) * 8;
    int arow_idx = m0 + ar; if (g.arow) { arow_idx = g.arow[m0 + ar]; if (arow_idx < 0) arow_idx = 0; }
    const float* Aptr = g.A + (size_t)arow_idx * g.lda + ak;
    const int bk = tid >> 4, bn = (tid & 15) * 8;
    for (int k0 = 0; k0 < g.K; k0 += 16) {
        const float4 a0 = *(const float4*)(Aptr + k0), a1 = *(const float4*)(Aptr + k0 + 4);
        const float* bp = Bp + (size_t)(k0 + bk) * g.ldb + n0 + bn;
        const float4 b0 = *(const float4*)bp, b1 = *(const float4*)(bp + 4);
        float4 c0, c1;
        if (MODE == 2) { const float* bp2 = B2p + (size_t)(k0 + bk) * g.ldb + n0 + bn; c0 = *(const float4*)bp2; c1 = *(const float4*)(bp2 + 4); }
        __syncthreads();
        As[ak + 0][ar] = a0.x; As[ak + 1][ar] = a0.y; As[ak + 2][ar] = a0.z; As[ak + 3][ar] = a0.w;
        As[ak + 4][ar] = a1.x; As[ak + 5][ar] = a1.y; As[ak + 6][ar] = a1.z; As[ak + 7][ar] = a1.w;
        *(float4*)&Bs[bk][bn] = b0; *(float4*)&Bs[bk][bn + 4] = b1;
        if (MODE == 2) { *(float4*)&Bs2[bk][bn] = c0; *(float4*)&Bs2[bk][bn + 4] = c1; }
        __syncthreads();
#pragma unroll
        for (int k = 0; k < 16; ++k) {
            float a[8], b[8];
            const float4 x0 = *(const float4*)&As[k][ty * 8], x1 = *(const float4*)&As[k][ty * 8 + 4];
            a[0] = x0.x; a[1] = x0.y; a[2] = x0.z; a[3] = x0.w; a[4] = x1.x; a[5] = x1.y; a[6] = x1.z; a[7] = x1.w;
            const float4 y0 = *(const float4*)&Bs[k][tx * 8], y1 = *(const float4*)&Bs[k][tx * 8 + 4];
            b[0] = y0.x; b[1] = y0.y; b[2] = y0.z; b[3] = y0.w; b[4] = y1.x; b[5] = y1.y; b[6] = y1.z; b[7] = y1.w;
#pragma unroll
            for (int i = 0; i < 8; ++i)
#pragma unroll
                for (int j = 0; j < 8; ++j) acc[i][j] = fmaf(a[i], b[j], acc[i][j]);
            if (MODE == 2) {
                const float4 z0 = *(const float4*)&Bs2[k][tx * 8], z1 = *(const float4*)&Bs2[k][tx * 8 + 4];
                b[0] = z0.x; b[1] = z0.y; b[2] = z0.z; b[3] = z0.w; b[4] = z1.x; b[5] = z1.y; b[6] = z1.z; b[7] = z1.w;
#pragma unroll
                for (int i = 0; i < 8; ++i)
#pragma unroll
                    for (int j = 0; j < 8; ++j) acc2[i][j] = fmaf(a[i], b[j], acc2[i][j]);
            }
        }
    }
    float* Cb = g.C; int ncol0 = n0;
    if (g.split_cols) { const int t = n0 / g.split_cols; Cb += (size_t)t * g.split_stride; ncol0 = n0 - t * g.split_cols; }
#pragma unroll
    for (int i = 0; i < 8; ++i) {
        const int row = m0 + ty * 8 + i;
#pragma unroll
        for (int j = 0; j < 8; ++j) {
            const int col = tx * 8 + j;
            float v = acc[i][j];
            if (MODE == 1) v = g.alpha * g.R[(size_t)row * g.ldr + n0 + col] + v;
            if (MODE == 2) { const float gt = acc[i][j]; v = gt / (1.f + expf(-gt)) * acc2[i][j]; }
            Cb[(size_t)row * g.ldc + ncol0 + col] = v;
        }
    }
}

__global__ __launch_bounds__(256) void attn_naive(const float* Q, const float* K, const float* V, const float* rel_bias, float* O) {
    const int w = blockIdx.x * 4 + (threadIdx.x >> 6), lane = threadIdx.x & 63;
    const int m = w >> 3, h = w & 7, b = m >> 12, t = m & 4095;
    const float q = Q[(size_t)m * 512 + h * 64 + lane] * 0.125f;
    float mx = -INFINITY, l = 0.f, o = 0.f;
    for (int p = 0; p < 3; ++p) {
        const int dil = (p == 0) ? 1 : (p == 1) ? 4 : 16;
        for (int j = 0; j <= 128; ++j) {
            const int tk = t - j * dil; if (tk < 0) break;
            const size_t off = ((size_t)(b * 4096 + tk)) * 512 + h * 64 + lane;
            float s = wave_sum(q * K[off]) + rel_bias[t5_bucket(j * dil) * 8 + h];
            const float mn = fmaxf(mx, s);
            const float sc = expf(mx - mn), pe = expf(s - mn);
            l = l * sc + pe; o = o * sc + pe * V[off]; mx = mn;
        }
    }
    O[(size_t)m * 512 + h * 64 + lane] = o / l;
}

__global__ void lru_conv(const float* PU, const float* conv_w, const float* conv_b, float* UC) {
    const size_t i = (size_t)blockIdx.x * blockDim.x + threadIdx.x; if (i >= (size_t)M_ * DL_) return;
    const int c = (int)(i & 511), m = (int)(i >> 9), t = m & 4095;
    float u = conv_b[c];
#pragma unroll
    for (int w = 0; w < 4; ++w) { const int tt = t - 3 + w; if (tt >= 0) u += conv_w[w * 512 + c] * PU[(size_t)(m - 3 + w) * 512 + c]; }
    UC[i] = u;
}
__global__ void lru_gates(const float* UC, const float* w_a, const float* b_a, const float* w_x, const float* b_x, const float* lam, float* Aout, float* Bout) {
    const size_t i = (size_t)blockIdx.x * blockDim.x + threadIdx.x; if (i >= (size_t)M_ * DL_) return;
    const int c = (int)(i & 511), m = (int)(i >> 9), g = c >> 6, j = c & 63;
    float ra = b_a[c], ri = b_x[c];
    const float* u = UC + (size_t)m * 512 + g * 64;
    for (int k = 0; k < 64; ++k) { const float uv = u[k]; ra = fmaf(uv, w_a[(g * 64 + k) * 64 + j], ra); ri = fmaf(uv, w_x[(g * 64 + k) * 64 + j], ri); }
    const float r = 1.f / (1.f + expf(-ra)), ig = 1.f / (1.f + expf(-ri));
    const float sp = log1pf(expf(-lam[c]));
    const float log_a = -8.f * r * sp;
    Aout[i] = expf(log_a);
    Bout[i] = sqrtf(-expm1f(2.f * log_a)) * (ig * UC[i]);
}
__global__ void lru_scan(const float* Ain, const float* Bin, const float* G, float* out) {
    const int i = blockIdx.x * blockDim.x + threadIdx.x; if (i >= NB_ * DL_) return;
    const int b = i >> 9, c = i & 511;
    float h = 0.f;
    for (int t = 0; t < S_; ++t) {
        const size_t o = ((size_t)(b * S_ + t)) * 512 + c;
        h = Ain[o] * h + Bin[o];
        const float x = G[o];
        const float ge = 0.5f * x * (1.f + tanhf(0.7978845608028654f * (x + 0.044715f * x * x * x)));
        out[o] = ge * h;
    }
}
__global__ __launch_bounds__(256) void merge_norm(const float* attn, const float* lru, const float* g_attn, const float* g_lru, float* Y) {
    const int m = blockIdx.x * 4 + (threadIdx.x >> 6), lane = threadIdx.x & 63;
    float a[8], l[8]; float sa = 0.f, sl = 0.f;
#pragma unroll
    for (int j = 0; j < 8; ++j) { a[j] = attn[(size_t)m * 512 + j * 64 + lane]; l[j] = lru[(size_t)m * 512 + j * 64 + lane]; sa += a[j] * a[j]; sl += l[j] * l[j]; }
    sa = wave_sum(sa); sl = wave_sum(sl);
    const float ra = 1.f / sqrtf(sa / 512.f + RMS_EPS), rl = 1.f / sqrtf(sl / 512.f + RMS_EPS);
#pragma unroll
    for (int j = 0; j < 8; ++j) { const int c = j * 64 + lane; Y[(size_t)m * 1024 + c] = a[j] * ra * g_attn[c]; Y[(size_t)m * 1024 + 512 + c] = l[j] * rl * g_lru[c]; }
}
__global__ __launch_bounds__(256) void ln_rows(float* X, const float* g, const float* bta) {
    const int m = blockIdx.x * 4 + (threadIdx.x >> 6), lane = threadIdx.x & 63;
    float v[16]; float s = 0.f;
#pragma unroll
    for (int j = 0; j < 16; ++j) { v[j] = X[(size_t)m * 1024 + j * 64 + lane]; s += v[j]; }
    const float mean = wave_sum(s) / 1024.f; float q = 0.f;
#pragma unroll
    for (int j = 0; j < 16; ++j) { v[j] -= mean; q += v[j] * v[j]; }
    const float rstd = 1.f / sqrtf(wave_sum(q) / 1024.f + LN_EPS);
#pragma unroll
    for (int j = 0; j < 16; ++j) { const int c = j * 64 + lane; X[(size_t)m * 1024 + c] = v[j] * rstd * g[c] + bta[c]; }
}
__global__ __launch_bounds__(256) void route(const float* X, const float* rw  , int* tok_e, float* tok_p) {
    const int m = blockIdx.x * 4 + (threadIdx.x >> 6), lane = threadIdx.x & 63;
    float lg[8];
#pragma unroll
    for (int e = 0; e < 8; ++e) lg[e] = 0.f;
    for (int j = 0; j < 16; ++j) { const int d = j * 64 + lane; const float x = X[(size_t)m * 1024 + d];
#pragma unroll
        for (int e = 0; e < 8; ++e) lg[e] = fmaf(x, rw[d * 8 + e], lg[e]); }
#pragma unroll
    for (int e = 0; e < 8; ++e) lg[e] = wave_sum(lg[e]);
    int e0 = 0; float v0 = lg[0];
#pragma unroll
    for (int e = 1; e < 8; ++e) if (lg[e] > v0) { v0 = lg[e]; e0 = e; }
    int e1 = -1; float v1 = -INFINITY;
#pragma unroll
    for (int e = 0; e < 8; ++e) if (e != e0 && lg[e] > v1) { v1 = lg[e]; e1 = e; }
    if (lane == 0) { const float p1 = expf(v1 - v0), den = 1.f + p1; tok_e[2 * m] = e0; tok_e[2 * m + 1] = e1; tok_p[2 * m] = 1.f / den; tok_p[2 * m + 1] = p1 / den; }
}
__global__ __launch_bounds__(256) void dispatch(const int* tok_e, int* tok_pos, int* row_tok, int* tile_expert  ) {
    __shared__ int s_tot[8], s_bef[8], s_w[4][8];
    const int tile = blockIdx.x, tid = threadIdx.x, lane = tid & 63, wv = tid >> 6;
    if (tid < 8) { s_tot[tid] = 0; s_bef[tid] = 0; }
    __syncthreads();
    int tot[8], bef[8];
#pragma unroll
    for (int e = 0; e < 8; ++e) { tot[e] = 0; bef[e] = 0; }
    for (int i = tid; i < 2 * M_; i += 256) { const int ev = tok_e[i]; const int before = ((i >> 1) < tile * 256) ? 1 : 0;
#pragma unroll
        for (int e = 0; e < 8; ++e) { const int hit = (ev == e) ? 1 : 0; tot[e] += hit; bef[e] += hit & before; } }
#pragma unroll
    for (int e = 0; e < 8; ++e) {
        int a = tot[e], b = bef[e];
#pragma unroll
        for (int o = 1; o < 64; o <<= 1) { a += __shfl_xor(a, o); b += __shfl_xor(b, o); }
        if (lane == 0) { atomicAdd(&s_tot[e], a); atomicAdd(&s_bef[e], b); }
    }
    const int tok = tile * 256 + tid; const int e0 = tok_e[2 * tok], e1 = tok_e[2 * tok + 1];
    int myrank0 = 0, myrank1 = 0;
#pragma unroll
    for (int e = 0; e < 8; ++e) {
        const bool has = (e0 == e) || (e1 == e);
        const unsigned long long mask = __ballot(has);
        const int rk = __popcll(mask & ((1ull << lane) - 1ull));
        if (e0 == e) myrank0 = rk; if (e1 == e) myrank1 = rk;
        if (lane == 0) s_w[wv][e] = __popcll(mask);
    }
    __syncthreads();
    int seg[9]; seg[0] = 0;
#pragma unroll
    for (int e = 0; e < 8; ++e) seg[e + 1] = seg[e] + ((s_tot[e] + 255) & ~255);
    int p0 = 0, p1 = 0;
#pragma unroll
    for (int e = 0; e < 8; ++e) {
        int wp = 0;
#pragma unroll
        for (int w2 = 0; w2 < 4; ++w2) if (w2 < wv) wp += s_w[w2][e];
        if (e0 == e) p0 = seg[e] + s_bef[e] + wp + myrank0;
        if (e1 == e) p1 = seg[e] + s_bef[e] + wp + myrank1;
    }
    tok_pos[2 * tok] = p0; tok_pos[2 * tok + 1] = p1; row_tok[p0] = tok; row_tok[p1] = tok;
    if (tile == 0) {
#pragma unroll
        for (int e = 0; e < 8; ++e) for (int r = seg[e] + s_tot[e] + tid; r < seg[e + 1]; r += 256) row_tok[r] = -1;
        const int nT = seg[8] >> 8;
        for (int j = tid; j <= NT_MAX; j += 256) {
            int ex = -1;
            if (j < nT) {
#pragma unroll
                for (int e = 0; e < 8; ++e) if (j * 256 >= seg[e] && j * 256 < seg[e + 1]) ex = e;
            }
            if (j == NT_MAX) ex = nT;
            tile_expert[j] = ex;
        }
    }
}
__global__ __launch_bounds__(256) void combine_ln(float* X, const float* Ys, const int* tok_pos, const float* tok_p, const float* g, const float* bta) {
    const int m = blockIdx.x * 4 + (threadIdx.x >> 6), lane = threadIdx.x & 63;
    const int p0 = tok_pos[2 * m], p1 = tok_pos[2 * m + 1]; const float w0 = tok_p[2 * m], w1 = tok_p[2 * m + 1];
    float v[16]; float s = 0.f;
#pragma unroll
    for (int j = 0; j < 16; ++j) { const int c = j * 64 + lane; const float f = w0 * Ys[(size_t)p0 * 1024 + c] + w1 * Ys[(size_t)p1 * 1024 + c]; v[j] = ALPHA * X[(size_t)m * 1024 + c] + f; s += v[j]; }
    const float mean = wave_sum(s) / 1024.f; float q = 0.f;
#pragma unroll
    for (int j = 0; j < 16; ++j) { v[j] -= mean; q += v[j] * v[j]; }
    const float rstd = 1.f / sqrtf(wave_sum(q) / 1024.f + LN_EPS);
#pragma unroll
    for (int j = 0; j < 16; ++j) { const int c = j * 64 + lane; X[(size_t)m * 1024 + c] = v[j] * rstd * g[c] + bta[c]; }
}
}

extern "C" void kernel_launch(void* const* d_in, const int* in_sizes, int n_in, void* d_out, int out_size, void* d_ws, size_t ws_size, hipStream_t stream) {
    const size_t MiB = 1u << 20;
    if (n_in != 24 || out_size != M_ * D_ || ws_size < 460 * MiB) { fprintf(stderr, "kernel_launch: unexpected shapes (n_in %d out %d ws %zu)\n", n_in, out_size, ws_size); return; }
    const float* x = (const float*)d_in[0]; const float* w_in = (const float*)d_in[1]; const float* conv_w = (const float*)d_in[2]; const float* conv_b = (const float*)d_in[3];
    const float* w_a = (const float*)d_in[4]; const float* b_a = (const float*)d_in[5]; const float* w_x = (const float*)d_in[6]; const float* b_x = (const float*)d_in[7];
    const float* lam = (const float*)d_in[8]; const float* rel_bias = (const float*)d_in[9]; const float* g_attn = (const float*)d_in[10]; const float* g_lru = (const float*)d_in[11];
    const float* w_out = (const float*)d_in[12]; const float* ln1_g = (const float*)d_in[13]; const float* ln1_b = (const float*)d_in[14]; const float* ln2_g = (const float*)d_in[15]; const float* ln2_b = (const float*)d_in[16];
    const float* ffn_g = (const float*)d_in[17]; const float* ffn_u = (const float*)d_in[18]; const float* ffn_d = (const float*)d_in[19]; const float* router_w = (const float*)d_in[20];
    const float* moe_g = (const float*)d_in[21]; const float* moe_u = (const float*)d_in[22]; const float* moe_d = (const float*)d_in[23];
    float* out = (float*)d_out; char* ws = (char*)d_ws;
    float* Qb = (float*)(ws + 0 * MiB); float* Kb = (float*)(ws + 64 * MiB); float* Vb = (float*)(ws + 128 * MiB); float* Ub = (float*)(ws + 192 * MiB); float* Gb = (float*)(ws + 256 * MiB);
    float* ATT = (float*)(ws + 320 * MiB); float* LRU = (float*)(ws + 384 * MiB);
    float* UC = Qb; float* Ab = Kb; float* Bb = Vb; float* Y = (float*)(ws + 0 * MiB);
    float* Hd = (float*)(ws + 0 * MiB);
    float* Ys = (float*)(ws + 0 * MiB);
    float* Hc = (float*)(ws + 264 * MiB);
    int* tok_e = (int*)(ws + 448 * MiB); float* tok_p = (float*)(ws + 449 * MiB); int* tok_pos = (int*)(ws + 450 * MiB); int* row_tok = (int*)(ws + 451 * MiB); int* tile_expert = (int*)(ws + 452 * MiB);

    for (int layer = 0; layer < 2; ++layer) {
        const float* xin = (layer == 0) ? x : out;
        {
            GemmArgs g{}; g.A = xin; g.lda = D_; g.B = w_in + (size_t)layer * D_ * 2560; g.ldb = 2560; g.M = M_; g.N = 2560; g.K = D_; g.C = Qb; g.ldc = 512; g.split_cols = 512; g.split_stride = (long long)M_ * 512;
            hipLaunchKernelGGL(gemm_f32<0>, dim3(2560 / 128, M_ / 128), dim3(256), 0, stream, g);
        }
        hipLaunchKernelGGL(attn_naive, dim3(M_ * H_ / 4), dim3(256), 0, stream, Qb, Kb, Vb, rel_bias, ATT);
        hipLaunchKernelGGL(lru_conv, dim3(M_ * DL_ / 256), dim3(256), 0, stream, Ub, conv_w + layer * 2048, conv_b + layer * 512, UC);
        hipLaunchKernelGGL(lru_gates, dim3(M_ * DL_ / 256), dim3(256), 0, stream, UC, w_a + (size_t)layer * 32768, b_a + layer * 512, w_x + (size_t)layer * 32768, b_x + layer * 512, lam + layer * 512, Ab, Bb);
        hipLaunchKernelGGL(lru_scan, dim3(NB_ * DL_ / 64), dim3(64), 0, stream, Ab, Bb, Gb, LRU);
        hipLaunchKernelGGL(merge_norm, dim3(M_ / 4), dim3(256), 0, stream, ATT, LRU, g_attn + layer * 512, g_lru + layer * 512, Y);
        {
            GemmArgs g{}; g.A = Y; g.lda = D_; g.B = w_out + (size_t)layer * D_ * D_; g.ldb = D_; g.M = M_; g.N = D_; g.K = D_; g.C = out; g.ldc = D_; g.R = xin; g.ldr = D_; g.alpha = ALPHA;
            hipLaunchKernelGGL(gemm_f32<1>, dim3(D_ / 128, M_ / 128), dim3(256), 0, stream, g);
        }
        hipLaunchKernelGGL(ln_rows, dim3(M_ / 4), dim3(256), 0, stream, out, ln1_g + layer * D_, ln1_b + layer * D_);
        if (layer == 0) {
            {   GemmArgs g{}; g.A = out; g.lda = D_; g.B = ffn_g; g.B2 = ffn_u; g.ldb = DFF_; g.M = M_; g.N = DFF_; g.K = D_; g.C = Hd; g.ldc = DFF_;
                hipLaunchKernelGGL(gemm_f32<2>, dim3(DFF_ / 128, M_ / 128), dim3(256), 0, stream, g); }
            {   GemmArgs g{}; g.A = Hd; g.lda = DFF_; g.B = ffn_d; g.ldb = D_; g.M = M_; g.N = D_; g.K = DFF_; g.C = out; g.ldc = D_; g.R = out; g.ldr = D_; g.alpha = ALPHA;
                hipLaunchKernelGGL(gemm_f32<1>, dim3(D_ / 128, M_ / 128), dim3(256), 0, stream, g); }
            hipLaunchKernelGGL(ln_rows, dim3(M_ / 4), dim3(256), 0, stream, out, ln2_g + layer * D_, ln2_b + layer * D_);
        } else {
            hipLaunchKernelGGL(route, dim3(M_ / 4), dim3(256), 0, stream, out, router_w, tok_e, tok_p);
            hipLaunchKernelGGL(dispatch, dim3(M_ / 256), dim3(256), 0, stream, tok_e, tok_pos, row_tok, tile_expert);
            for (int c = 0; c < (SORT_ROWS + 8191) / 8192; ++c) {
                const int rows = (c * 8192 + 8192 <= SORT_ROWS) ? 8192 : SORT_ROWS - c * 8192;
                {   GemmArgs g{}; g.A = out; g.lda = D_; g.arow = row_tok + c * 8192; g.B = moe_g; g.B2 = moe_u; g.ldb = DFE_; g.b_estride = (long long)D_ * DFE_; g.tile_expert = tile_expert + c * 32;
                    g.M = rows; g.N = DFE_; g.K = D_; g.C = Hc; g.ldc = DFE_;
                    hipLaunchKernelGGL(gemm_f32<2>, dim3(DFE_ / 128, rows / 128), dim3(256), 0, stream, g); }
                {   GemmArgs g{}; g.A = Hc; g.lda = DFE_; g.B = moe_d; g.ldb = D_; g.b_estride = (long long)DFE_ * D_; g.tile_expert = tile_expert + c * 32;
                    g.M = rows; g.N = D_; g.K = DFE_; g.C = Ys + (size_t)c * 8192 * D_; g.ldc = D_;
                    hipLaunchKernelGGL(gemm_f32<0>, dim3(D_ / 128, rows / 128), dim3(256), 0, stream, g); }
            }
            hipLaunchKernelGGL(combine_ln, dim3(M_ / 4), dim3(256), 0, stream, out, Ys, tok_pos, tok_p, ln2_g + layer * D_, ln2_b + layer * D_);
        }
    }
}
```

```cpp
#include <hip/hip_runtime.h>
#include <cstdio>
#include <cstdint>
#include <cmath>
namespace pg8 {
#define PG8_LAS __attribute__((address_space(3)))
typedef unsigned short bf16_t;
typedef short bf16x8 __attribute__((ext_vector_type(8)));
typedef float f32x4 __attribute__((ext_vector_type(4)));
typedef unsigned u32x4 __attribute__((ext_vector_type(4)));
typedef int i32x4 __attribute__((ext_vector_type(4)));
typedef int i32x8 __attribute__((ext_vector_type(8)));
constexpr int BM = 256, BK = 64, HALF = 128, HTB = HALF * BK * 2  , STAGE_BYTES = 8 * HTB, NXCD = 8, WGM = 8;

__host__ __device__ __forceinline__ int lds_byte(int r, int c) { const int st = (r >> 4) * 2 + (c >> 5), rr = r & 15, cc = c & 31, ob = rr * 64 + cc * 2; return st * 1024 + (ob ^ (((ob >> 9) & 1) << 5)); }
__host__ __device__ __forceinline__ void stage_rc(int b, int& R, int& C) { const int st = b / 1024, sb = b % 1024, swz = sb ^ (((sb >> 9) & 1) << 5); R = (st >> 1) * 16 + swz / 64; C = (st & 1) * 32 + (swz % 64) / 2; }
__host__ __device__ __forceinline__ int perm32(int rho) { const int n = rho >> 4, i = rho & 15; return 8 * (i >> 2) + 4 * n + (i & 3); }

struct Unit { int pm, pn; size_t boffb, aoffb; int ks; };
struct Gemm { const bf16_t* A; const bf16_t* Bt; int M, N, K; int ld; };

struct StaticOrder {
    int nM, nN, nwg, G, c;
    __host__ __device__ void init(int M, int N, int G_, int c_) { nM = M / BM; nN = N / BM; nwg = nM * nN; G = G_; c = c_; }
    __host__ __device__ bool next(int i, Unit& u) const {
        const long L = (long)i * G + c; if (L >= nwg) return false;
        int wgid = (int)L; { const int q = nwg / NXCD, r = nwg % NXCD, xcd = wgid % NXCD, off = wgid / NXCD; wgid = (xcd < r ? xcd * (q + 1) : r * (q + 1) + (xcd - r) * q) + off; }
        const int nig = WGM * nN, gid = wgid / nig, fm = gid * WGM, gsz = (nM - fm) < WGM ? (nM - fm) : WGM;
        u.pm = fm + ((wgid % nig) % gsz); u.pn = (wgid % nig) / gsz; u.boffb = 0; u.aoffb = 0; u.ks = 0; return true;
    }
    __device__ __forceinline__ void a_ready(const Unit&) const {}
    __device__ __forceinline__ void done(const Unit&) const {}
};

__device__ __forceinline__ unsigned cvt_pk_bf16(float lo, float hi) { unsigned r; asm volatile("v_cvt_pk_bf16_f32 %0, %1, %2" : "=v"(r) : "v"(lo), "v"(hi)); return r; }
typedef float f32x2 __attribute__((ext_vector_type(2)));
__device__ __forceinline__ f32x2 gelu_pk(f32x2 v) {
    const f32x2 av = __builtin_elementwise_abs(v), d = av * 0.2316418882f + 1.0f;
    f32x2 t; t.x = __builtin_amdgcn_rcpf(d.x); t.y = __builtin_amdgcn_rcpf(d.y);
    f32x2 q = t * 0.5307027145f + (-0.7265760135f); q = q * t + 0.7107068705f; q = q * t + (-0.142248368f); q = q * t + 0.127414796f; q = q * t;
    const f32x2 s = (v * v) * (-0.72134752044f);
    f32x2 e; e.x = __builtin_amdgcn_exp2f(s.x); e.y = __builtin_amdgcn_exp2f(s.y);
    const f32x2 m = v * (q * e), r = v - m;
    f32x2 o; o.x = v.x < 0.f ? m.x : r.x; o.y = v.y < 0.f ? m.y : r.y; return o;
}

template <int ACT  > struct EpiBf16 {
    static constexpr bool PERM = true, AFTER_DRAIN = false; static_assert(ACT == 0 || ACT == 1, "EpiBf16: ACT is 0 (none) or 1 (gelu_pk)");
    bf16_t* O; int ldc; const float* bias; int split_cols; size_t split_stride; float scale0;
    __device__ __forceinline__ void operator()(const f32x4 (&acc)[2][2][4][2], const Unit& u, int wr, int wc, int fr, int fq) const {
        const int row0 = u.pm * BM + wr * 64 + fr; int colt = u.pn * BM; bf16_t* base = O;
        float sc = 1.f; if (split_cols) { const int t = colt / split_cols; base += (size_t)t * split_stride; colt -= t * split_cols; if (t == 0) sc = scale0; }
        const int col0 = colt + wc * 32 + 8 * fq, bcol0 = u.pn * BM + wc * 32 + 8 * fq;
        f32x4 bv[2][2];
#pragma unroll
        for (int bj = 0; bj < 2; ++bj)
#pragma unroll
            for (int n = 0; n < 2; ++n) bv[bj][n] = bias ? *(const f32x4*)(bias + bcol0 + bj * HALF + 4 * n) : (f32x4){0.f, 0.f, 0.f, 0.f};
#pragma unroll
        for (int ai = 0; ai < 2; ++ai)
#pragma unroll
            for (int m = 0; m < 4; ++m) { bf16_t* rowp = base + (size_t)(row0 + ai * HALF + m * 16) * ldc + col0;
#pragma unroll
                for (int bj = 0; bj < 2; ++bj) { f32x4 v0 = acc[ai][bj][m][0] + bv[bj][0], v1 = acc[ai][bj][m][1] + bv[bj][1];
                    if (ACT == 1) { f32x2 a = gelu_pk((f32x2){v0[0], v0[1]}), b = gelu_pk((f32x2){v0[2], v0[3]}), c = gelu_pk((f32x2){v1[0], v1[1]}), d = gelu_pk((f32x2){v1[2], v1[3]});
                        v0 = (f32x4){a.x, a.y, b.x, b.y}; v1 = (f32x4){c.x, c.y, d.x, d.y}; }
                    v0 = v0 * sc; v1 = v1 * sc; u32x4 w; w.x = cvt_pk_bf16(v0[0], v0[1]); w.y = cvt_pk_bf16(v0[2], v0[3]); w.z = cvt_pk_bf16(v1[0], v1[1]); w.w = cvt_pk_bf16(v1[2], v1[3]);
                    *(u32x4*)(rowp + bj * HALF) = w; } }
    }
};

struct EpiSwiGLU {
    static constexpr bool PERM = true, AFTER_DRAIN = false;
    bf16_t* O; int ldc; bf16_t* O2; int split_pm; float wscale;
    __device__ __forceinline__ static float silu_mul(float g, float u) { return g * __builtin_amdgcn_rcpf(1.0f + __builtin_amdgcn_exp2f(g * -1.4426950408889634f)) * u; }
    __device__ __forceinline__ void operator()(const f32x4 (&acc)[2][2][4][2], const Unit& u, int wr, int wc, int fr, int fq) const {
        const int row0 = u.pm * BM + wr * 64 + fr, col0 = u.pn * HALF + wc * 32 + 8 * fq;
#pragma unroll
        for (int ai = 0; ai < 2; ++ai)
#pragma unroll
            for (int m = 0; m < 4; ++m) { bf16_t* rowp = ((split_pm >= 0 && u.pm >= split_pm) ? O2 : O) + (size_t)(row0 + ai * HALF + m * 16) * ldc + col0;
                const f32x4 g0 = acc[ai][0][m][0] * wscale, g1 = acc[ai][0][m][1] * wscale, u0 = acc[ai][1][m][0] * wscale, u1 = acc[ai][1][m][1] * wscale;
                u32x4 w; w.x = cvt_pk_bf16(silu_mul(g0[0], u0[0]), silu_mul(g0[1], u0[1])); w.y = cvt_pk_bf16(silu_mul(g0[2], u0[2]), silu_mul(g0[3], u0[3]));
                w.z = cvt_pk_bf16(silu_mul(g1[0], u1[0]), silu_mul(g1[1], u1[1])); w.w = cvt_pk_bf16(silu_mul(g1[2], u1[2]), silu_mul(g1[3], u1[3]));
                *(u32x4*)rowp = w; }
    }
};
struct EpiResF32 {
    static constexpr bool PERM = false, AFTER_DRAIN = false;
    const float* R; float* out; int ldc; float alpha;
    __device__ __forceinline__ void operator()(const f32x4 (&acc)[2][2][4][2], const Unit& u, int wr, int wc, int fr, int fq) const {
        const int col0 = u.pn * BM + wc * 32 + 4 * fq;
#pragma unroll
        for (int ai = 0; ai < 2; ++ai)
#pragma unroll
            for (int m = 0; m < 4; ++m) { const size_t off = (size_t)(u.pm * BM + ai * HALF + wr * 64 + m * 16 + fr) * ldc + col0;
#pragma unroll
                for (int bj = 0; bj < 2; ++bj)
#pragma unroll
                    for (int n = 0; n < 2; ++n) { const f32x4 rs = *(const f32x4*)(R + off + bj * HALF + n * 16); *(f32x4*)(out + off + bj * HALF + n * 16) = rs * alpha + acc[ai][bj][m][n]; }
                if (m & 1) asm volatile("" ::: "memory"); }
    }
};
__device__ __forceinline__ unsigned pk4_e4m3(float a, float b, float c, float d) {
    a = __builtin_fminf(__builtin_fmaxf(a, -448.f), 448.f); b = __builtin_fminf(__builtin_fmaxf(b, -448.f), 448.f); c = __builtin_fminf(__builtin_fmaxf(c, -448.f), 448.f); d = __builtin_fminf(__builtin_fmaxf(d, -448.f), 448.f);
    unsigned w = 0u; w = __builtin_amdgcn_cvt_pk_fp8_f32(a, b, w, false); w = __builtin_amdgcn_cvt_pk_fp8_f32(c, d, w, true); return w;
}
struct EpiSwiGLU8 {
    static constexpr bool PERM = true, AFTER_DRAIN = false;
    unsigned char* O; int ldc; float wscale, hscale;
    __device__ __forceinline__ void operator()(const f32x4 (&acc)[2][2][4][2], const Unit& u, int wr, int wc, int fr, int fq) const {
        const int row0 = u.pm * BM + wr * 64 + fr, col0 = u.pn * HALF + wc * 32 + 8 * fq;
        typedef unsigned u32x2 __attribute__((ext_vector_type(2)));
#pragma unroll
        for (int ai = 0; ai < 2; ++ai)
#pragma unroll
            for (int m = 0; m < 4; ++m) { unsigned char* rowp = O + (size_t)(row0 + ai * HALF + m * 16) * ldc + col0;
                const f32x4 g0 = acc[ai][0][m][0] * wscale, g1 = acc[ai][0][m][1] * wscale, u0 = acc[ai][1][m][0] * (wscale * hscale), u1 = acc[ai][1][m][1] * (wscale * hscale);
                u32x2 w; w.x = pk4_e4m3(EpiSwiGLU::silu_mul(g0[0], u0[0]), EpiSwiGLU::silu_mul(g0[1], u0[1]), EpiSwiGLU::silu_mul(g0[2], u0[2]), EpiSwiGLU::silu_mul(g0[3], u0[3]));
                w.y = pk4_e4m3(EpiSwiGLU::silu_mul(g1[0], u1[0]), EpiSwiGLU::silu_mul(g1[1], u1[1]), EpiSwiGLU::silu_mul(g1[2], u1[2]), EpiSwiGLU::silu_mul(g1[3], u1[3]));
                *(u32x2*)rowp = w; }
    }
};
struct EpiBf16S {
    static constexpr bool PERM = true, AFTER_DRAIN = false;
    bf16_t* O; int ldc; float s;
    __device__ __forceinline__ void operator()(const f32x4 (&acc)[2][2][4][2], const Unit& u, int wr, int wc, int fr, int fq) const {
        const int row0 = u.pm * BM + wr * 64 + fr, col0 = u.pn * BM + wc * 32 + 8 * fq;
#pragma unroll
        for (int ai = 0; ai < 2; ++ai)
#pragma unroll
            for (int m = 0; m < 4; ++m) { bf16_t* rowp = O + (size_t)(row0 + ai * HALF + m * 16) * ldc + col0;
#pragma unroll
                for (int bj = 0; bj < 2; ++bj) { const f32x4 v0 = acc[ai][bj][m][0] * s, v1 = acc[ai][bj][m][1] * s;
                    u32x4 w; w.x = cvt_pk_bf16(v0[0], v0[1]); w.y = cvt_pk_bf16(v0[2], v0[3]); w.z = cvt_pk_bf16(v1[0], v1[1]); w.w = cvt_pk_bf16(v1[2], v1[3]);
                    *(u32x4*)(rowp + bj * HALF) = w; } }
    }
};
struct EpiResBf16 {
    static constexpr bool PERM = true, AFTER_DRAIN = false;
    const bf16_t* R; bf16_t* out; int ldc; float alpha; float s;
    __device__ __forceinline__ void operator()(const f32x4 (&acc)[2][2][4][2], const Unit& u, int wr, int wc, int fr, int fq) const {
        const int row0 = u.pm * BM + wr * 64 + fr, col0 = u.pn * BM + wc * 32 + 8 * fq;
#pragma unroll
        for (int ai = 0; ai < 2; ++ai)
#pragma unroll
            for (int m = 0; m < 4; ++m) { const size_t off = (size_t)(row0 + ai * HALF + m * 16) * ldc + col0;
#pragma unroll
                for (int bj = 0; bj < 2; ++bj) { const u32x4 rv = *(const u32x4*)(R + off + bj * HALF); const f32x4 v0 = acc[ai][bj][m][0] * s, v1 = acc[ai][bj][m][1] * s;
                    u32x4 w;
                    w.x = cvt_pk_bf16(alpha * __uint_as_float(rv.x << 16) + v0[0], alpha * __uint_as_float(rv.x & 0xffff0000u) + v0[1]);
                    w.y = cvt_pk_bf16(alpha * __uint_as_float(rv.y << 16) + v0[2], alpha * __uint_as_float(rv.y & 0xffff0000u) + v0[3]);
                    w.z = cvt_pk_bf16(alpha * __uint_as_float(rv.z << 16) + v1[0], alpha * __uint_as_float(rv.z & 0xffff0000u) + v1[1]);
                    w.w = cvt_pk_bf16(alpha * __uint_as_float(rv.w << 16) + v1[2], alpha * __uint_as_float(rv.w & 0xffff0000u) + v1[3]);
                    *(u32x4*)(out + off + bj * HALF) = w; }
                if (m & 1) asm volatile("" ::: "memory"); }
    }
};
struct MoeOrder {
    int base, nrows, nN, G, c; int segt[9]; size_t estride_b; int split_pm; size_t adiff;
    __device__ __forceinline__ bool next(int i, Unit& u) const {
        const long L = (long)i * G + c; if (L >= (long)nrows * nN) return false;
        u.pm = base + (int)(L % nrows); u.pn = (int)(L / nrows);
        int e = 0;
#pragma unroll
        for (int k = 1; k < 8; ++k) e += (u.pm >= segt[k]) ? 1 : 0;
        u.boffb = (size_t)e * estride_b; u.aoffb = (split_pm >= 0 && u.pm >= split_pm) ? adiff : 0; u.ks = 0; return true;
    }
    __device__ __forceinline__ void a_ready(const Unit&) const {}
    __device__ __forceinline__ void done(const Unit&) const {}
};
struct MoeSplitK {
    int base, nrows, nN, nS, KS, G, c; int segt[9]; size_t estride_b;
    __device__ __forceinline__ bool next(int i, Unit& u) const {
        const long L = (long)i * G + c; if (L >= (long)nrows * nN * nS) return false;
        u.ks = (int)(L % nS); const int rest = (int)(L / nS); u.pm = base + rest % nrows; u.pn = rest / nrows;
        int e = 0;
#pragma unroll
        for (int k = 1; k < 8; ++k) e += (u.pm >= segt[k]) ? 1 : 0;
        u.boffb = (size_t)e * estride_b + (size_t)u.ks * KS * 2; u.aoffb = (size_t)u.ks * KS * 2; return true;
    }
    __device__ __forceinline__ void a_ready(const Unit&) const {}
    __device__ __forceinline__ void done(const Unit&) const {}
};
struct EpiPart {
    static constexpr bool PERM = true, AFTER_DRAIN = false;
    bf16_t* P; int ldc, base, ptiles; float s;
    __device__ __forceinline__ void operator()(const f32x4 (&acc)[2][2][4][2], const Unit& u, int wr, int wc, int fr, int fq) const {
        const int row0 = (u.ks * ptiles + (u.pm - base)) * BM + wr * 64 + fr, col0 = u.pn * BM + wc * 32 + 8 * fq;
#pragma unroll
        for (int ai = 0; ai < 2; ++ai)
#pragma unroll
            for (int m = 0; m < 4; ++m) { bf16_t* rowp = P + (size_t)(row0 + ai * HALF + m * 16) * ldc + col0;
#pragma unroll
                for (int bj = 0; bj < 2; ++bj) { const f32x4 v0 = acc[ai][bj][m][0] * s, v1 = acc[ai][bj][m][1] * s;
                    u32x4 w; w.x = cvt_pk_bf16(v0[0], v0[1]); w.y = cvt_pk_bf16(v0[2], v0[3]); w.z = cvt_pk_bf16(v1[0], v1[1]); w.w = cvt_pk_bf16(v1[2], v1[3]);
                    *(u32x4*)(rowp + bj * HALF) = w; } }
    }
};

template <class Epi, class Sched, bool ALIGN_EPI = false, bool SP2 = false, bool FP8 = false>
__device__ __forceinline__ void gemm_phase(PG8_LAS unsigned char* lds, const Gemm g, const Sched& S, const Epi& E) {
    const int tid = threadIdx.x, wid = __builtin_amdgcn_readfirstlane(tid >> 6), lane = tid & 63, wr = wid >> 2, wc = wid & 3, fr = lane & 15, fq = lane >> 4;
    const int K = g.K, nt = K / BK, LD = g.ld ? g.ld : g.K;
    unsigned voffA[2], voffB[2];
#pragma unroll
    for (int i = 0; i < 2; ++i) { int R, C; stage_rc(tid * 16 + i * 8192, R, C); const int Rb = Epi::PERM ? ((R & ~31) + perm32(R & 31)) : R;
        voffA[i] = (unsigned)(R * LD + C) * 2u; voffB[i] = (unsigned)(Rb * LD + C) * 2u; }
    const size_t kstep = (size_t)(BK * 2);
    const size_t hstep = (size_t)HALF * LD * 2;
    const size_t tstep = 2 * hstep;
    const unsigned ldsw = (unsigned)wid * 1024u;
    const int aoff = lds_byte(wr * 64 + fr, fq * 8), boff = lds_byte(wc * 32 + fr, fq * 8);
#define PG8_SA(b, h) (((b) * 2 + (h)) * HTB)
#define PG8_SB(b, h) ((4 + (b) * 2 + (h)) * HTB)
#define PG8_STAGE(bufoff, gbase, voff) do { _Pragma("unroll") for (int _i = 0; _i < 2; ++_i) \
        __builtin_amdgcn_global_load_lds((const unsigned*)((const char*)(gbase) + (voff)[_i]), (PG8_LAS unsigned*)(lds + (bufoff) + ldsw + _i * 8192), 16, 0, 0); } while (0)
#define PG8_LDA(dst, b, h) do { if constexpr (FP8) { _Pragma("unroll") for (int m = 0; m < 4; ++m) { const i32x4 lo_ = *(const PG8_LAS i32x4*)(lds + PG8_SA(b, h) + aoff + m * 2048), hi_ = *(const PG8_LAS i32x4*)(lds + PG8_SA(b, h) + aoff + m * 2048 + 1024); \
            dst##8[m] = __builtin_shufflevector(lo_, hi_, 0, 1, 2, 3, 4, 5, 6, 7); } } \
        else { _Pragma("unroll") for (int m = 0; m < 4; ++m) _Pragma("unroll") for (int k = 0; k < 2; ++k) dst[m][k] = *(const PG8_LAS bf16x8*)(lds + PG8_SA(b, h) + aoff + m * 2048 + k * 1024); } } while (0)
#define PG8_LDB(dst, b, h) do { if constexpr (FP8) { _Pragma("unroll") for (int n = 0; n < 2; ++n) { const i32x4 lo_ = *(const PG8_LAS i32x4*)(lds + PG8_SB(b, h) + boff + n * 2048), hi_ = *(const PG8_LAS i32x4*)(lds + PG8_SB(b, h) + boff + n * 2048 + 1024); \
            dst##8[n] = __builtin_shufflevector(lo_, hi_, 0, 1, 2, 3, 4, 5, 6, 7); } } \
        else { _Pragma("unroll") for (int n = 0; n < 2; ++n) _Pragma("unroll") for (int k = 0; k < 2; ++k) dst[n][k] = *(const PG8_LAS bf16x8*)(lds + PG8_SB(b, h) + boff + n * 2048 + k * 1024); } } while (0)
#define PG8_MMA(ai, bj, At, Bt) do { __builtin_amdgcn_s_setprio(1); \
        if constexpr (FP8) { _Pragma("unroll") for (int m = 0; m < 4; ++m) _Pragma("unroll") for (int n = 0; n < 2; ++n) \
            asm volatile("v_mfma_scale_f32_16x16x128_f8f6f4 %0, %1, %2, %0, %3, %3 op_sel_hi:[0,0,0]" : "+v"(acc[ai][bj][m][n]) : "v"(Bt##8[n]), "v"(At##8[m]), "v"(fp8_one)); } \
        else { _Pragma("unroll") for (int m = 0; m < 4; ++m) _Pragma("unroll") for (int n = 0; n < 2; ++n) _Pragma("unroll") for (int k = 0; k < 2; ++k) \
            acc[ai][bj][m][n] = __builtin_amdgcn_mfma_f32_16x16x32_bf16(Bt[n][k], At[m][k], acc[ai][bj][m][n], 0, 0, 0); } \
        __builtin_amdgcn_s_setprio(0); } while (0)
#define PG8_WAIT_V(n) asm volatile("s_waitcnt vmcnt(" #n ")" ::: "memory")
#define PG8_WAIT_L(n) asm volatile("s_waitcnt lgkmcnt(" #n ")" ::: "memory")
#define PG8_BAR __builtin_amdgcn_s_barrier()
#define PG8_SCHED __builtin_amdgcn_sched_barrier(0)
    Unit cur, nxt; int ui = 0;
    if (!S.next(0, cur)) return;
    f32x4 acc[2][2][4][2];
#pragma unroll
    for (int a = 0; a < 2; ++a)
#pragma unroll
        for (int b = 0; b < 2; ++b)
#pragma unroll
            for (int m = 0; m < 4; ++m)
#pragma unroll
                for (int n = 0; n < 2; ++n) acc[a][b][m][n] = (f32x4){0.f, 0.f, 0.f, 0.f};
    bf16x8 At[4][2], B0[2][2], B1[2][2];
    i32x8 At8[4], B08[2], B18[2];
    int fp8_one = 0x7F7F7F7F; if constexpr (FP8) asm volatile("" : "+v"(fp8_one));
    const char* cA = (const char*)g.A + (size_t)cur.pm * tstep + cur.aoffb; const char* cB = (const char*)g.Bt + (size_t)cur.pn * tstep + cur.boffb;
    S.a_ready(cur);
    if constexpr (SP2) {
        PG8_STAGE(PG8_SB(0, 0), cB, voffB); PG8_STAGE(PG8_SB(0, 1), cB + hstep, voffB); PG8_STAGE(PG8_SA(0, 0), cA, voffA); PG8_STAGE(PG8_SA(0, 1), cA + hstep, voffA);
        if (wr == 1) PG8_BAR;
        PG8_WAIT_V(2); PG8_BAR;
        PG8_STAGE(PG8_SB(1, 0), cB + kstep, voffB); PG8_STAGE(PG8_SA(1, 0), cA + kstep, voffA); PG8_STAGE(PG8_SB(1, 1), cB + hstep + kstep, voffB);
        PG8_WAIT_V(6); PG8_BAR;
    } else {
        PG8_STAGE(PG8_SB(0, 0), cB, voffB); PG8_STAGE(PG8_SA(0, 0), cA, voffA); PG8_STAGE(PG8_SB(0, 1), cB + hstep, voffB); PG8_STAGE(PG8_SA(0, 1), cA + hstep, voffA);
        if (wr == 1) PG8_BAR;
        PG8_WAIT_V(4); PG8_BAR;
        PG8_STAGE(PG8_SB(1, 0), cB + kstep, voffB); PG8_STAGE(PG8_SA(1, 0), cA + kstep, voffA); PG8_STAGE(PG8_SB(1, 1), cB + hstep + kstep, voffB);
        PG8_WAIT_V(6); PG8_BAR;
    }
    for (;;) {
        const bool has_next = S.next(ui + 1, nxt);
        const char* nA = has_next ? (const char*)g.A + (size_t)nxt.pm * tstep + nxt.aoffb : cA; const char* nB = has_next ? (const char*)g.Bt + (size_t)nxt.pn * tstep + nxt.boffb : cB;
#pragma unroll 1
        for (int t = 0; t < nt; t += 2) {
            const bool last = (t == nt - 2);
            const char* a1 = cA + (size_t)(t + 1) * kstep;
            const char* a2 = last ? nA : cA + (size_t)(t + 2) * kstep; const char* b2 = last ? nB : cB + (size_t)(t + 2) * kstep;
            const char* a3 = a2 + kstep; const char* b3 = b2 + kstep;
            if (last && has_next) S.a_ready(nxt);
            if constexpr (SP2) {
            PG8_LDB(B0, 0, 0); PG8_LDB(B1, 0, 1); PG8_SCHED; PG8_LDA(At, 0, 0); PG8_STAGE(PG8_SA(1, 1), a1 + hstep, voffA);
            PG8_WAIT_V(8); PG8_WAIT_L(0); PG8_BAR; PG8_MMA(0, 0, At, B0); PG8_MMA(0, 1, At, B1); PG8_BAR; PG8_SCHED;
            PG8_LDA(At, 0, 1); PG8_STAGE(PG8_SB(0, 0), b2, voffB); PG8_STAGE(PG8_SB(0, 1), b2 + hstep, voffB); PG8_STAGE(PG8_SA(0, 0), a2, voffA);
            PG8_WAIT_V(8); PG8_WAIT_L(0); PG8_BAR; PG8_MMA(1, 0, At, B0); PG8_MMA(1, 1, At, B1); PG8_BAR; PG8_SCHED;
            PG8_LDB(B0, 1, 0); PG8_LDB(B1, 1, 1); PG8_SCHED; PG8_LDA(At, 1, 0); PG8_STAGE(PG8_SA(0, 1), a2 + hstep, voffA);
            PG8_WAIT_V(8); PG8_WAIT_L(0); PG8_BAR; PG8_MMA(0, 0, At, B0); PG8_MMA(0, 1, At, B1); PG8_BAR; PG8_SCHED;
            PG8_LDA(At, 1, 1); PG8_STAGE(PG8_SB(1, 0), b3, voffB); PG8_STAGE(PG8_SB(1, 1), b3 + hstep, voffB); PG8_STAGE(PG8_SA(1, 0), a3, voffA);
            PG8_WAIT_V(8); PG8_WAIT_L(0); PG8_BAR; PG8_MMA(1, 0, At, B0); PG8_MMA(1, 1, At, B1); PG8_BAR; PG8_SCHED;
            } else {
            PG8_LDB(B0, 0, 0); PG8_SCHED; PG8_LDA(At, 0, 0); PG8_STAGE(PG8_SA(1, 1), a1 + hstep, voffA);
            PG8_WAIT_L(8); PG8_BAR; PG8_WAIT_L(0); PG8_MMA(0, 0, At, B0); PG8_BAR; PG8_SCHED;
            PG8_LDB(B1, 0, 1); PG8_STAGE(PG8_SB(0, 0), b2, voffB);
            PG8_BAR; PG8_WAIT_L(0); PG8_MMA(0, 1, At, B1); PG8_BAR;
            PG8_LDA(At, 0, 1); PG8_STAGE(PG8_SA(0, 0), a2, voffA);
            PG8_BAR; PG8_WAIT_L(0); PG8_MMA(1, 0, At, B0); PG8_BAR; PG8_SCHED;
            PG8_STAGE(PG8_SB(0, 1), b2 + hstep, voffB);
            PG8_WAIT_V(6); PG8_BAR; PG8_MMA(1, 1, At, B1); PG8_BAR;
            PG8_LDB(B0, 1, 0); PG8_SCHED; PG8_LDA(At, 1, 0); PG8_STAGE(PG8_SA(0, 1), a2 + hstep, voffA);
            PG8_WAIT_L(8); PG8_BAR; PG8_WAIT_L(0); PG8_MMA(0, 0, At, B0); PG8_BAR; PG8_SCHED;
            PG8_LDB(B1, 1, 1); PG8_STAGE(PG8_SB(1, 0), b3, voffB);
            PG8_BAR; PG8_WAIT_L(0); PG8_MMA(0, 1, At, B1); PG8_BAR;
            PG8_LDA(At, 1, 1); PG8_STAGE(PG8_SA(1, 0), a3, voffA);
            PG8_BAR; PG8_WAIT_L(0); PG8_MMA(1, 0, At, B0); PG8_BAR; PG8_SCHED;
            PG8_STAGE(PG8_SB(1, 1), b3 + hstep, voffB);
            PG8_WAIT_V(6); PG8_BAR; PG8_MMA(1, 1, At, B1); PG8_BAR;
            }
        }
        if constexpr (FP8) asm volatile("s_nop 15\n\ts_nop 15" ::: "memory");
        if constexpr (ALIGN_EPI) { if (wr == 0) PG8_BAR; }
        if constexpr (!Epi::AFTER_DRAIN) { E(acc, cur, wr, wc, fr, fq); S.done(cur); }
        if (!has_next) break;
#pragma unroll
        for (int a = 0; a < 2; ++a)
#pragma unroll
            for (int b = 0; b < 2; ++b)
#pragma unroll
                for (int m = 0; m < 4; ++m)
#pragma unroll
                    for (int n = 0; n < 2; ++n) acc[a][b][m][n] = (f32x4){0.f, 0.f, 0.f, 0.f};
        cur = nxt; cA = nA; cB = nB; ++ui;
        if constexpr (ALIGN_EPI) { if (wr == 1) PG8_BAR; }
    }
    PG8_WAIT_V(0);
    if constexpr (!ALIGN_EPI) { if (wr == 0) PG8_BAR; }
    PG8_BAR;
    if constexpr (Epi::AFTER_DRAIN) { E.fused(acc, cur, wr, wc, fr, fq, lds, wid, lane); S.done(cur); }
#undef PG8_SA
#undef PG8_SB
#undef PG8_STAGE
#undef PG8_LDA
#undef PG8_LDB
#undef PG8_MMA
#undef PG8_WAIT_V
#undef PG8_WAIT_L
#undef PG8_BAR
#undef PG8_SCHED
}
}
#define GAS __attribute__((address_space(1)))
#define LAS __attribute__((address_space(3)))
typedef unsigned short bf16;
typedef unsigned v4u __attribute__((ext_vector_type(4)));
typedef float f32x4 __attribute__((ext_vector_type(4)));
typedef short bf16x8 __attribute__((ext_vector_type(8)));
typedef GAS unsigned gu32;
typedef GAS unsigned long long gu64;
#define RLX_AGENT __ATOMIC_RELAXED, __HIP_MEMORY_SCOPE_AGENT
#define LDS_WAIT() asm volatile("s_waitcnt lgkmcnt(0)" ::: "memory")
#define VM_WAIT() asm volatile("s_waitcnt vmcnt(0)" ::: "memory")
__device__ __forceinline__ unsigned long long rt() { return __builtin_amdgcn_s_memrealtime(); }
__device__ __forceinline__ unsigned f2bf(float f) { unsigned u = __builtin_bit_cast(unsigned, f); return (u + 0x7fffu + ((u >> 16) & 1u)) >> 16; }
typedef float pk_f32x2_t __attribute__((ext_vector_type(2))); typedef __bf16 pk_bf16x2_t __attribute__((ext_vector_type(2)));
__device__ __forceinline__ unsigned pk2(float lo, float hi) { const pk_f32x2_t v = {lo, hi}; return __builtin_bit_cast(unsigned, __builtin_convertvector(v, pk_bf16x2_t)); }

#define XB_TMO      128
#define XB_XCNT(j)  (256  + 64 * (j))
#define XB_XSUB(j)  (1280 + 64 * (j))
#define XB_XGEN(j)  (2304 + 64 * (j))
#define XB_TOP      3328
#define XB_TOPGEN   3392
#define XCD_BAR_WORDS 3456
#define XB_SPIN_CAP (1u << 18)

__device__ __forceinline__ unsigned xb_ld(unsigned* p)              { return __hip_atomic_load(p, __ATOMIC_RELAXED, __HIP_MEMORY_SCOPE_AGENT); }
__device__ __forceinline__ unsigned xb_add(unsigned* p, unsigned v) { return __hip_atomic_fetch_add(p, v, __ATOMIC_RELAXED, __HIP_MEMORY_SCOPE_AGENT); }
__device__ __forceinline__ unsigned xb_xcc_id() { return (unsigned)__builtin_amdgcn_s_getreg((3 << 11) | 20) & 0xFu; }
#define XB_SPIN(cond, bar) do { unsigned _sp = 0; while (cond) { __builtin_amdgcn_s_sleep(1); \
    if ((++_sp & 255u) == 0u) { if (xb_ld(&(bar)[XB_TMO])) break; if (_sp > XB_SPIN_CAP) { atomicAdd(&(bar)[XB_TMO], 1u); break; } } } } while (0)

struct XcdBarrier {
    unsigned* bar; unsigned x;
    volatile LAS unsigned* st;
};

__device__ __forceinline__ XcdBarrier xcd_barrier_post(unsigned* bar, volatile LAS unsigned* st) {
    XcdBarrier b; b.bar = bar; b.x = xb_xcc_id(); b.st = st;
    if (threadIdx.x == 0) (void)xb_add(&bar[XB_XCNT(b.x)], 1u);
    return b;
}
__device__ __forceinline__ void xcd_barrier_complete(unsigned* bar, unsigned x, unsigned& nloc, unsigned& nx) {
    const unsigned G = gridDim.x * gridDim.y * gridDim.z;
    unsigned sum, cnt, mine, sp = 0u;
    for (;;) {
        sum = 0u; cnt = 0u; mine = 0u;
#pragma unroll
        for (unsigned j = 0; j < 16; ++j) { const unsigned c = xb_ld(&bar[XB_XCNT(j)]); sum += c; cnt += (c > 0u) ? 1u : 0u; mine = (j == x) ? c : mine; }
        if (sum == G) break;
        __builtin_amdgcn_s_sleep(1);
        if ((++sp & 255u) == 0u) { if (xb_ld(&bar[XB_TMO])) break; if (sp > XB_SPIN_CAP) { atomicAdd(&bar[XB_TMO], 1u); break; } }
    }
    nloc = mine > 0u ? mine : 1u; nx = cnt > 0u ? cnt : 1u;
}

__device__ __forceinline__ void xcd_barrier(const XcdBarrier& b) {
    asm volatile("s_waitcnt vmcnt(0)" ::: "memory");
    __syncthreads();
    if (threadIdx.x == 0) {
        unsigned* bar = b.bar;
        __builtin_amdgcn_s_waitcnt(0);
        unsigned nloc = b.st[0], nx = b.st[1];
        if (nloc == 0u) { xcd_barrier_complete(bar, b.x, nloc, nx); b.st[0] = nloc; b.st[1] = nx; }
        const unsigned old = xb_add(&bar[XB_XSUB(b.x)], 1u);
        const unsigned gen = old / nloc;
        if (old + 1u == (gen + 1u) * nloc) {
            __builtin_amdgcn_fence(__ATOMIC_RELEASE, "agent");
            asm volatile("s_waitcnt vmcnt(0)" ::: "memory");
            const unsigned og = xb_add(&bar[XB_TOP], 1u);
            const unsigned tg = og / nx;
            if (og + 1u == (tg + 1u) * nx) xb_add(&bar[XB_TOPGEN], 1u);
            else XB_SPIN(xb_ld(&bar[XB_TOPGEN]) == tg, bar);
            __builtin_amdgcn_fence(__ATOMIC_ACQUIRE, "agent");
            xb_add(&bar[XB_XGEN(b.x)], 1u);
            asm volatile("s_waitcnt vmcnt(0)" ::: "memory");
        } else {
            XB_SPIN(xb_ld(&bar[XB_XGEN(b.x)]) == gen, bar);
            __builtin_amdgcn_fence(__ATOMIC_ACQUIRE, "agent");
            asm volatile("s_waitcnt vmcnt(0)" ::: "memory");
        }
    }
    __syncthreads();
}


constexpr int NWAVES = 8;
constexpr int NBATCH = 8, SEQ = 4096, M = NBATCH * SEQ, D = 1024, DIN = 2560, DA = 512, DL = 512, NH = 8, HD = 64;
constexpr int DFF = 2816, NE = 8, DFE = 3584;
constexpr int SORT_ROWS = 2 * M + NE * 256, NT_MAX = SORT_ROWS / 256;
constexpr int CHUNK_TILES = 128, NCHUNK = (NT_MAX + CHUNK_TILES - 1) / CHUNK_TILES;
constexpr float ALPHA = 1.4142135623730951f, LN_EPS = 1e-5f, RMS_EPS = 1e-6f;
constexpr float LOG2E = 1.4426950408889634f, QSCALE = 0.125f * LOG2E;
constexpr int PH_PRO = 0, PH_L0 = 1, PH_L1 = 9;
constexpr int PH_DISPATCH = 14, PH_MOE0 = 15, PH_COMBINE = PH_MOE0 + 2 * NCHUNK, NPH = PH_COMBINE + 1;
constexpr size_t MiB = 1u << 20;
constexpr size_t WS_CTL = 0, CTL_ZERO_BYTES = 1 * MiB;
constexpr size_t WS_TOKE = 1 * MiB, WS_TOKP = WS_TOKE + 256 * 1024, WS_TOKPOS = WS_TOKP + 256 * 1024, WS_SEG = WS_TOKPOS + 256 * 1024;
constexpr size_t WS_LRUW = 2 * MiB;
constexpr size_t WS_LSE = 3 * MiB, WS_AGG = 6 * MiB;
constexpr size_t WS_WIN = 8 * MiB, WS_WOUT = 18 * MiB, WS_WGU = 22 * MiB, WS_WD = 33 * MiB, WS_MGU = 39 * MiB, WS_MD = 95 * MiB;
constexpr size_t WS_XB = 207 * MiB;
constexpr size_t WS_Q = 271 * MiB, WS_K = 303 * MiB, WS_V = 335 * MiB, WS_U = 367 * MiB, WS_G = 399 * MiB;
constexpr size_t WS_O0 = 39 * MiB, WS_O1 = 71 * MiB, WS_O2 = 103 * MiB;
constexpr size_t WS_LA = 135 * MiB, WS_BE = 167 * MiB;
constexpr size_t WS_Y = WS_Q;
constexpr size_t WS_HB = 271 * MiB, WS_X8 = 359 * MiB;
constexpr int TAIL_KS = 512, TAIL_NS = DFE / TAIL_KS, TAIL_TILES = NT_MAX - (NCHUNK - 1) * CHUNK_TILES;
constexpr size_t WS_PART = 8 * MiB;
static_assert(WS_PART + (size_t)TAIL_NS * TAIL_TILES * 256 * D * 2 <= 39 * MiB, "tail partials");
constexpr size_t WS_HCA = 151 * MiB, WS_XS8 = 271 * MiB, WS_YS = 337 * MiB, WS_END = 469 * MiB;
constexpr float MOE_HSCALE = 8.0f, MOE_DSCALE = 128.0f;
constexpr float MOE_WSCALE = 32.0f;
static_assert(WS_MGU + (size_t)NE * 2 * DFE * D <= WS_MD && WS_MD + (size_t)NE * D * DFE <= WS_HCA && WS_HCA + (size_t)TAIL_TILES * 256 * DFE <= WS_XB && (size_t)CHUNK_TILES * 256 * DFE <= (size_t)M * D * 4 && WS_XS8 + (size_t)SORT_ROWS * D <= WS_YS && WS_YS + (size_t)SORT_ROWS * D * 2 <= WS_END, "d_ws map");
constexpr int CW_TMO = 0, CW_CODE = 1, CW_BAR = 4096;
constexpr unsigned long long PROBE_MASK = 0ull; constexpr unsigned PROBE_K = 8; constexpr int PROBE_SEAM = -1;
constexpr int RING_OFF = 0, RING_BYTES = 131072;
constexpr int LDSCTL_OFF = RING_BYTES, MISC_OFF = LDSCTL_OFF + 320;
constexpr int LDS_BYTES = 147456;

typedef int v4i __attribute__((ext_vector_type(4)));
typedef unsigned v2u __attribute__((ext_vector_type(2)));
typedef float f32x2 __attribute__((ext_vector_type(2)));
struct Frame {
    LAS unsigned char* lds;
    volatile LAS unsigned* MISC;
    gu32* ctl;
    int tid, lane, wave;
    int vcu, G;
    unsigned long long pt0, pacc;
};
__device__ __forceinline__ int fresh_lane() { int l; asm volatile("v_mbcnt_lo_u32_b32 %0, -1, 0\n\tv_mbcnt_hi_u32_b32 %0, -1, %0" : "=v"(l)); return l; }
struct Args { const float* in[24]; float* out; unsigned char* ws; int ph_lo, ph_hi, li, pad; };

__device__ __forceinline__ float wave_sum(float v) {
#pragma unroll
    for (int o = 1; o < 64; o <<= 1) v += __shfl_xor(v, o);
    return v;
}
__device__ __forceinline__ float bf2f(bf16 h) { return __uint_as_float((unsigned)h << 16); }
__device__ __forceinline__ float bflo(unsigned w) { return __uint_as_float(w << 16); }
__device__ __forceinline__ float bfhi(unsigned w) { return __uint_as_float(w & 0xffff0000u); }

__device__ __forceinline__ void transpose_item(const float* W, int N, bf16* WT, int ldt, int dst_row0, LAS float* scr, int kb, int nb, int lane) {
    const int k0 = 64 * kb, n0 = 32 * nb;
    f32x4 v[8];
#pragma unroll
    for (int i = 0; i < 8; ++i) v[i] = *(const GAS f32x4*)(W + (size_t)(k0 + 8 * i + (lane >> 3)) * N + n0 + 4 * (lane & 7));
#pragma unroll
    for (int i = 0; i < 8; ++i) { LAS float* d = scr + (8 * i + (lane >> 3)) * 33 + 4 * (lane & 7); d[0] = v[i].x; d[1] = v[i].y; d[2] = v[i].z; d[3] = v[i].w; }
    LDS_WAIT(); asm volatile("" ::: "memory");
    const int c = lane & 7;
#pragma unroll
    for (int j = 0; j < 4; ++j) { const int n = (lane >> 3) + 8 * j; const LAS float* s = scr + (8 * c) * 33 + n;
        v4u o; o.x = pk2(s[0 * 33], s[1 * 33]); o.y = pk2(s[2 * 33], s[3 * 33]); o.z = pk2(s[4 * 33], s[5 * 33]); o.w = pk2(s[6 * 33], s[7 * 33]);
        *(GAS v4u*)(WT + (size_t)(dst_row0 + n) * ldt + k0 + 8 * c) = o; }
    LDS_WAIT(); asm volatile("" ::: "memory");
}
__device__ __forceinline__ unsigned pk4_fp8(float a, float b, float c, float d) {
    a = __builtin_fminf(__builtin_fmaxf(a, -448.f), 448.f); b = __builtin_fminf(__builtin_fmaxf(b, -448.f), 448.f); c = __builtin_fminf(__builtin_fmaxf(c, -448.f), 448.f); d = __builtin_fminf(__builtin_fmaxf(d, -448.f), 448.f);
    unsigned w = 0u; w = __builtin_amdgcn_cvt_pk_fp8_f32(a, b, w, false); w = __builtin_amdgcn_cvt_pk_fp8_f32(c, d, w, true); return w;
}
__device__ __forceinline__ void transpose_item_fp8(const float* W, int N, unsigned char* WT8, int ldt, int dst_row0, LAS float* scr, int kb, int nb, int lane, float scale) {
    const int k0 = 64 * kb, n0 = 32 * nb;
    f32x4 v[8];
#pragma unroll
    for (int i = 0; i < 8; ++i) v[i] = *(const GAS f32x4*)(W + (size_t)(k0 + 8 * i + (lane >> 3)) * N + n0 + 4 * (lane & 7));
#pragma unroll
    for (int i = 0; i < 8; ++i) { LAS float* d = scr + (8 * i + (lane >> 3)) * 33 + 4 * (lane & 7); d[0] = v[i].x * scale; d[1] = v[i].y * scale; d[2] = v[i].z * scale; d[3] = v[i].w * scale; }
    LDS_WAIT(); asm volatile("" ::: "memory");
    const int c = lane & 3;
#pragma unroll
    for (int j = 0; j < 2; ++j) { const int n = (lane >> 2) + 16 * j; const LAS float* s = scr + (16 * c) * 33 + n;
        v4u o; o.x = pk4_fp8(s[0 * 33], s[1 * 33], s[2 * 33], s[3 * 33]); o.y = pk4_fp8(s[4 * 33], s[5 * 33], s[6 * 33], s[7 * 33]);
        o.z = pk4_fp8(s[8 * 33], s[9 * 33], s[10 * 33], s[11 * 33]); o.w = pk4_fp8(s[12 * 33], s[13 * 33], s[14 * 33], s[15 * 33]);
        *(GAS v4u*)(WT8 + (size_t)(dst_row0 + n) * ldt + k0 + 16 * c) = o; }
    LDS_WAIT(); asm volatile("" ::: "memory");
}
__device__ __forceinline__ void tr_gu8(const float* W, int K, int N, unsigned char* WT8, int half, LAS float* scr, int item, int lane, float scale) {
    const int nblk = N / 32, kb = item / nblk, nb = item % nblk, n0 = 32 * nb; transpose_item_fp8(W, N, WT8, K, (n0 >> 7) * 256 + half * 128 + (n0 & 127), scr, kb, nb, lane, scale);
}
__device__ __forceinline__ void tr_plain8(const float* W, int K, int N, unsigned char* WT8, LAS float* scr, int item, int lane, float scale) {
    const int nblk = N / 32, kb = item / nblk, nb = item % nblk; transpose_item_fp8(W, N, WT8, K, 32 * nb, scr, kb, nb, lane, scale);
}
__device__ __forceinline__ void tr_plain(const float* W, int K, int N, bf16* WT, LAS float* scr, int item, int lane) {
    const int nblk = N / 32, kb = item / nblk, nb = item % nblk; transpose_item(W, N, WT, K, 32 * nb, scr, kb, nb, lane);
}
__device__ __forceinline__ void tr_gu(const float* W, int K, int N, bf16* WT, int half, LAS float* scr, int item, int lane) {
    const int nblk = N / 32, kb = item / nblk, nb = item % nblk, n0 = 32 * nb; transpose_item(W, N, WT, K, (n0 >> 7) * 256 + half * 128 + (n0 & 127), scr, kb, nb, lane);
}

__device__ __forceinline__ void phase_prologue(Frame& F, const Args& a) {
    LAS float* scr = (LAS float*)(F.lds + RING_OFF + F.wave * 16384);
    const int gw = F.vcu * NWAVES + F.wave, NGW = F.G * NWAVES;
    unsigned char* ws = a.ws;
    constexpr int I_WIN = (D / 64) * (DIN / 32), I_WOUT = (D / 64) * (D / 32), I_GU = (D / 64) * (DFF / 32), I_DN = (DFF / 64) * (D / 32), I_LRU = 64;
    constexpr int NITEMS = 2 * I_WIN + 2 * I_WOUT + 2 * I_GU + I_DN + I_LRU;
    for (int it = gw; it < NITEMS; it += NGW) {
        int r = it;
        if (r < 2 * I_WIN) { const int l = r / I_WIN; r -= l * I_WIN; tr_plain(a.in[1] + (size_t)l * D * DIN, D, DIN, (bf16*)(ws + WS_WIN) + (size_t)l * DIN * D, scr, r, F.lane); continue; } r -= 2 * I_WIN;
        if (r < 2 * I_WOUT) { const int l = r / I_WOUT; r -= l * I_WOUT; tr_plain(a.in[12] + (size_t)l * D * D, D, D, (bf16*)(ws + WS_WOUT) + (size_t)l * D * D, scr, r, F.lane); continue; } r -= 2 * I_WOUT;
        if (r < I_GU) { tr_gu(a.in[17], D, DFF, (bf16*)(ws + WS_WGU), 0, scr, r, F.lane); continue; } r -= I_GU;
        if (r < I_GU) { tr_gu(a.in[18], D, DFF, (bf16*)(ws + WS_WGU), 1, scr, r, F.lane); continue; } r -= I_GU;
        if (r < I_DN) { tr_plain8(a.in[19], DFF, D, ws + WS_WD, scr, r, F.lane, MOE_DSCALE); continue; } r -= I_DN;
        { const int mi = r >> 1, it2 = r & 1, l = mi >> 4, gate = (mi >> 3) & 1, g = mi & 7;
          const float* src = (gate ? a.in[6] : a.in[4]) + (size_t)(l * 8 + g) * 4096; tr_plain(src, 64, 64, (bf16*)(ws + WS_LRUW) + (size_t)mi * 4096, scr, it2, F.lane); }
    }
    const float* x = a.in[0]; bf16* XBp = (bf16*)(ws + WS_XB);
    for (int m = gw; m < M; m += NGW) {
        const GAS f32x4* xr = (const GAS f32x4*)(x + (size_t)m * D) + F.lane; GAS unsigned long long* o8 = (GAS unsigned long long*)(XBp + (size_t)m * D) + F.lane;
#pragma unroll
        for (int j = 0; j < 4; ++j) { const f32x4 v = xr[64 * j]; o8[64 * j] = (unsigned long long)pk2(v.x, v.y) | ((unsigned long long)pk2(v.z, v.w) << 32); }
    }
}
__device__ __forceinline__ void phase_moe_cvt(Frame& F, const Args& a) {
    LAS float* scr = (LAS float*)(F.lds + RING_OFF + 32768 + F.wave * 8704);
    const int gw = F.vcu * NWAVES + F.wave, NGW = F.G * NWAVES;
    constexpr int I_MG = (D / 64) * (DFE / 32), I_MD = (DFE / 64) * (D / 32), I_E = 2 * I_MG + I_MD;
    for (int it = gw; it < NE * I_E; it += NGW) {
        const int e = it / I_E; int r = it - e * I_E;
        unsigned char* gu = a.ws + WS_MGU + (size_t)e * (2 * DFE) * D; unsigned char* dn = a.ws + WS_MD + (size_t)e * D * DFE;
        if (r < I_MG) { tr_gu8(a.in[21] + (size_t)e * D * DFE, D, DFE, gu, 0, scr, r, F.lane, MOE_WSCALE); continue; } r -= I_MG;
        if (r < I_MG) { tr_gu8(a.in[22] + (size_t)e * D * DFE, D, DFE, gu, 1, scr, r, F.lane, MOE_WSCALE); continue; } r -= I_MG;
        tr_plain8(a.in[23] + (size_t)e * DFE * D, DFE, D, dn, scr, r, F.lane, MOE_DSCALE);
    }
}
template <bool ROUTE>
__device__ __forceinline__ void phase_ln(Frame& F, bf16* XBp, const float* g, const float* b, const float* rw, int* tok_e, float* tok_p, unsigned char* X8 = nullptr) {
    const int gw = F.vcu * NWAVES + F.wave, NGW = F.G * NWAVES;
    LAS f32x4* rws = (LAS f32x4*)(F.lds + RING_OFF);
    if (ROUTE) { for (int i = F.tid; i < 2048; i += NWAVES * 64) rws[i] = ((const GAS f32x4*)rw)[i]; LDS_WAIT(); __syncthreads(); }
    f32x4 gv[4], bv[4];
#pragma unroll
    for (int j = 0; j < 2; ++j) { gv[2 * j] = ((const GAS f32x4*)g)[2 * F.lane + 128 * j]; gv[2 * j + 1] = ((const GAS f32x4*)g)[2 * F.lane + 128 * j + 1]; bv[2 * j] = ((const GAS f32x4*)b)[2 * F.lane + 128 * j]; bv[2 * j + 1] = ((const GAS f32x4*)b)[2 * F.lane + 128 * j + 1]; }
    v4u nx[2], ny[2];
    { const GAS v4u* xr = (const GAS v4u*)(XBp + (size_t)(gw < M ? gw : 0) * D) + F.lane; nx[0] = xr[0]; nx[1] = xr[64]; }
    { const int m1 = (gw + NGW < M) ? gw + NGW : 0; const GAS v4u* xr = (const GAS v4u*)(XBp + (size_t)m1 * D) + F.lane; ny[0] = xr[0]; ny[1] = xr[64]; }
    for (int m = gw; m < M; m += NGW) {
        const v4u r0 = nx[0], r1 = nx[1];
        nx[0] = ny[0]; nx[1] = ny[1];
        { const int mn = (m + 2 * NGW < M) ? m + 2 * NGW : m; const GAS v4u* xr = (const GAS v4u*)(XBp + (size_t)mn * D) + F.lane; ny[0] = xr[0]; ny[1] = xr[64]; }
        f32x4 v[4];
        v[0] = (f32x4){bflo(r0.x), bfhi(r0.x), bflo(r0.y), bfhi(r0.y)}; v[1] = (f32x4){bflo(r0.z), bfhi(r0.z), bflo(r0.w), bfhi(r0.w)};
        v[2] = (f32x4){bflo(r1.x), bfhi(r1.x), bflo(r1.y), bfhi(r1.y)}; v[3] = (f32x4){bflo(r1.z), bfhi(r1.z), bflo(r1.w), bfhi(r1.w)};
        float s = 0.f;
#pragma unroll
        for (int j = 0; j < 4; ++j) s += (v[j].x + v[j].y) + (v[j].z + v[j].w);
        const float mean = wave_sum(s) * (1.f / D); float s2 = 0.f;
#pragma unroll
        for (int j = 0; j < 4; ++j) { v[j] = v[j] - mean; s2 += (v[j].x * v[j].x + v[j].y * v[j].y) + (v[j].z * v[j].z + v[j].w * v[j].w); }
        const float rstd = 1.f / sqrtf(wave_sum(s2) * (1.f / D) + LN_EPS);
#pragma unroll
        for (int j = 0; j < 4; ++j) v[j] = v[j] * rstd * gv[j] + bv[j];
        GAS v4u* xw = (GAS v4u*)(XBp + (size_t)m * D) + F.lane;
        xw[0] = (v4u){pk2(v[0].x, v[0].y), pk2(v[0].z, v[0].w), pk2(v[1].x, v[1].y), pk2(v[1].z, v[1].w)};
        xw[64] = (v4u){pk2(v[2].x, v[2].y), pk2(v[2].z, v[2].w), pk2(v[3].x, v[3].y), pk2(v[3].z, v[3].w)};
        if (X8) { GAS v2u* x8 = (GAS v2u*)(X8 + (size_t)m * D) + F.lane;
            x8[0] = (v2u){pk4_fp8(v[0].x, v[0].y, v[0].z, v[0].w), pk4_fp8(v[1].x, v[1].y, v[1].z, v[1].w)}; x8[64] = (v2u){pk4_fp8(v[2].x, v[2].y, v[2].z, v[2].w), pk4_fp8(v[3].x, v[3].y, v[3].z, v[3].w)}; }
        if (ROUTE) {
            f32x4 la = {0.f, 0.f, 0.f, 0.f}, lb = {0.f, 0.f, 0.f, 0.f};
#pragma unroll
            for (int j = 0; j < 4; ++j)
#pragma unroll
                for (int i = 0; i < 4; ++i) { const int c = 8 * F.lane + 512 * (j >> 1) + 4 * (j & 1) + i; const f32x4 w0 = rws[2 * c], w1 = rws[2 * c + 1]; la += w0 * v[j][i]; lb += w1 * v[j][i]; }
            float lg[8];
            lg[0] = wave_sum(la.x); lg[1] = wave_sum(la.y); lg[2] = wave_sum(la.z); lg[3] = wave_sum(la.w); lg[4] = wave_sum(lb.x); lg[5] = wave_sum(lb.y); lg[6] = wave_sum(lb.z); lg[7] = wave_sum(lb.w);
            int e0 = 0; float v0 = lg[0];
#pragma unroll
            for (int e = 1; e < 8; ++e) if (lg[e] > v0) { v0 = lg[e]; e0 = e; }
            int e1 = -1; float v1 = -INFINITY;
#pragma unroll
            for (int e = 0; e < 8; ++e) if (e != e0 && lg[e] > v1) { v1 = lg[e]; e1 = e; }
            if (F.lane == 0) { const float p1 = expf(v1 - v0), den = 1.f + p1; tok_e[2 * m] = e0; tok_e[2 * m + 1] = e1; tok_p[2 * m] = 1.f / den; tok_p[2 * m + 1] = p1 / den; }
        }
    }
}
__device__ __forceinline__ void phase_dispatch(Frame& F, const int* tok_e, int* tok_pos, int* segtab, const bf16* XBp, unsigned char* XS8) {
    LAS int* s_tot = (LAS int*)(F.lds + RING_OFF); LAS int* s_bef = s_tot + 8; LAS int* s_w = s_tot + 16; LAS int* s_pos = s_tot + 32;
    for (int tile = blockIdx.x; tile < M / 128; tile += F.G) {
        __syncthreads();
        if (F.tid < 32) s_tot[F.tid] = 0;
        __syncthreads();
        int tot[8], bef[8];
#pragma unroll
        for (int e = 0; e < 8; ++e) { tot[e] = 0; bef[e] = 0; }
        const GAS v4i* te4 = (const GAS v4i*)tok_e;
        for (int i4 = F.tid; i4 < 2 * M / 4; i4 += NWAVES * 64) { const v4i ev = te4[i4]; const int before = (2 * i4 < tile * 128) ? 1 : 0;
#pragma unroll
            for (int e = 0; e < 8; ++e) { const int hit = (ev.x == e) + (ev.y == e) + (ev.z == e) + (ev.w == e); tot[e] += hit; bef[e] += before ? hit : 0; } }
#pragma unroll
        for (int e = 0; e < 8; ++e) { int a = tot[e], b = bef[e];
#pragma unroll
            for (int o = 1; o < 64; o <<= 1) { a += __shfl_xor(a, o); b += __shfl_xor(b, o); }
            if (F.lane == 0) { __hip_atomic_fetch_add(&s_tot[e], a, __ATOMIC_RELAXED, __HIP_MEMORY_SCOPE_WORKGROUP); __hip_atomic_fetch_add(&s_bef[e], b, __ATOMIC_RELAXED, __HIP_MEMORY_SCOPE_WORKGROUP); } }
        int e0 = -1, e1 = -1, rk0 = 0, rk1 = 0; const int tok = tile * 128 + F.tid;
        if (F.wave < 2) { e0 = tok_e[2 * tok]; e1 = tok_e[2 * tok + 1];
#pragma unroll
            for (int e = 0; e < 8; ++e) { const bool has = (e0 == e) || (e1 == e); const unsigned long long mask = __ballot(has); const int rk = __popcll(mask & ((1ull << F.lane) - 1ull));
                if (e0 == e) rk0 = rk; if (e1 == e) rk1 = rk; if (F.lane == 0) s_w[F.wave * 8 + e] = __popcll(mask); } }
        LDS_WAIT(); __syncthreads();
        int seg[9]; seg[0] = 0;
#pragma unroll
        for (int e = 0; e < 8; ++e) seg[e + 1] = seg[e] + ((s_tot[e] + 255) & ~255);
        if (F.wave < 2) { int p0 = 0, p1 = 0;
#pragma unroll
            for (int e = 0; e < 8; ++e) { const int wp = (F.wave == 1) ? s_w[e] : 0; if (e0 == e) p0 = seg[e] + s_bef[e] + wp + rk0; if (e1 == e) p1 = seg[e] + s_bef[e] + wp + rk1; }
            tok_pos[2 * tok] = p0; tok_pos[2 * tok + 1] = p1; s_pos[2 * F.tid] = p0; s_pos[2 * F.tid + 1] = p1; }
        if (tile == 0) {
#pragma unroll
            for (int k = 0; k < 9; ++k) if (F.tid == k) segtab[k] = seg[k] >> 8;
        }
        LDS_WAIT(); __syncthreads();
        for (int i0 = F.wave * 16; i0 < F.wave * 16 + 16; i0 += 4) { v4u ra[4], rb[4];
#pragma unroll
            for (int j = 0; j < 4; ++j) { const GAS v4u* src = (const GAS v4u*)(XBp + (size_t)(tile * 128 + i0 + j) * D) + F.lane; ra[j] = src[0]; rb[j] = src[64]; }
#pragma unroll
            for (int j = 0; j < 4; ++j) { const int p0 = s_pos[2 * (i0 + j)], p1 = s_pos[2 * (i0 + j) + 1];
                v2u qa, qb;
                qa.x = pk4_fp8(bflo(ra[j].x), bfhi(ra[j].x), bflo(ra[j].y), bfhi(ra[j].y)); qa.y = pk4_fp8(bflo(ra[j].z), bfhi(ra[j].z), bflo(ra[j].w), bfhi(ra[j].w));
                qb.x = pk4_fp8(bflo(rb[j].x), bfhi(rb[j].x), bflo(rb[j].y), bfhi(rb[j].y)); qb.y = pk4_fp8(bflo(rb[j].z), bfhi(rb[j].z), bflo(rb[j].w), bfhi(rb[j].w));
                GAS v2u* d0 = (GAS v2u*)(XS8 + (size_t)p0 * D) + F.lane; d0[0] = qa; d0[64] = qb;
                GAS v2u* d1 = (GAS v2u*)(XS8 + (size_t)p1 * D) + F.lane; d1[0] = qa; d1[64] = qb; } }
    }
}
__device__ __forceinline__ void phase_combine(Frame& F, const bf16* XBp, float* outp, const bf16* YS, const int* tok_pos, const float* tok_p, const float* g, const float* b, const bf16* PART, const int mode, const int tail_row0, const int gw, const int NGW) {
    f32x4 gv[4], bv[4];
#pragma unroll
    for (int j = 0; j < 4; ++j) { gv[j] = ((const GAS f32x4*)g)[F.lane + 64 * j]; bv[j] = ((const GAS f32x4*)b)[F.lane + 64 * j]; }
    for (int m = gw; m < M; m += NGW) {
        const int p0 = __builtin_amdgcn_readfirstlane(tok_pos[2 * m]), p1 = __builtin_amdgcn_readfirstlane(tok_pos[2 * m + 1]);
        const bool in_tail = (p0 >= tail_row0) || (p1 >= tail_row0);
        if ((mode == 1 && in_tail) || (mode == 2 && !in_tail)) continue;
        const float w0 = tok_p[2 * m], w1 = tok_p[2 * m + 1];
        const GAS v2u* xr = (const GAS v2u*)(XBp + (size_t)m * D) + F.lane;
        const GAS v2u* y0 = (const GAS v2u*)(YS + (size_t)p0 * D) + F.lane; const GAS v2u* y1 = (const GAS v2u*)(YS + (size_t)p1 * D) + F.lane;
        f32x4 v[4]; float s = 0.f;
#pragma unroll
        for (int j = 0; j < 4; ++j) { const v2u x = xr[64 * j]; f32x4 ya, yc;
            if (p0 >= tail_row0) { ya = (f32x4){0.f, 0.f, 0.f, 0.f};
#pragma unroll
                for (int ks = 0; ks < TAIL_NS; ++ks) { const v2u q = ((const GAS v2u*)(PART + ((size_t)ks * TAIL_TILES * 256 + (p0 - tail_row0)) * D) + F.lane)[64 * j]; ya += (f32x4){bflo(q.x), bfhi(q.x), bflo(q.y), bfhi(q.y)}; } }
            else { const v2u q = y0[64 * j]; ya = (f32x4){bflo(q.x), bfhi(q.x), bflo(q.y), bfhi(q.y)}; }
            if (p1 >= tail_row0) { yc = (f32x4){0.f, 0.f, 0.f, 0.f};
#pragma unroll
                for (int ks = 0; ks < TAIL_NS; ++ks) { const v2u q = ((const GAS v2u*)(PART + ((size_t)ks * TAIL_TILES * 256 + (p1 - tail_row0)) * D) + F.lane)[64 * j]; yc += (f32x4){bflo(q.x), bfhi(q.x), bflo(q.y), bfhi(q.y)}; } }
            else { const v2u q = y1[64 * j]; yc = (f32x4){bflo(q.x), bfhi(q.x), bflo(q.y), bfhi(q.y)}; }
            v[j].x = ALPHA * bflo(x.x) + (w0 * ya.x + w1 * yc.x); v[j].y = ALPHA * bfhi(x.x) + (w0 * ya.y + w1 * yc.y);
            v[j].z = ALPHA * bflo(x.y) + (w0 * ya.z + w1 * yc.z); v[j].w = ALPHA * bfhi(x.y) + (w0 * ya.w + w1 * yc.w);
            s += (v[j].x + v[j].y) + (v[j].z + v[j].w); }
        const float mean = wave_sum(s) * (1.f / D); float s2 = 0.f;
#pragma unroll
        for (int j = 0; j < 4; ++j) { v[j] = v[j] - mean; s2 += (v[j].x * v[j].x + v[j].y * v[j].y) + (v[j].z * v[j].z + v[j].w * v[j].w); }
        const float rstd = 1.f / sqrtf(wave_sum(s2) * (1.f / D) + LN_EPS);
        GAS f32x4* ow = (GAS f32x4*)(outp + (size_t)m * D) + F.lane;
#pragma unroll
        for (int j = 0; j < 4; ++j) ow[64 * j] = v[j] * rstd * gv[j] + bv[j];
    }
}

namespace att {
typedef float f32x16 __attribute__((ext_vector_type(16)));
typedef short s16x4 __attribute__((ext_vector_type(4)));
constexpr int NTASK = NBATCH * NH * 48;
constexpr int K_PITCH = 144, V_OFF = 384 * K_PITCH, V_DBS = 384 * 64 + 64, BIAS_OFF = V_OFF + 2 * V_DBS, TAB_OFF = BIAS_OFF + 528, NEG_OFF = TAB_OFF + 5 * 4 * 64 * 16, ATT_LDS = NEG_OFF + 4 * 64 * 16;
static_assert(ATT_LDS <= RING_BYTES && (TAB_OFF % 16) == 0, "attention LDS");
__device__ __forceinline__ int t5_bucket(int dist) {
    if (dist < 16) return dist;
    int b = 16;
    b += dist >= 22; b += dist >= 30; b += dist >= 40; b += dist >= 54; b += dist >= 73; b += dist >= 99; b += dist >= 134; b += dist >= 182;
    b += dist >= 246; b += dist >= 332; b += dist >= 450; b += dist >= 609; b += dist >= 825; b += dist >= 1117; b += dist >= 1513;
    return b;
}
__device__ __forceinline__ s16x4 vtr(LAS const unsigned char* p) { typedef short v4i16_t __attribute__((ext_vector_type(4))); return __builtin_bit_cast(s16x4, __builtin_amdgcn_ds_read_tr16_b64_v4i16((LAS v4i16_t*)p)); }
struct Task { int head, p, b, r, k, dil; };
__device__ __forceinline__ Task decode(int n, int head) { Task t; t.head = head; t.p = n >> 7; t.b = (n >> 4) & 7; const int q16 = n & 15, npair = 16 >> (2 * t.p); t.r = q16 / npair; t.k = q16 - t.r * npair; t.dil = 1 << (2 * t.p); return t; }

#define PBR(k) do { if (PROBE_MASK >> 32) { const unsigned long long t_ = rt(); if ((PROBE_MASK >> (k)) & 1ull) F.pacc += t_ - F.pt0; F.pt0 = t_; } } while (0)
__device__ __forceinline__ void attn_phase(Frame& F, const bf16* Qg, const bf16* Kg, const bf16* Vg, const float* rel_bias, bf16* O0, bf16* O1, bf16* O2, float* LSE) {
    LAS unsigned char* lds = F.lds + RING_OFF;
    LAS float* bias_l = (LAS float*)(lds + BIAS_OFF);
    LAS f32x4* tab = (LAS f32x4*)(lds + TAB_OFF);
    const int w = F.wave, l = F.lane, q_rel = l & 31, hh = l >> 5;
    const int head = (int)blockIdx.x & 7, jwg = (int)blockIdx.x >> 3, nwg = (F.G + 7 - head) >> 3;
    const int T0 = jwg, T1 = NTASK / 8;
    v4u kreg[6], vreg[6]; bf16x8 qn[4];
    int cur_hp = -1;
#define ATT_LOAD(T_) do { const Task t_ = decode(T_, head); const size_t rb_ = (size_t)t_.b * SEQ * DA + t_.head * HD; \
        _Pragma("unroll") for (int n = 0; n < 6; ++n) { const int ci = F.tid + 512 * n, kk = ci >> 3, c = ci & 7, li = 256 * t_.k - 128 + kk; \
            const bool ok_ = li >= 0; const size_t off = rb_ + (size_t)((ok_ ? li : 0) * t_.dil + t_.r) * DA + c * 8;     \
            const v4u kx_ = *(const GAS v4u*)(Kg + off), vx_ = *(const GAS v4u*)(Vg + off); kreg[n] = ok_ ? kx_ : (v4u){0u, 0u, 0u, 0u}; vreg[n] = ok_ ? vx_ : (v4u){0u, 0u, 0u, 0u}; } \
        const bf16* qp_ = Qg + rb_ + (size_t)((256 * t_.k + 32 * w + q_rel) * t_.dil + t_.r) * DA + 8 * hh; \
        _Pragma("unroll") for (int s = 0; s < 4; ++s) qn[s] = *(const GAS bf16x8*)(qp_ + 16 * s); } while (0)
    if (T0 < T1) ATT_LOAD(T0);
    for (int T = T0; T < T1; T += nwg) {
        const Task t = decode(T, head);
        const int hp = t.p;
        if (PROBE_MASK >> 32) F.pt0 = rt();
        __syncthreads();
#pragma unroll
        for (int n = 0; n < 6; ++n) { const int ci = F.tid + 512 * n, kk = ci >> 3, c = ci & 7;
            *(LAS v4u*)(lds + kk * K_PITCH + c * 16) = kreg[n];
            *(LAS v4u*)(lds + V_OFF + (c >> 2) * V_DBS + kk * 64 + (c & 3) * 16) = vreg[n]; }
        bf16x8 qf[4];
#pragma unroll
        for (int s = 0; s < 4; ++s) qf[s] = qn[s];
        if (hp != cur_hp) {
            if (F.tid < 129) bias_l[F.tid] = rel_bias[t5_bucket(F.tid * t.dil) * NH + t.head] * LOG2E;
            LDS_WAIT(); __syncthreads();
            for (int idx = F.tid; idx < 5 * 4 * 64; idx += NWAVES * 64) { const int ln = idx & 63, e4 = (idx >> 6) & 3, i = idx >> 8, qr = ln & 31, h2 = ln >> 5;
                f32x4 tv;
#pragma unroll
                for (int j = 0; j < 4; ++j) { const int k_rel = j + 8 * e4 + 4 * h2; int delta = 128 - 32 * i + qr - k_rel; const bool ok = (i != 0 || k_rel >= qr) && (i != 4 || k_rel <= qr);
                    delta = delta < 0 ? 0 : (delta > 128 ? 128 : delta); tv[j] = ok ? bias_l[delta] : -1e30f; }
                tab[idx] = tv; }
            for (int idx = F.tid; idx < 4 * 64; idx += NWAVES * 64) ((LAS f32x4*)(lds + NEG_OFF))[idx] = (f32x4){-1e30f, -1e30f, -1e30f, -1e30f};
            cur_hp = hp;
        }
        LDS_WAIT(); __syncthreads();
        PBR(32);
        if (T + nwg < T1) ATT_LOAD(T + nwg);
        f32x16 st[5];
        const LAS unsigned char* kbase = lds + (32 * w + q_rel) * K_PITCH + 16 * hh;
        const LAS f32x4* negt = (const LAS f32x4*)(lds + NEG_OFF) + l;
        float mx = -1e30f;
#pragma unroll
        for (int i = 0; i < 5; ++i) {
            const LAS f32x4* tp = (t.k == 0 && w + i < 4) ? negt : tab + (i * 4) * 64 + l;
#pragma unroll
            for (int e4 = 0; e4 < 4; ++e4) { const f32x4 tv = tp[e4 * 64];
#pragma unroll
                for (int j = 0; j < 4; ++j) st[i][4 * e4 + j] = tv[j]; }
#pragma unroll
            for (int s = 0; s < 4; ++s) { const bf16x8 kf = *(const LAS bf16x8*)(kbase + i * (32 * K_PITCH) + s * 32); st[i] = __builtin_amdgcn_mfma_f32_32x32x16_bf16(kf, qf[s], st[i], 0, 0, 0); }
        }
#pragma unroll
        for (int i = 0; i < 5; ++i)
#pragma unroll
            for (int e = 0; e < 16; ++e) mx = fmaxf(mx, st[i][e]);
        mx = fmaxf(mx, __shfl_xor(mx, 32));
        PBR(33);
        float ls[5];
#pragma unroll
        for (int i = 0; i < 5; ++i) { float a0 = 0.f, a1 = 0.f;
#pragma unroll
            for (int e = 0; e < 16; e += 2) { const float p0 = __builtin_amdgcn_exp2f(st[i][e] - mx), p1 = __builtin_amdgcn_exp2f(st[i][e + 1] - mx); st[i][e] = p0; st[i][e + 1] = p1; a0 += p0; a1 += p1; }
            ls[i] = a0 + a1; }
        float lsum = (ls[0] + ls[1]) + (ls[2] + ls[3]) + ls[4];
        lsum += __shfl_xor(lsum, 32);
        PBR(34);
        f32x16 o[2];
#pragma unroll
        for (int e = 0; e < 16; ++e) { o[0][e] = 0.f; o[1][e] = 0.f; }
        const LAS unsigned char* vb = lds + V_OFF + (32 * w + 4 * hh + ((l & 15) >> 2)) * 64 + (16 * ((l >> 4) & 1) + 4 * (l & 3)) * 2;
#pragma unroll
        for (int i = 0; i < 5; ++i)
#pragma unroll
            for (int s2 = 0; s2 < 2; ++s2) {
                v4u pw; pw.x = pk2(st[i][8 * s2 + 0], st[i][8 * s2 + 1]); pw.y = pk2(st[i][8 * s2 + 2], st[i][8 * s2 + 3]);
                pw.z = pk2(st[i][8 * s2 + 4], st[i][8 * s2 + 5]); pw.w = pk2(st[i][8 * s2 + 6], st[i][8 * s2 + 7]);
                const bf16x8 pf = __builtin_bit_cast(bf16x8, pw);
#pragma unroll
                for (int db = 0; db < 2; ++db) { const s16x4 lo = vtr(vb + db * V_DBS + i * 2048 + s2 * 1024), hi = vtr(vb + db * V_DBS + i * 2048 + s2 * 1024 + 512);
                    const bf16x8 vf = (bf16x8){lo[0], lo[1], lo[2], lo[3], hi[0], hi[1], hi[2], hi[3]};
                    o[db] = __builtin_amdgcn_mfma_f32_32x32x16_bf16(vf, pf, o[db], 0, 0, 0); }
            }
        PBR(35);
        const float inv = 1.0f / lsum;
        const size_t rowbase = (size_t)t.b * SEQ * DA + t.head * HD; const int qtok = (256 * t.k + 32 * w + q_rel) * t.dil + t.r;
        bf16* Op = (t.p == 0) ? O0 : (t.p == 1) ? O1 : O2;
        bf16* orow = Op + rowbase + (size_t)qtok * DA + 8 * hh;
#pragma unroll
        for (int db = 0; db < 2; ++db)
#pragma unroll
            for (int g = 0; g < 4; g += 2) {
                unsigned ax = pk2(o[db][4 * g] * inv, o[db][4 * g + 1] * inv), ay = pk2(o[db][4 * g + 2] * inv, o[db][4 * g + 3] * inv);
                unsigned bx = pk2(o[db][4 * g + 4] * inv, o[db][4 * g + 5] * inv), by = pk2(o[db][4 * g + 6] * inv, o[db][4 * g + 7] * inv);
                { const auto r = __builtin_amdgcn_permlane32_swap(ax, bx, false, false); ax = r[0]; bx = r[1]; }
                { const auto r = __builtin_amdgcn_permlane32_swap(ay, by, false, false); ay = r[0]; by = r[1]; }
                *(GAS v4u*)(orow + 32 * db + 8 * g) = (v4u){ax, ay, bx, by}; }
        if (hh == 0) LSE[((size_t)t.p * M + (size_t)t.b * SEQ + qtok) * NH + t.head] = mx + __builtin_amdgcn_logf(lsum);
        PBR(36);
    }
#undef ATT_LOAD
}
__device__ __forceinline__ void merge_attn_phase(Frame& F, const bf16* O0, const bf16* O1, const bf16* O2, const float* LSE, const float* g_attn, bf16* Y) {
    const int gw = F.vcu * NWAVES + F.wave, NGW = F.G * NWAVES, head = F.lane >> 3;
    const f32x4 g0 = ((const GAS f32x4*)g_attn)[2 * F.lane], g1 = ((const GAS f32x4*)g_attn)[2 * F.lane + 1];
    v4u na, nb, nc; float nl0, nl1, nl2;
#define MRG_LOAD(m_) do { const int mm_ = (m_) < M ? (m_) : 0; na = ((const GAS v4u*)(O0 + (size_t)mm_ * DA))[F.lane]; nb = ((const GAS v4u*)(O1 + (size_t)mm_ * DA))[F.lane]; nc = ((const GAS v4u*)(O2 + (size_t)mm_ * DA))[F.lane]; \
        nl0 = LSE[((size_t)0 * M + mm_) * NH + head]; nl1 = LSE[((size_t)1 * M + mm_) * NH + head]; nl2 = LSE[((size_t)2 * M + mm_) * NH + head]; } while (0)
    MRG_LOAD(gw);
    for (int m = gw; m < M; m += NGW) {
        const v4u a = na, b = nb, c = nc; const float l0 = nl0, l1 = nl1, l2 = nl2;
        MRG_LOAD(m + NGW);
        const float mx = fmaxf(l0, fmaxf(l1, l2));
        float w0 = __builtin_amdgcn_exp2f(l0 - mx), w1 = __builtin_amdgcn_exp2f(l1 - mx), w2 = __builtin_amdgcn_exp2f(l2 - mx);
        const float inv = 1.0f / (w0 + w1 + w2); w0 *= inv; w1 *= inv; w2 *= inv;
        float v[8]; float ss = 0.f;
#pragma unroll
        for (int j = 0; j < 4; ++j) { v[2 * j] = w0 * bflo(a[j]) + w1 * bflo(b[j]) + w2 * bflo(c[j]); v[2 * j + 1] = w0 * bfhi(a[j]) + w1 * bfhi(b[j]) + w2 * bfhi(c[j]); ss += v[2 * j] * v[2 * j] + v[2 * j + 1] * v[2 * j + 1]; }
        const float rs = 1.0f / sqrtf(wave_sum(ss) * (1.0f / DA) + RMS_EPS);
        v4u ov; ov.x = pk2(v[0] * rs * g0.x, v[1] * rs * g0.y); ov.y = pk2(v[2] * rs * g0.z, v[3] * rs * g0.w); ov.z = pk2(v[4] * rs * g1.x, v[5] * rs * g1.y); ov.w = pk2(v[6] * rs * g1.z, v[7] * rs * g1.w);
        ((GAS v4u*)(Y + (size_t)m * D))[F.lane] = ov;
    }
#undef MRG_LOAD
}
}

namespace lru {
constexpr int TAB_OFF = 0, STG_OFF = 10240, STG_WAVE = 16 * 68 * 4, GST_OFF = STG_OFF + NWAVES * STG_WAVE, GST_WAVE = 16 * 64 * 2, VST_OFF = GST_OFF + NWAVES * GST_WAVE, VST_WAVE = 64 * 64 * 2,
              SS_OFF = VST_OFF + NWAVES * VST_WAVE, LRU_LDS = SS_OFF + 2048;
static_assert(LRU_LDS <= RING_BYTES && (SS_OFF % 16) == 0 && (STG_OFF % 16) == 0, "LRU LDS");
constexpr int NUNIT = NBATCH * (SEQ / 64);
constexpr int FT_PITCH = 144, FT_WAVE = 64 * FT_PITCH;
static_assert(NWAVES * FT_WAVE + 2048 <= RING_BYTES, "LRU final LDS");
__device__ __forceinline__ float sigmoidf_fast(float x) { return __builtin_amdgcn_rcpf(1.0f + __builtin_amdgcn_exp2f(-LOG2E * x)); }

template <bool FINAL>
__device__ __forceinline__ void lru_phase(Frame& F, const int layer, const Args& a, const bf16* Ug, const bf16* Gg, float* AGG, bf16* Y, bf16* LAo, bf16* BEo) {
    LAS unsigned char* lds = F.lds + RING_OFF;
    LAS float* convw = (LAS float*)(lds + TAB_OFF);
    LAS float* convb = convw + 2048;
    __syncthreads();
    for (int i = F.tid; i < 2048; i += NWAVES * 64) convw[i] = a.in[2][layer * 2048 + i];
    if (F.tid < 512) convb[F.tid] = a.in[3][layer * 512 + F.tid];
    LDS_WAIT(); __syncthreads();
    const int g = F.wave, l = F.lane, c16 = l & 15, lg = l >> 4;
    float nba[4], nbx[4], c2[4];
#pragma unroll
    for (int t = 0; t < 4; ++t) { const int ch = 64 * g + 16 * t + c16; nba[t] = -LOG2E * a.in[5][layer * 512 + ch]; nbx[t] = -LOG2E * a.in[7][layer * 512 + ch]; c2[t] = -8.0f * LOG2E * log1pf(expf(-a.in[8][layer * 512 + ch])); }
    bf16x8 wf[2][4][2];
    { const bf16* Wbase = (const bf16*)(a.ws + WS_LRUW) + (size_t)(layer * 16 + g) * 4096 + c16 * 64 + 8 * lg;
#pragma unroll
      for (int gate = 0; gate < 2; ++gate)
#pragma unroll
        for (int t = 0; t < 4; ++t)
#pragma unroll
            for (int s = 0; s < 2; ++s) wf[gate][t][s] = *(const GAS bf16x8*)(Wbase + (size_t)gate * 8 * 4096 + t * 16 * 64 + s * 32); }
    LAS float* stg = (LAS float*)(lds + STG_OFF + g * STG_WAVE);
    LAS bf16* gst = (LAS bf16*)(lds + GST_OFF + g * GST_WAVE);
    LAS bf16* vst = (LAS bf16*)(lds + VST_OFF + g * VST_WAVE);
    LAS float* ssl = (LAS float*)(lds + SS_OFF);
    LAS float* stg_c = stg + (4 * lg) * 68 + c16;
    LAS bf16* gst_c = gst + (4 * lg) * 64 + c16;
    LAS bf16* vst_c = vst + (4 * lg) * 64 + c16;
    LAS float* ssl_w = ssl + (4 * lg) * 8 + g;
    for (int unit = blockIdx.x; unit < NUNIT; unit += F.G) {
        const int b = unit >> 6, c = unit & 63; const size_t tok0 = (size_t)b * SEQ + 64 * c;
        v4u un[2][4]; v4u gn[2];
#define LRU_LOAD(ss_) do { const int ts_ = 64 * c + 16 * (ss_) + c16; const size_t row_ = tok0 + 16 * (ss_) + c16; \
            _Pragma("unroll") for (int s = 0; s < 2; ++s) _Pragma("unroll") for (int w = 0; w < 4; ++w) { \
                const bool ok_ = ts_ - 3 + w >= 0; const v4u x_ = *(const GAS v4u*)(Ug + (ok_ ? row_ - 3 + w : row_) * DL + 64 * g + 32 * s + 8 * lg);     \
                un[s][w] = ok_ ? x_ : (v4u){0u, 0u, 0u, 0u}; } \
            if (FINAL) { const bf16* gp_ = Gg + (tok0 + 16 * (ss_) + (l >> 2)) * DL + 64 * g + (l & 3) * 16; gn[0] = *(const GAS v4u*)gp_; gn[1] = *(const GAS v4u*)(gp_ + 8); } } while (0)
        LRU_LOAD(0);
        float hc[4], At[4];
#pragma unroll
        for (int t = 0; t < 4; ++t) { hc[t] = 0.f; At[t] = 1.f; }
        if (FINAL) {
#pragma unroll 4
            for (int cc = 0; cc < c; ++cc) {
#pragma unroll
                for (int t = 0; t < 4; ++t) { const f32x2 ab = *(const GAS f32x2*)(AGG + ((size_t)(b * 64 + cc) * 512 + 64 * g + 16 * t + c16) * 2); hc[t] = ab.x * hc[t] + ab.y; } }
        }
#pragma unroll
        for (int ss = 0; ss < 4; ++ss) {
            if (FINAL) { *(LAS v4u*)(gst + (l >> 2) * 64 + (l & 3) * 16) = gn[0]; *(LAS v4u*)(gst + (l >> 2) * 64 + (l & 3) * 16 + 8) = gn[1]; }
            bf16x8 af[2];
#pragma unroll
            for (int s = 0; s < 2; ++s) { const int cb = 64 * g + 32 * s + 8 * lg;
                f32x4 u0 = *(const LAS f32x4*)(convb + cb), u1 = *(const LAS f32x4*)(convb + cb + 4);
#pragma unroll
                for (int w = 0; w < 4; ++w) { const v4u x = un[s][w];
                    const f32x4 w0 = *(const LAS f32x4*)(convw + w * 512 + cb), w1 = *(const LAS f32x4*)(convw + w * 512 + cb + 4);
                    u0.x += w0.x * bflo(x.x); u0.y += w0.y * bfhi(x.x); u0.z += w0.z * bflo(x.y); u0.w += w0.w * bfhi(x.y);
                    u1.x += w1.x * bflo(x.z); u1.y += w1.y * bfhi(x.z); u1.z += w1.z * bflo(x.w); u1.w += w1.w * bfhi(x.w); }
                *(LAS f32x4*)(stg + c16 * 68 + 32 * s + 8 * lg) = u0; *(LAS f32x4*)(stg + c16 * 68 + 32 * s + 8 * lg + 4) = u1;
                v4u pw; pw.x = pk2(u0.x, u0.y); pw.y = pk2(u0.z, u0.w); pw.z = pk2(u1.x, u1.y); pw.w = pk2(u1.z, u1.w); af[s] = __builtin_bit_cast(bf16x8, pw); }
            if (ss < 3) LRU_LOAD(ss + 1);
            f32x4 acc[2][4];
#pragma unroll
            for (int gate = 0; gate < 2; ++gate)
#pragma unroll
                for (int t = 0; t < 4; ++t) { acc[gate][t] = (f32x4){0.f, 0.f, 0.f, 0.f};
#pragma unroll
                    for (int s = 0; s < 2; ++s) acc[gate][t] = __builtin_amdgcn_mfma_f32_16x16x32_bf16(af[s], wf[gate][t][s], acc[gate][t], 0, 0, 0); }
            float ssq[4] = {0.f, 0.f, 0.f, 0.f};
#pragma unroll
            for (int t = 0; t < 4; ++t) {
                float aj[4], bj[4], l2[4];
#pragma unroll
                for (int r = 0; r < 4; ++r) { const float uu = stg_c[r * 68 + 16 * t];
                    const float rr = __builtin_amdgcn_rcpf(1.0f + __builtin_amdgcn_exp2f(__builtin_fmaf(acc[0][t][r], -LOG2E, nba[t])));
                    const float ig = __builtin_amdgcn_rcpf(1.0f + __builtin_amdgcn_exp2f(__builtin_fmaf(acc[1][t][r], -LOG2E, nbx[t])));
                    l2[r] = rr * c2[t]; aj[r] = __builtin_amdgcn_exp2f(l2[r]);
                    bj[r] = __builtin_amdgcn_sqrtf(__builtin_fmaf(-aj[r], aj[r], 1.0f)) * (ig * uu); }
                if (!FINAL) {
                    const size_t lo = (((((size_t)unit * 8 + g) * 4 + ss) * 4 + t) * 64 + l) * 4;
                    *(GAS v2u*)(LAo + lo) = (v2u){pk2(l2[0], l2[1]), pk2(l2[2], l2[3])}; *(GAS v2u*)(BEo + lo) = (v2u){pk2(bj[0], bj[1]), pk2(bj[2], bj[3])}; }
                float hl[4], cum[4]; hl[0] = bj[0]; cum[0] = aj[0];
#pragma unroll
                for (int r = 1; r < 4; ++r) { hl[r] = aj[r] * hl[r - 1] + bj[r]; cum[r] = cum[r - 1] * aj[r]; }
                float A = cum[3], B = hl[3];
                float pA = __shfl(A, (l + 48) & 63), pB = __shfl(B, (l + 48) & 63);
                if (lg >= 1) { B = A * pB + B; A = A * pA; }
                pA = __shfl(A, (l + 32) & 63); pB = __shfl(B, (l + 32) & 63);
                if (lg >= 2) { B = A * pB + B; A = A * pA; }
                float eA = __shfl(A, (l + 48) & 63), eB = __shfl(B, (l + 48) & 63); if (lg == 0) { eA = 1.0f; eB = 0.0f; }
                const float hin = eA * hc[t] + eB;
                const float tA = __shfl(A, 48 + c16), tB = __shfl(B, 48 + c16);
                hc[t] = tA * hc[t] + tB; At[t] *= tA;
                if (FINAL) {
#pragma unroll
                    for (int r = 0; r < 4; ++r) { const float h = hl[r] + cum[r] * hin; const float gx = bf2f(gst_c[r * 64 + 16 * t]);
                        const float z2 = 1.5957691216057308f * (gx + 0.044715f * gx * gx * gx); const float vv = gx * sigmoidf_fast(z2) * h;
                        vst_c[(16 * ss + r) * 64 + 16 * t] = (bf16)f2bf(vv); ssq[r] += vv * vv; }
                }
            }
            if (FINAL) {
#pragma unroll
                for (int r = 0; r < 4; ++r) { float q = ssq[r]; q += __shfl_xor(q, 1); q += __shfl_xor(q, 2); q += __shfl_xor(q, 4); q += __shfl_xor(q, 8); if (c16 == 0) ssl_w[(16 * ss + r) * 8] = q; }
            }
        }
#undef LRU_LOAD
        if (!FINAL) {
            if (lg == 0) {
#pragma unroll
                for (int t = 0; t < 4; ++t) *(GAS f32x2*)(AGG + ((size_t)(b * 64 + c) * 512 + 64 * g + 16 * t + c16) * 2) = (f32x2){At[t], hc[t]}; }
        } else {
            LDS_WAIT(); __syncthreads();
            f32x4 gq[4];
#pragma unroll
            for (int j = 0; j < 4; ++j) gq[j] = ((const GAS f32x4*)(a.in[11] + layer * 512 + 64 * g + (l & 3) * 16))[j];
#pragma unroll
            for (int ss = 0; ss < 4; ++ss) { const int tl = 16 * ss + (l >> 2);
                const f32x4 s0 = *(const LAS f32x4*)(ssl + tl * 8), s1 = *(const LAS f32x4*)(ssl + tl * 8 + 4);
                const float rs = 1.0f / sqrtf(((s0.x + s0.y) + (s0.z + s0.w) + (s1.x + s1.y) + (s1.z + s1.w)) * (1.0f / DL) + RMS_EPS);
                const v4u y0 = *(const LAS v4u*)(vst + tl * 64 + (l & 3) * 16), y1 = *(const LAS v4u*)(vst + tl * 64 + (l & 3) * 16 + 8);
                v4u o0, o1;
                o0.x = pk2(bflo(y0.x) * rs * gq[0].x, bfhi(y0.x) * rs * gq[0].y); o0.y = pk2(bflo(y0.y) * rs * gq[0].z, bfhi(y0.y) * rs * gq[0].w);
                o0.z = pk2(bflo(y0.z) * rs * gq[1].x, bfhi(y0.z) * rs * gq[1].y); o0.w = pk2(bflo(y0.w) * rs * gq[1].z, bfhi(y0.w) * rs * gq[1].w);
                o1.x = pk2(bflo(y1.x) * rs * gq[2].x, bfhi(y1.x) * rs * gq[2].y); o1.y = pk2(bflo(y1.y) * rs * gq[2].z, bfhi(y1.y) * rs * gq[2].w);
                o1.z = pk2(bflo(y1.z) * rs * gq[3].x, bfhi(y1.z) * rs * gq[3].y); o1.w = pk2(bflo(y1.w) * rs * gq[3].z, bfhi(y1.w) * rs * gq[3].w);
                GAS v4u* dst = (GAS v4u*)(Y + (tok0 + tl) * D + DL + 64 * g + (l & 3) * 16); dst[0] = o0; dst[1] = o1; }
            __syncthreads();
        }
    }
}

__device__ __forceinline__ void lru_final_phase(Frame& F, const int layer, const Args& a, const bf16* Gg, const float* AGG, const bf16* LAi, const bf16* BEi, bf16* Y) {
    LAS unsigned char* lds = F.lds + RING_OFF;
    const int g = F.wave, l = F.lane;
    LAS unsigned char* tile = lds + g * FT_WAVE;
    LAS float* ssl = (LAS float*)(lds + NWAVES * FT_WAVE);
    f32x4 gq[2];
#pragma unroll
    for (int j = 0; j < 2; ++j) gq[j] = ((const GAS f32x4*)(a.in[11] + layer * 512 + 64 * g + (l & 7) * 8))[j];
    __syncthreads();
    for (int u0 = blockIdx.x, it = 0; u0 < NUNIT; u0 += F.G, ++it) {
        const int unit = (it & 1) ? (u0 ^ 63) : u0;
        const int b = unit >> 6, c = unit & 63; const size_t tok0 = (size_t)b * SEQ + 64 * c;
        v4u gr[8];
#pragma unroll
        for (int j = 0; j < 8; ++j) gr[j] = *(const GAS v4u*)(Gg + (tok0 + 8 * j + (l >> 3)) * DL + 64 * g + (l & 7) * 8);
        const GAS v2u* lap = (const GAS v2u*)(LAi + ((((size_t)unit * 8 + g) * 4) * 4 + (l >> 4)) * 256 + (l & 15) * 4); const GAS v2u* bep = (const GAS v2u*)(BEi + ((((size_t)unit * 8 + g) * 4) * 4 + (l >> 4)) * 256 + (l & 15) * 4);
        v2u la8[8], be8[8];
#pragma unroll
        for (int j = 0; j < 8; ++j) { la8[j] = lap[(j >> 2) * 4 * 64 + (j & 3) * 16]; be8[j] = bep[(j >> 2) * 4 * 64 + (j & 3) * 16]; }
        float h = 0.f;
        { const GAS f32x2* ap = (const GAS f32x2*)(AGG + ((size_t)(b * 64) * 512 + 64 * g + l) * 2);
          int cc = 0;
          for (; cc + 16 <= c; cc += 16) { f32x2 ab[16];
#pragma unroll
              for (int j = 0; j < 16; ++j) ab[j] = ap[(size_t)(cc + j) * 512];
#pragma unroll
              for (int j = 0; j < 16; ++j) h = ab[j].x * h + ab[j].y; }
          { f32x2 ab[16];
#pragma unroll
              for (int j = 0; j < 16; ++j) ab[j] = ap[(size_t)((cc + j < c) ? cc + j : 0) * 512];
#pragma unroll
              for (int j = 0; j < 16; ++j) if (cc + j < c) h = ab[j].x * h + ab[j].y; } }
#pragma unroll
        for (int j = 0; j < 8; ++j) *(LAS v4u*)(tile + (8 * j + (l >> 3)) * FT_PITCH + (l & 7) * 16) = gr[j];
        LAS bf16* col = (LAS bf16*)(tile + 2 * l);
#pragma unroll
        for (int half = 0; half < 2; ++half) {
            if (half == 1) {
#pragma unroll
                for (int j = 0; j < 8; ++j) { la8[j] = lap[(2 + (j >> 2)) * 4 * 64 + (j & 3) * 16]; be8[j] = bep[(2 + (j >> 2)) * 4 * 64 + (j & 3) * 16]; } }
#pragma unroll
            for (int j = 0; j < 8; ++j)
#pragma unroll
                for (int e = 0; e < 4; ++e) { const int tt = 32 * half + 4 * j + e; const unsigned lw = la8[j][e >> 1], bw = be8[j][e >> 1];
                    const float l2 = (e & 1) ? bfhi(lw) : bflo(lw), be = (e & 1) ? bfhi(bw) : bflo(bw);
                    h = __builtin_amdgcn_exp2f(l2) * h + be;
                    const float gx = bf2f(col[tt * (FT_PITCH / 2)]);
                    const float z2 = 1.5957691216057308f * (gx + 0.044715f * gx * gx * gx);
                    col[tt * (FT_PITCH / 2)] = (bf16)pk2(gx * sigmoidf_fast(z2) * h, 0.f); }
        }
        { float q = 0.f;
#pragma unroll
          for (int j = 0; j < 8; ++j) { const v4u y = *(const LAS v4u*)(tile + l * FT_PITCH + 16 * j);
#pragma unroll
              for (int e = 0; e < 4; ++e) { const float x0 = bflo(y[e]), x1 = bfhi(y[e]); q += x0 * x0 + x1 * x1; } }
          ssl[l * 8 + g] = q; }
        LDS_WAIT(); __syncthreads();
#pragma unroll
        for (int j = 0; j < 8; ++j) { const int tl = 8 * j + (l >> 3);
            const f32x4 s0 = *(const LAS f32x4*)(ssl + tl * 8), s1 = *(const LAS f32x4*)(ssl + tl * 8 + 4);
            const float rs = 1.0f / sqrtf(((s0.x + s0.y) + (s0.z + s0.w) + (s1.x + s1.y) + (s1.z + s1.w)) * (1.0f / DL) + RMS_EPS);
            const v4u y = *(const LAS v4u*)(tile + tl * FT_PITCH + (l & 7) * 16);
            v4u o; o.x = pk2(bflo(y.x) * rs * gq[0].x, bfhi(y.x) * rs * gq[0].y); o.y = pk2(bflo(y.y) * rs * gq[0].z, bfhi(y.y) * rs * gq[0].w);
            o.z = pk2(bflo(y.z) * rs * gq[1].x, bfhi(y.z) * rs * gq[1].y); o.w = pk2(bflo(y.w) * rs * gq[1].z, bfhi(y.w) * rs * gq[1].w);
            *(GAS v4u*)(Y + (tok0 + tl) * D + DL + 64 * g + (l & 7) * 8) = o; }
        __syncthreads();
    }
}
}

#define PB_BEGIN(k) do { F.lane = fresh_lane(); if (PROBE_MASK && ((PROBE_MASK >> (k)) & 1ull)) F.pt0 = rt(); } while (0)
#define PB_END(k) do { if (PROBE_MASK && ((PROBE_MASK >> (k)) & 1ull)) F.pacc += rt() - F.pt0; } while (0)
#define IN(k) (lo <= (k) && (k) < hi)
#define SEAM(k) do { if (IN(k) && IN((k) + 1)) { if ((PROBE_MASK & (1ull << 37)) && (PROBE_SEAM < 0 || PROBE_SEAM == (k))) { const unsigned long long t_ = rt(); xcd_barrier(bar); F.pacc += rt() - t_; } else xcd_barrier(bar); } } while (0)
template <int layer>
__device__ __forceinline__ void run_layer(Frame& F, const Args& args, const XcdBarrier& bar, const int lo, const int hi) {
    unsigned char* ws = args.ws; bf16* XBp = (bf16*)(ws + WS_XB);
        const int pb = layer ? PH_L1 : PH_L0;
        PB_BEGIN(pb + 0);
        if (IN(pb + 0)) {
            pg8::Gemm g{XBp, (const bf16*)(ws + WS_WIN) + (size_t)layer * DIN * D, M, DIN, D}; pg8::StaticOrder S; S.init(M, DIN, F.G, (int)blockIdx.x);
            pg8::EpiBf16<0> E{(bf16*)(ws + WS_Q), DA, nullptr, DA, (size_t)M * DA, QSCALE};
            pg8::gemm_phase<pg8::EpiBf16<0>, pg8::StaticOrder, true, true>(F.lds + RING_OFF, g, S, E);
        }
        SEAM(pb + 0);
        PB_END(pb + 0);
        PB_BEGIN(pb + 1);
        if (IN(pb + 1)) { PB_BEGIN(27); att::attn_phase(F, (const bf16*)(ws + WS_Q), (const bf16*)(ws + WS_K), (const bf16*)(ws + WS_V), args.in[9], (bf16*)(ws + WS_O0), (bf16*)(ws + WS_O1), (bf16*)(ws + WS_O2), (float*)(ws + WS_LSE)); PB_END(27);
            PB_BEGIN(28); lru::lru_phase<false>(F, layer, args, (const bf16*)(ws + WS_U), (const bf16*)(ws + WS_G), (float*)(ws + WS_AGG), nullptr, (bf16*)(ws + WS_LA), (bf16*)(ws + WS_BE)); PB_END(28); }
        SEAM(pb + 1);
        PB_END(pb + 1);
        PB_BEGIN(pb + 2);
        if (IN(pb + 2)) { PB_BEGIN(29); att::merge_attn_phase(F, (const bf16*)(ws + WS_O0), (const bf16*)(ws + WS_O1), (const bf16*)(ws + WS_O2), (const float*)(ws + WS_LSE), args.in[10] + layer * DA, (bf16*)(ws + WS_Y)); PB_END(29);
            PB_BEGIN(30); lru::lru_final_phase(F, layer, args, (const bf16*)(ws + WS_G), (const float*)(ws + WS_AGG), (const bf16*)(ws + WS_LA), (const bf16*)(ws + WS_BE), (bf16*)(ws + WS_Y)); PB_END(30); }
        SEAM(pb + 2);
        PB_END(pb + 2);
        PB_BEGIN(pb + 3);
        if (IN(pb + 3)) {
            pg8::Gemm g{(const bf16*)(ws + WS_Y), (const bf16*)(ws + WS_WOUT) + (size_t)layer * D * D, M, D, D}; pg8::StaticOrder S; S.init(M, D, F.G, (int)blockIdx.x);
            pg8::EpiResBf16 E{XBp, XBp, D, ALPHA, 1.0f};
            pg8::gemm_phase<pg8::EpiResBf16, pg8::StaticOrder, true, true>(F.lds + RING_OFF, g, S, E);
        }
        SEAM(pb + 3);
        PB_END(pb + 3);
        PB_BEGIN(pb + 4);
        if (IN(pb + 4)) {
            if (layer == 0) phase_ln<false>(F, XBp, args.in[13], args.in[14], nullptr, nullptr, nullptr);
            else { phase_ln<true>(F, XBp, args.in[13] + D, args.in[14] + D, args.in[20], (int*)(ws + WS_TOKE), (float*)(ws + WS_TOKP)); PB_BEGIN(26); phase_moe_cvt(F, args); PB_END(26); }
        }
        SEAM(pb + 4);
        PB_END(pb + 4);
        if (layer == 0) {
            PB_BEGIN(pb + 5);
            if (IN(pb + 5)) {
                pg8::Gemm g{XBp, (const bf16*)(ws + WS_WGU), M, 2 * DFF, D}; pg8::StaticOrder S; S.init(M, 2 * DFF, F.G, (int)blockIdx.x);
                pg8::EpiSwiGLU8 E{ws + WS_HB, DFF, 1.0f, MOE_HSCALE};
                pg8::gemm_phase<pg8::EpiSwiGLU8, pg8::StaticOrder, true, true>(F.lds + RING_OFF, g, S, E);
            }
            SEAM(pb + 5);
            PB_END(pb + 5);
            PB_BEGIN(pb + 6);
            if (IN(pb + 6)) {
                pg8::Gemm g{(const bf16*)(ws + WS_HB), (const bf16*)(ws + WS_WD), M, D, DFF / 2}; pg8::StaticOrder S; S.init(M, D, F.G, (int)blockIdx.x);
                pg8::EpiResBf16 E{XBp, XBp, D, ALPHA, 1.0f / (MOE_HSCALE * MOE_DSCALE)};
                pg8::gemm_phase<pg8::EpiResBf16, pg8::StaticOrder, true, true, true>(F.lds + RING_OFF, g, S, E);
            }
            SEAM(pb + 6);
            PB_END(pb + 6);
            PB_BEGIN(pb + 7);
            if (IN(pb + 7)) phase_ln<false>(F, XBp, args.in[15], args.in[16], nullptr, nullptr, nullptr);
            SEAM(pb + 7);
            PB_END(pb + 7);
        }
}

__global__ void __launch_bounds__(NWAVES * 64, 2) fwd(Args args) {
    extern __shared__ __attribute__((aligned(16))) unsigned char lds[];
    Frame F;
    F.lds = (LAS unsigned char*)lds;
    F.MISC = (volatile LAS unsigned*)(F.lds + MISC_OFF);
    F.tid = threadIdx.x; F.lane = F.tid & 63; F.wave = __builtin_amdgcn_readfirstlane(F.tid >> 6);
    F.pt0 = 0ull; F.pacc = 0ull;
    F.G = gridDim.x; { const int bx = blockIdx.x; F.vcu = (F.G % 8 == 0) ? (bx % 8) * (F.G / 8) + bx / 8 : bx; }
    unsigned char* ws = args.ws;
    F.ctl = (gu32*)(ws + WS_CTL);
    for (int u = F.tid; u < (LDS_BYTES - LDSCTL_OFF) / 4; u += NWAVES * 64) ((LAS unsigned*)(F.lds + LDSCTL_OFF))[u] = 0u;
    __syncthreads();
    const int lo = args.ph_lo, hi = args.ph_hi;
    const bool use_bar = (hi - lo) > 1;
    XcdBarrier bar; bar.bar = (unsigned*)(F.ctl + CW_BAR) + args.li * XCD_BAR_WORDS; bar.x = 0; bar.st = nullptr;
    if (use_bar) bar = xcd_barrier_post((unsigned*)(F.ctl + CW_BAR) + args.li * XCD_BAR_WORDS, F.MISC + 8);
    float* out = args.out;
    bf16* XBp = (bf16*)(ws + WS_XB);

    PB_BEGIN(PH_PRO);
    if (IN(PH_PRO)) phase_prologue(F, args);
    SEAM(PH_PRO);
    PB_END(PH_PRO);

    run_layer<0>(F, args, bar, lo, hi);
    run_layer<1>(F, args, bar, lo, hi);
    PB_BEGIN(PH_DISPATCH);
    if (IN(PH_DISPATCH)) phase_dispatch(F, (const int*)(ws + WS_TOKE), (int*)(ws + WS_TOKPOS), (int*)(ws + WS_SEG), XBp, ws + WS_XS8);
    SEAM(PH_DISPATCH);
    PB_END(PH_DISPATCH);
    for (int c = 0; c < NCHUNK - 1; ++c) {
        const int pg = PH_MOE0 + 2 * c;
        if (IN(pg) || IN(pg + 1)) {
            pg8::MoeOrder S; S.G = F.G; S.c = (int)blockIdx.x; S.base = c * CHUNK_TILES;
            const GAS int* st = (const GAS int*)(ws + WS_SEG);
#pragma unroll
            for (int k = 0; k < 9; ++k) S.segt[k] = __builtin_amdgcn_readfirstlane(st[k]);
            const int nT = S.segt[8]; S.nrows = nT - S.base; if (S.nrows > CHUNK_TILES) S.nrows = CHUNK_TILES; if (S.nrows < 0) S.nrows = 0;
            unsigned char* HCv = (unsigned char*)out - (size_t)S.base * 256 * DFE;
            S.split_pm = -1; S.adiff = 0;
            PB_BEGIN(pg);
            if (IN(pg)) {
                S.nN = 2 * DFE / 256; S.estride_b = (size_t)2 * DFE * D;
                pg8::Gemm g{(const bf16*)(ws + WS_XS8), (const bf16*)(ws + WS_MGU), SORT_ROWS, 2 * DFE, D / 2};
                pg8::EpiSwiGLU8 E{HCv, DFE, 1.0f / MOE_WSCALE, MOE_HSCALE};
                pg8::gemm_phase<pg8::EpiSwiGLU8, pg8::MoeOrder, true, true, true>(F.lds + RING_OFF, g, S, E);
            }
            SEAM(pg);
            PB_END(pg);
            PB_BEGIN(pg + 1);
            if (IN(pg + 1)) {
                S.nN = D / 256; S.estride_b = (size_t)D * DFE;
                pg8::Gemm g{(const bf16*)HCv, (const bf16*)(ws + WS_MD), SORT_ROWS, D, DFE / 2};
                pg8::EpiBf16S E{(bf16*)(ws + WS_YS), D, 1.0f / (MOE_HSCALE * MOE_DSCALE)};
                pg8::gemm_phase<pg8::EpiBf16S, pg8::MoeOrder, true, true, true>(F.lds + RING_OFF, g, S, E);
            }
            SEAM(pg + 1);
            PB_END(pg + 1);
        }
    }
    {
        constexpr int pg = PH_MOE0 + 2 * (NCHUNK - 1), TAIL_ROW0 = (NCHUNK - 1) * CHUNK_TILES * 256;
        pg8::MoeOrder S; S.G = F.G; S.c = (int)blockIdx.x; S.base = (NCHUNK - 1) * CHUNK_TILES; S.nrows = 0; S.split_pm = -1; S.adiff = 0;
        unsigned char* HCv = ws + WS_HCA - (size_t)S.base * 256 * DFE;
        if (IN(pg) || IN(pg + 1)) {
            const GAS int* st = (const GAS int*)(ws + WS_SEG);
#pragma unroll
            for (int k = 0; k < 9; ++k) S.segt[k] = __builtin_amdgcn_readfirstlane(st[k]);
            S.nrows = S.segt[8] - S.base; if (S.nrows > CHUNK_TILES) S.nrows = CHUNK_TILES; if (S.nrows < 0) S.nrows = 0;
        }
        PB_BEGIN(pg);
        if (IN(pg)) {
            S.nN = 2 * DFE / 256; S.estride_b = (size_t)2 * DFE * D;
            pg8::Gemm g{(const bf16*)(ws + WS_XS8), (const bf16*)(ws + WS_MGU), SORT_ROWS, 2 * DFE, D / 2};
            pg8::EpiSwiGLU8 E{HCv, DFE, 1.0f / MOE_WSCALE, MOE_HSCALE};
            pg8::gemm_phase<pg8::EpiSwiGLU8, pg8::MoeOrder, true, true, true>(F.lds + RING_OFF, g, S, E);
        }
        SEAM(pg);
        PB_END(pg);
        PB_BEGIN(pg + 1);
        if (IN(pg + 1)) {
            {
                pg8::MoeSplitK S2; S2.base = S.base; S2.nrows = S.nrows; S2.nN = D / 256; S2.nS = TAIL_NS; S2.KS = TAIL_KS / 2; S2.G = F.G; S2.c = (int)blockIdx.x; S2.estride_b = (size_t)D * DFE;
#pragma unroll
                for (int k2 = 0; k2 < 9; ++k2) S2.segt[k2] = S.segt[k2];
                pg8::Gemm g{(const bf16*)HCv, (const bf16*)(ws + WS_MD), SORT_ROWS, D, TAIL_KS / 2, DFE / 2};
                pg8::EpiPart E{(bf16*)(ws + WS_PART), D, S.base, TAIL_TILES, 1.0f / (MOE_HSCALE * MOE_DSCALE)};
                pg8::gemm_phase<pg8::EpiPart, pg8::MoeSplitK, true, true, true>(F.lds + RING_OFF, g, S2, E);
            }
            phase_combine(F, XBp, out, (const bf16*)(ws + WS_YS), (const int*)(ws + WS_TOKPOS), (const float*)(ws + WS_TOKP), args.in[15] + D, args.in[16] + D, (const bf16*)(ws + WS_PART), 1, TAIL_ROW0, F.vcu * NWAVES + F.wave, F.G * NWAVES);
        }
        SEAM(pg + 1);
        PB_END(pg + 1);
        PB_BEGIN(PH_COMBINE);
        if (IN(PH_COMBINE)) phase_combine(F, XBp, out, (const bf16*)(ws + WS_YS), (const int*)(ws + WS_TOKPOS), (const float*)(ws + WS_TOKP), args.in[15] + D, args.in[16] + D, (const bf16*)(ws + WS_PART), 2, TAIL_ROW0, F.vcu * NWAVES + F.wave, F.G * NWAVES);
        PB_END(PH_COMBINE);
        if (PROBE_MASK && blockIdx.x == 0 && F.tid == 0) { const unsigned long long te = rt() + (unsigned long long)PROBE_K * F.pacc; while (rt() < te) __builtin_amdgcn_s_sleep(8); }
    }
#undef IN
#undef SEAM
}

extern "C" void kernel_launch(void* const* d_in, const int* in_sizes, int n_in, void* d_out, int out_size, void* d_ws, size_t ws_size, hipStream_t stream) {
    static int grid = 0;
    if (grid == 0) {
        if (n_in != 24 || in_sizes[0] != M * D || out_size != M * D || ws_size < WS_END) { fprintf(stderr, "kernel_launch: unexpected problem (n_in %d, out %d, ws %zu < %zu)\n", n_in, out_size, ws_size, (size_t)WS_END); grid = -1; return; }
        int dev = 0, cus = 0, per_cu = 0;
        if (hipGetDevice(&dev) != hipSuccess || hipDeviceGetAttribute(&cus, hipDeviceAttributeMultiprocessorCount, dev) != hipSuccess) { grid = -1; return; }
        if (hipFuncSetAttribute((const void*)fwd, hipFuncAttributeMaxDynamicSharedMemorySize, LDS_BYTES) != hipSuccess) { fprintf(stderr, "kernel_launch: hipFuncSetAttribute failed\n"); grid = -1; return; }
        if (hipOccupancyMaxActiveBlocksPerMultiprocessor(&per_cu, (const void*)fwd, NWAVES * 64, LDS_BYTES) != hipSuccess || per_cu < 1) fprintf(stderr, "kernel_launch: occupancy query says %d\n", per_cu);
        (void)hipGetLastError();
        grid = cus;
    }
    if (grid < 0) return;
    (void)hipMemsetAsync((char*)d_ws + WS_CTL, 0, CTL_ZERO_BYTES, stream);
    Args a{};
    for (int i = 0; i < 24; ++i) a.in[i] = (const float*)d_in[i];
    a.out = (float*)d_out; a.ws = (unsigned char*)d_ws;
    int li = 0;
    auto launch = [&](int lo, int hi) { a.ph_lo = lo; a.ph_hi = hi; a.li = li++; hipLaunchKernelGGL(fwd, dim3(grid), dim3(NWAVES * 64), LDS_BYTES, stream, a); };
    auto each = [&](int lo, int hi) { for (int p = lo; p < hi; ++p) launch(p, p + 1); };
#if defined(MK_PER_PHASE)
    each(PH_PRO, NPH);
#else
    launch(PH_PRO, NPH);
#endif
}
```

```cpp
#include <hip/hip_runtime.h>
#include <cstdio>
#include <cstdint>
#include <cmath>
namespace pg8 {
#define PG8_LAS __attribute__((address_space(3)))
typedef unsigned short bf16_t;
typedef short bf16x8 __attribute__((ext_vector_type(8)));
typedef float f32x4 __attribute__((ext_vector_type(4)));
typedef unsigned u32x4 __attribute__((ext_vector_type(4)));
typedef int i32x4 __attribute__((ext_vector_type(4)));
typedef int i32x8 __attribute__((ext_vector_type(8)));
constexpr int BM = 256, BK = 64, HALF = 128, HTB = HALF * BK * 2  , STAGE_BYTES = 8 * HTB, NXCD = 8, WGM = 8;

__host__ __device__ __forceinline__ int lds_byte(int r, int c) { const int st = (r >> 4) * 2 + (c >> 5), rr = r & 15, cc = c & 31, ob = rr * 64 + cc * 2; return st * 1024 + (ob ^ (((ob >> 9) & 1) << 5)); }
__host__ __device__ __forceinline__ void stage_rc(int b, int& R, int& C) { const int st = b / 1024, sb = b % 1024, swz = sb ^ (((sb >> 9) & 1) << 5); R = (st >> 1) * 16 + swz / 64; C = (st & 1) * 32 + (swz % 64) / 2; }
__host__ __device__ __forceinline__ int perm32(int rho) { const int n = rho >> 4, i = rho & 15; return 8 * (i >> 2) + 4 * n + (i & 3); }

struct Unit { int pm, pn; size_t boffb, aoffb; int ks; };
struct Gemm { const bf16_t* A; const bf16_t* Bt; int M, N, K; int ld; };

struct StaticOrder {
    int nM, nN, nwg, G, c;
    __host__ __device__ void init(int M, int N, int G_, int c_) { nM = M / BM; nN = N / BM; nwg = nM * nN; G = G_; c = c_; }
    __host__ __device__ bool next(int i, Unit& u) const {
        const long L = (long)i * G + c; if (L >= nwg) return false;
        int wgid = (int)L; { const int q = nwg / NXCD, r = nwg % NXCD, xcd = wgid % NXCD, off = wgid / NXCD; wgid = (xcd < r ? xcd * (q + 1) : r * (q + 1) + (xcd - r) * q) + off; }
        const int nig = WGM * nN, gid = wgid / nig, fm = gid * WGM, gsz = (nM - fm) < WGM ? (nM - fm) : WGM;
        u.pm = fm + ((wgid % nig) % gsz); u.pn = (wgid % nig) / gsz; u.boffb = 0; u.aoffb = 0; u.ks = 0; return true;
    }
    __device__ __forceinline__ void a_ready(const Unit&) const {}
    __device__ __forceinline__ void done(const Unit&) const {}
};

__device__ __forceinline__ unsigned cvt_pk_bf16(float lo, float hi) { unsigned r; asm volatile("v_cvt_pk_bf16_f32 %0, %1, %2" : "=v"(r) : "v"(lo), "v"(hi)); return r; }
typedef float f32x2 __attribute__((ext_vector_type(2)));
__device__ __forceinline__ f32x2 gelu_pk(f32x2 v) {
    const f32x2 av = __builtin_elementwise_abs(v), d = av * 0.2316418882f + 1.0f;
    f32x2 t; t.x = __builtin_amdgcn_rcpf(d.x); t.y = __builtin_amdgcn_rcpf(d.y);
    f32x2 q = t * 0.5307027145f + (-0.7265760135f); q = q * t + 0.7107068705f; q = q * t + (-0.142248368f); q = q * t + 0.127414796f; q = q * t;
    const f32x2 s = (v * v) * (-0.72134752044f);
    f32x2 e; e.x = __builtin_amdgcn_exp2f(s.x); e.y = __builtin_amdgcn_exp2f(s.y);
    const f32x2 m = v * (q * e), r = v - m;
    f32x2 o; o.x = v.x < 0.f ? m.x : r.x; o.y = v.y < 0.f ? m.y : r.y; return o;
}

template <int ACT  > struct EpiBf16 {
    static constexpr bool PERM = true, AFTER_DRAIN = false; static_assert(ACT == 0 || ACT == 1, "EpiBf16: ACT is 0 (none) or 1 (gelu_pk)");
    bf16_t* O; int ldc; const float* bias; int split_cols; size_t split_stride; float scale0;
    __device__ __forceinline__ void operator()(const f32x4 (&acc)[2][2][4][2], const Unit& u, int wr, int wc, int fr, int fq) const {
        const int row0 = u.pm * BM + wr * 64 + fr; int colt = u.pn * BM; bf16_t* base = O;
        float sc = 1.f; if (split_cols) { const int t = colt / split_cols; base += (size_t)t * split_stride; colt -= t * split_cols; if (t == 0) sc = scale0; }
        const int col0 = colt + wc * 32 + 8 * fq, bcol0 = u.pn * BM + wc * 32 + 8 * fq;
        f32x4 bv[2][2];
#pragma unroll
        for (int bj = 0; bj < 2; ++bj)
#pragma unroll
            for (int n = 0; n < 2; ++n) bv[bj][n] = bias ? *(const f32x4*)(bias + bcol0 + bj * HALF + 4 * n) : (f32x4){0.f, 0.f, 0.f, 0.f};
#pragma unroll
        for (int ai = 0; ai < 2; ++ai)
#pragma unroll
            for (int m = 0; m < 4; ++m) { bf16_t* rowp = base + (size_t)(row0 + ai * HALF + m * 16) * ldc + col0;
#pragma unroll
                for (int bj = 0; bj < 2; ++bj) { f32x4 v0 = acc[ai][bj][m][0] + bv[bj][0], v1 = acc[ai][bj][m][1] + bv[bj][1];
                    if (ACT == 1) { f32x2 a = gelu_pk((f32x2){v0[0], v0[1]}), b = gelu_pk((f32x2){v0[2], v0[3]}), c = gelu_pk((f32x2){v1[0], v1[1]}), d = gelu_pk((f32x2){v1[2], v1[3]});
                        v0 = (f32x4){a.x, a.y, b.x, b.y}; v1 = (f32x4){c.x, c.y, d.x, d.y}; }
                    v0 = v0 * sc; v1 = v1 * sc; u32x4 w; w.x = cvt_pk_bf16(v0[0], v0[1]); w.y = cvt_pk_bf16(v0[2], v0[3]); w.z = cvt_pk_bf16(v1[0], v1[1]); w.w = cvt_pk_bf16(v1[2], v1[3]);
                    *(u32x4*)(rowp + bj * HALF) = w; } }
    }
};

struct EpiSwiGLU {
    static constexpr bool PERM = true, AFTER_DRAIN = false;
    bf16_t* O; int ldc; bf16_t* O2; int split_pm; float wscale;
    __device__ __forceinline__ static float silu_mul(float g, float u) { return g * __builtin_amdgcn_rcpf(1.0f + __builtin_amdgcn_exp2f(g * -1.4426950408889634f)) * u; }
    __device__ __forceinline__ void operator()(const f32x4 (&acc)[2][2][4][2], const Unit& u, int wr, int wc, int fr, int fq) const {
        const int row0 = u.pm * BM + wr * 64 + fr, col0 = u.pn * HALF + wc * 32 + 8 * fq;
#pragma unroll
        for (int ai = 0; ai < 2; ++ai)
#pragma unroll
            for (int m = 0; m < 4; ++m) { bf16_t* rowp = ((split_pm >= 0 && u.pm >= split_pm) ? O2 : O) + (size_t)(row0 + ai * HALF + m * 16) * ldc + col0;
                const f32x4 g0 = acc[ai][0][m][0] * wscale, g1 = acc[ai][0][m][1] * wscale, u0 = acc[ai][1][m][0] * wscale, u1 = acc[ai][1][m][1] * wscale;
                u32x4 w; w.x = cvt_pk_bf16(silu_mul(g0[0], u0[0]), silu_mul(g0[1], u0[1])); w.y = cvt_pk_bf16(silu_mul(g0[2], u0[2]), silu_mul(g0[3], u0[3]));
                w.z = cvt_pk_bf16(silu_mul(g1[0], u1[0]), silu_mul(g1[1], u1[1])); w.w = cvt_pk_bf16(silu_mul(g1[2], u1[2]), silu_mul(g1[3], u1[3]));
                *(u32x4*)rowp = w; }
    }
};
struct EpiResF32 {
    static constexpr bool PERM = false, AFTER_DRAIN = false;
    const float* R; float* out; int ldc; float alpha;
    __device__ __forceinline__ void operator()(const f32x4 (&acc)[2][2][4][2], const Unit& u, int wr, int wc, int fr, int fq) const {
        const int col0 = u.pn * BM + wc * 32 + 4 * fq;
#pragma unroll
        for (int ai = 0; ai < 2; ++ai)
#pragma unroll
            for (int m = 0; m < 4; ++m) { const size_t off = (size_t)(u.pm * BM + ai * HALF + wr * 64 + m * 16 + fr) * ldc + col0;
#pragma unroll
                for (int bj = 0; bj < 2; ++bj)
#pragma unroll
                    for (int n = 0; n < 2; ++n) { const f32x4 rs = *(const f32x4*)(R + off + bj * HALF + n * 16); *(f32x4*)(out + off + bj * HALF + n * 16) = rs * alpha + acc[ai][bj][m][n]; }
                if (m & 1) asm volatile("" ::: "memory"); }
    }
};
__device__ __forceinline__ unsigned pk4_e4m3(float a, float b, float c, float d) {
    a = __builtin_fminf(__builtin_fmaxf(a, -448.f), 448.f); b = __builtin_fminf(__builtin_fmaxf(b, -448.f), 448.f); c = __builtin_fminf(__builtin_fmaxf(c, -448.f), 448.f); d = __builtin_fminf(__builtin_fmaxf(d, -448.f), 448.f);
    unsigned w = 0u; w = __builtin_amdgcn_cvt_pk_fp8_f32(a, b, w, false); w = __builtin_amdgcn_cvt_pk_fp8_f32(c, d, w, true); return w;
}
struct EpiSwiGLU8 {
    static constexpr bool PERM = true, AFTER_DRAIN = false;
    unsigned char* O; int ldc; float wscale, hscale;
    __device__ __forceinline__ void operator()(const f32x4 (&acc)[2][2][4][2], const Unit& u, int wr, int wc, int fr, int fq) const {
        const int row0 = u.pm * BM + wr * 64 + fr, col0 = u.pn * HALF + wc * 32 + 8 * fq;
        typedef unsigned u32x2 __attribute__((ext_vector_type(2)));
#pragma unroll
        for (int ai = 0; ai < 2; ++ai)
#pragma unroll
            for (int m = 0; m < 4; ++m) { unsigned char* rowp = O + (size_t)(row0 + ai * HALF + m * 16) * ldc + col0;
                const f32x4 g0 = acc[ai][0][m][0] * wscale, g1 = acc[ai][0][m][1] * wscale, u0 = acc[ai][1][m][0] * (wscale * hscale), u1 = acc[ai][1][m][1] * (wscale * hscale);
                u32x2 w; w.x = pk4_e4m3(EpiSwiGLU::silu_mul(g0[0], u0[0]), EpiSwiGLU::silu_mul(g0[1], u0[1]), EpiSwiGLU::silu_mul(g0[2], u0[2]), EpiSwiGLU::silu_mul(g0[3], u0[3]));
                w.y = pk4_e4m3(EpiSwiGLU::silu_mul(g1[0], u1[0]), EpiSwiGLU::silu_mul(g1[1], u1[1]), EpiSwiGLU::silu_mul(g1[2], u1[2]), EpiSwiGLU::silu_mul(g1[3], u1[3]));
                *(u32x2*)rowp = w; }
    }
};
struct EpiBf16S {
    static constexpr bool PERM = true, AFTER_DRAIN = false;
    bf16_t* O; int ldc; float s;
    __device__ __forceinline__ void operator()(const f32x4 (&acc)[2][2][4][2], const Unit& u, int wr, int wc, int fr, int fq) const {
        const int row0 = u.pm * BM + wr * 64 + fr, col0 = u.pn * BM + wc * 32 + 8 * fq;
#pragma unroll
        for (int ai = 0; ai < 2; ++ai)
#pragma unroll
            for (int m = 0; m < 4; ++m) { bf16_t* rowp = O + (size_t)(row0 + ai * HALF + m * 16) * ldc + col0;
#pragma unroll
                for (int bj = 0; bj < 2; ++bj) { const f32x4 v0 = acc[ai][bj][m][0] * s, v1 = acc[ai][bj][m][1] * s;
                    u32x4 w; w.x = cvt_pk_bf16(v0[0], v0[1]); w.y = cvt_pk_bf16(v0[2], v0[3]); w.z = cvt_pk_bf16(v1[0], v1[1]); w.w = cvt_pk_bf16(v1[2], v1[3]);
                    *(u32x4*)(rowp + bj * HALF) = w; } }
    }
};
struct EpiResBf16 {
    static constexpr bool PERM = true, AFTER_DRAIN = false;
    const bf16_t* R; bf16_t* out; int ldc; float alpha; float s;
    __device__ __forceinline__ void operator()(const f32x4 (&acc)[2][2][4][2], const Unit& u, int wr, int wc, int fr, int fq) const {
        const int row0 = u.pm * BM + wr * 64 + fr, col0 = u.pn * BM + wc * 32 + 8 * fq;
#pragma unroll
        for (int ai = 0; ai < 2; ++ai)
#pragma unroll
            for (int m = 0; m < 4; ++m) { const size_t off = (size_t)(row0 + ai * HALF + m * 16) * ldc + col0;
#pragma unroll
                for (int bj = 0; bj < 2; ++bj) { const u32x4 rv = *(const u32x4*)(R + off + bj * HALF); const f32x4 v0 = acc[ai][bj][m][0] * s, v1 = acc[ai][bj][m][1] * s;
                    u32x4 w;
                    w.x = cvt_pk_bf16(alpha * __uint_as_float(rv.x << 16) + v0[0], alpha * __uint_as_float(rv.x & 0xffff0000u) + v0[1]);
                    w.y = cvt_pk_bf16(alpha * __uint_as_float(rv.y << 16) + v0[2], alpha * __uint_as_float(rv.y & 0xffff0000u) + v0[3]);
                    w.z = cvt_pk_bf16(alpha * __uint_as_float(rv.z << 16) + v1[0], alpha * __uint_as_float(rv.z & 0xffff0000u) + v1[1]);
                    w.w = cvt_pk_bf16(alpha * __uint_as_float(rv.w << 16) + v1[2], alpha * __uint_as_float(rv.w & 0xffff0000u) + v1[3]);
                    *(u32x4*)(out + off + bj * HALF) = w; }
                if (m & 1) asm volatile("" ::: "memory"); }
    }
};
constexpr int MOE_SUB = 64;
struct MoeOrder {
    int base, nrows, nN, G, c; int segt[9]; size_t estride_b; int split_pm; size_t adiff;
    __device__ __forceinline__ bool next(int i, Unit& u) const {
        const long L = (long)i * G + c; if (L >= (long)nrows * nN) return false;
        if (nrows % MOE_SUB) { u.pm = base + (int)(L % nrows); u.pn = (int)(L / nrows); }
        else { const int per = MOE_SUB * nN, sc = (int)(L / per), Lr = (int)(L % per); u.pm = base + sc * MOE_SUB + Lr % MOE_SUB; u.pn = Lr / MOE_SUB; }
        int e = 0;
#pragma unroll
        for (int k = 1; k < 8; ++k) e += (u.pm >= segt[k]) ? 1 : 0;
        u.boffb = (size_t)e * estride_b; u.aoffb = (split_pm >= 0 && u.pm >= split_pm) ? adiff : 0; u.ks = 0; return true;
    }
    __device__ __forceinline__ void a_ready(const Unit&) const {}
    __device__ __forceinline__ void done(const Unit&) const {}
};
struct MoeSplitK {
    int base, nrows, nN, nS, KS, G, c; int segt[9]; size_t estride_b;
    __device__ __forceinline__ bool next(int i, Unit& u) const {
        const long L = (long)i * G + c; if (L >= (long)nrows * nN * nS) return false;
        u.ks = (int)(L % nS); const int rest = (int)(L / nS); u.pm = base + rest % nrows; u.pn = rest / nrows;
        int e = 0;
#pragma unroll
        for (int k = 1; k < 8; ++k) e += (u.pm >= segt[k]) ? 1 : 0;
        u.boffb = (size_t)e * estride_b + (size_t)u.ks * KS * 2; u.aoffb = (size_t)u.ks * KS * 2; return true;
    }
    __device__ __forceinline__ void a_ready(const Unit&) const {}
    __device__ __forceinline__ void done(const Unit&) const {}
};
struct EpiPart {
    static constexpr bool PERM = true, AFTER_DRAIN = false;
    bf16_t* P; int ldc, base, ptiles; float s;
    __device__ __forceinline__ void operator()(const f32x4 (&acc)[2][2][4][2], const Unit& u, int wr, int wc, int fr, int fq) const {
        const int row0 = (u.ks * ptiles + (u.pm - base)) * BM + wr * 64 + fr, col0 = u.pn * BM + wc * 32 + 8 * fq;
#pragma unroll
        for (int ai = 0; ai < 2; ++ai)
#pragma unroll
            for (int m = 0; m < 4; ++m) { bf16_t* rowp = P + (size_t)(row0 + ai * HALF + m * 16) * ldc + col0;
#pragma unroll
                for (int bj = 0; bj < 2; ++bj) { const f32x4 v0 = acc[ai][bj][m][0] * s, v1 = acc[ai][bj][m][1] * s;
                    u32x4 w; w.x = cvt_pk_bf16(v0[0], v0[1]); w.y = cvt_pk_bf16(v0[2], v0[3]); w.z = cvt_pk_bf16(v1[0], v1[1]); w.w = cvt_pk_bf16(v1[2], v1[3]);
                    *(u32x4*)(rowp + bj * HALF) = w; } }
    }
};

template <class Epi, class Sched, bool ALIGN_EPI = false, bool SP2 = false, bool FP8 = false>
__device__ __forceinline__ void gemm_phase(PG8_LAS unsigned char* lds, const Gemm g, const Sched& S, const Epi& E) {
    const int tid = threadIdx.x, wid = __builtin_amdgcn_readfirstlane(tid >> 6), lane = tid & 63, wr = wid >> 2, wc = wid & 3, fr = lane & 15, fq = lane >> 4;
    const int K = g.K, nt = K / BK, LD = g.ld ? g.ld : g.K;
    unsigned voffA[2], voffB[2];
#pragma unroll
    for (int i = 0; i < 2; ++i) { int R, C; stage_rc(tid * 16 + i * 8192, R, C); const int Rb = Epi::PERM ? ((R & ~31) + perm32(R & 31)) : R;
        voffA[i] = (unsigned)(R * LD + C) * 2u; voffB[i] = (unsigned)(Rb * LD + C) * 2u; }
    const size_t kstep = (size_t)(BK * 2);
    const size_t hstep = (size_t)HALF * LD * 2;
    const size_t tstep = 2 * hstep;
    const unsigned ldsw = (unsigned)wid * 1024u;
    const int aoff = lds_byte(wr * 64 + fr, fq * 8), boff = lds_byte(wc * 32 + fr, fq * 8);
#define PG8_SA(b, h) (((b) * 2 + (h)) * HTB)
#define PG8_SB(b, h) ((4 + (b) * 2 + (h)) * HTB)
#define PG8_STAGE(bufoff, gbase, voff) do { _Pragma("unroll") for (int _i = 0; _i < 2; ++_i) \
        __builtin_amdgcn_global_load_lds((const unsigned*)((const char*)(gbase) + (voff)[_i]), (PG8_LAS unsigned*)(lds + (bufoff) + ldsw + _i * 8192), 16, 0, 0); } while (0)
#define PG8_LDA(dst, b, h) do { if constexpr (FP8) { _Pragma("unroll") for (int m = 0; m < 4; ++m) { const i32x4 lo_ = *(const PG8_LAS i32x4*)(lds + PG8_SA(b, h) + aoff + m * 2048), hi_ = *(const PG8_LAS i32x4*)(lds + PG8_SA(b, h) + aoff + m * 2048 + 1024); \
            dst##8[m] = __builtin_shufflevector(lo_, hi_, 0, 1, 2, 3, 4, 5, 6, 7); } } \
        else { _Pragma("unroll") for (int m = 0; m < 4; ++m) _Pragma("unroll") for (int k = 0; k < 2; ++k) dst[m][k] = *(const PG8_LAS bf16x8*)(lds + PG8_SA(b, h) + aoff + m * 2048 + k * 1024); } } while (0)
#define PG8_LDB(dst, b, h) do { if constexpr (FP8) { _Pragma("unroll") for (int n = 0; n < 2; ++n) { const i32x4 lo_ = *(const PG8_LAS i32x4*)(lds + PG8_SB(b, h) + boff + n * 2048), hi_ = *(const PG8_LAS i32x4*)(lds + PG8_SB(b, h) + boff + n * 2048 + 1024); \
            dst##8[n] = __builtin_shufflevector(lo_, hi_, 0, 1, 2, 3, 4, 5, 6, 7); } } \
        else { _Pragma("unroll") for (int n = 0; n < 2; ++n) _Pragma("unroll") for (int k = 0; k < 2; ++k) dst[n][k] = *(const PG8_LAS bf16x8*)(lds + PG8_SB(b, h) + boff + n * 2048 + k * 1024); } } while (0)
#define PG8_MMA(ai, bj, At, Bt) do { __builtin_amdgcn_s_setprio(1); \
        if constexpr (FP8) { _Pragma("unroll") for (int m = 0; m < 4; ++m) _Pragma("unroll") for (int n = 0; n < 2; ++n) \
            asm volatile("v_mfma_scale_f32_16x16x128_f8f6f4 %0, %1, %2, %0, %3, %3 op_sel_hi:[0,0,0]" : "+v"(acc[ai][bj][m][n]) : "v"(Bt##8[n]), "v"(At##8[m]), "v"(fp8_one)); } \
        else { _Pragma("unroll") for (int m = 0; m < 4; ++m) _Pragma("unroll") for (int n = 0; n < 2; ++n) _Pragma("unroll") for (int k = 0; k < 2; ++k) \
            acc[ai][bj][m][n] = __builtin_amdgcn_mfma_f32_16x16x32_bf16(Bt[n][k], At[m][k], acc[ai][bj][m][n], 0, 0, 0); } \
        __builtin_amdgcn_s_setprio(0); } while (0)
#define PG8_WAIT_V(n) asm volatile("s_waitcnt vmcnt(" #n ")" ::: "memory")
#define PG8_WAIT_L(n) asm volatile("s_waitcnt lgkmcnt(" #n ")" ::: "memory")
#define PG8_BAR __builtin_amdgcn_s_barrier()
#define PG8_SCHED __builtin_amdgcn_sched_barrier(0)
    Unit cur, nxt; int ui = 0;
    if (!S.next(0, cur)) return;
    f32x4 acc[2][2][4][2];
#pragma unroll
    for (int a = 0; a < 2; ++a)
#pragma unroll
        for (int b = 0; b < 2; ++b)
#pragma unroll
            for (int m = 0; m < 4; ++m)
#pragma unroll
                for (int n = 0; n < 2; ++n) acc[a][b][m][n] = (f32x4){0.f, 0.f, 0.f, 0.f};
    bf16x8 At[4][2], B0[2][2], B1[2][2];
    i32x8 At8[4], B08[2], B18[2];
    int fp8_one = 0x7F7F7F7F; if constexpr (FP8) asm volatile("" : "+v"(fp8_one));
    const char* cA = (const char*)g.A + (size_t)cur.pm * tstep + cur.aoffb; const char* cB = (const char*)g.Bt + (size_t)cur.pn * tstep + cur.boffb;
    S.a_ready(cur);
    if constexpr (SP2) {
        PG8_STAGE(PG8_SB(0, 0), cB, voffB); PG8_STAGE(PG8_SB(0, 1), cB + hstep, voffB); PG8_STAGE(PG8_SA(0, 0), cA, voffA); PG8_STAGE(PG8_SA(0, 1), cA + hstep, voffA);
        if (wr == 1) PG8_BAR;
        PG8_WAIT_V(2); PG8_BAR;
        PG8_STAGE(PG8_SB(1, 0), cB + kstep, voffB); PG8_STAGE(PG8_SA(1, 0), cA + kstep, voffA); PG8_STAGE(PG8_SB(1, 1), cB + hstep + kstep, voffB);
        PG8_WAIT_V(6); PG8_BAR;
    } else {
        PG8_STAGE(PG8_SB(0, 0), cB, voffB); PG8_STAGE(PG8_SA(0, 0), cA, voffA); PG8_STAGE(PG8_SB(0, 1), cB + hstep, voffB); PG8_STAGE(PG8_SA(0, 1), cA + hstep, voffA);
        if (wr == 1) PG8_BAR;
        PG8_WAIT_V(4); PG8_BAR;
        PG8_STAGE(PG8_SB(1, 0), cB + kstep, voffB); PG8_STAGE(PG8_SA(1, 0), cA + kstep, voffA); PG8_STAGE(PG8_SB(1, 1), cB + hstep + kstep, voffB);
        PG8_WAIT_V(6); PG8_BAR;
    }
    for (;;) {
        const bool has_next = S.next(ui + 1, nxt);
        const char* nA = has_next ? (const char*)g.A + (size_t)nxt.pm * tstep + nxt.aoffb : cA; const char* nB = has_next ? (const char*)g.Bt + (size_t)nxt.pn * tstep + nxt.boffb : cB;
#pragma unroll 1
        for (int t = 0; t < nt; t += 2) {
            const bool last = (t == nt - 2);
            const char* a1 = cA + (size_t)(t + 1) * kstep;
            const char* a2 = last ? nA : cA + (size_t)(t + 2) * kstep; const char* b2 = last ? nB : cB + (size_t)(t + 2) * kstep;
            const char* a3 = a2 + kstep; const char* b3 = b2 + kstep;
            if (last && has_next) S.a_ready(nxt);
            if constexpr (SP2) {
            PG8_LDB(B0, 0, 0); PG8_LDB(B1, 0, 1); PG8_SCHED; PG8_LDA(At, 0, 0); PG8_STAGE(PG8_SA(1, 1), a1 + hstep, voffA);
            PG8_WAIT_V(8); PG8_WAIT_L(0); PG8_BAR; PG8_MMA(0, 0, At, B0); PG8_MMA(0, 1, At, B1); PG8_BAR; PG8_SCHED;
            PG8_LDA(At, 0, 1); PG8_STAGE(PG8_SB(0, 0), b2, voffB); PG8_STAGE(PG8_SB(0, 1), b2 + hstep, voffB); PG8_STAGE(PG8_SA(0, 0), a2, voffA);
            PG8_WAIT_V(8); PG8_WAIT_L(0); PG8_BAR; PG8_MMA(1, 0, At, B0); PG8_MMA(1, 1, At, B1); PG8_BAR; PG8_SCHED;
            PG8_LDB(B0, 1, 0); PG8_LDB(B1, 1, 1); PG8_SCHED; PG8_LDA(At, 1, 0); PG8_STAGE(PG8_SA(0, 1), a2 + hstep, voffA);
            PG8_WAIT_V(8); PG8_WAIT_L(0); PG8_BAR; PG8_MMA(0, 0, At, B0); PG8_MMA(0, 1, At, B1); PG8_BAR; PG8_SCHED;
            PG8_LDA(At, 1, 1); PG8_STAGE(PG8_SB(1, 0), b3, voffB); PG8_STAGE(PG8_SB(1, 1), b3 + hstep, voffB); PG8_STAGE(PG8_SA(1, 0), a3, voffA);
            PG8_WAIT_V(8); PG8_WAIT_L(0); PG8_BAR; PG8_MMA(1, 0, At, B0); PG8_MMA(1, 1, At, B1); PG8_BAR; PG8_SCHED;
            } else {
            PG8_LDB(B0, 0, 0); PG8_SCHED; PG8_LDA(At, 0, 0); PG8_STAGE(PG8_SA(1, 1), a1 + hstep, voffA);
            PG8_WAIT_L(8); PG8_BAR; PG8_WAIT_L(0); PG8_MMA(0, 0, At, B0); PG8_BAR; PG8_SCHED;
            PG8_LDB(B1, 0, 1); PG8_STAGE(PG8_SB(0, 0), b2, voffB);
            PG8_BAR; PG8_WAIT_L(0); PG8_MMA(0, 1, At, B1); PG8_BAR;
            PG8_LDA(At, 0, 1); PG8_STAGE(PG8_SA(0, 0), a2, voffA);
            PG8_BAR; PG8_WAIT_L(0); PG8_MMA(1, 0, At, B0); PG8_BAR; PG8_SCHED;
            PG8_STAGE(PG8_SB(0, 1), b2 + hstep, voffB);
            PG8_WAIT_V(6); PG8_BAR; PG8_MMA(1, 1, At, B1); PG8_BAR;
            PG8_LDB(B0, 1, 0); PG8_SCHED; PG8_LDA(At, 1, 0); PG8_STAGE(PG8_SA(0, 1), a2 + hstep, voffA);
            PG8_WAIT_L(8); PG8_BAR; PG8_WAIT_L(0); PG8_MMA(0, 0, At, B0); PG8_BAR; PG8_SCHED;
            PG8_LDB(B1, 1, 1); PG8_STAGE(PG8_SB(1, 0), b3, voffB);
            PG8_BAR; PG8_WAIT_L(0); PG8_MMA(0, 1, At, B1); PG8_BAR;
            PG8_LDA(At, 1, 1); PG8_STAGE(PG8_SA(1, 0), a3, voffA);
            PG8_BAR; PG8_WAIT_L(0); PG8_MMA(1, 0, At, B0); PG8_BAR; PG8_SCHED;
            PG8_STAGE(PG8_SB(1, 1), b3 + hstep, voffB);
            PG8_WAIT_V(6); PG8_BAR; PG8_MMA(1, 1, At, B1); PG8_BAR;
            }
        }
        if constexpr (FP8) asm volatile("s_nop 15\n\ts_nop 15" ::: "memory");
        if constexpr (ALIGN_EPI) { if (wr == 0) PG8_BAR; }
        if constexpr (!Epi::AFTER_DRAIN) { E(acc, cur, wr, wc, fr, fq); S.done(cur); }
        if (!has_next) break;
#pragma unroll
        for (int a = 0; a < 2; ++a)
#pragma unroll
            for (int b = 0; b < 2; ++b)
#pragma unroll
                for (int m = 0; m < 4; ++m)
#pragma unroll
                    for (int n = 0; n < 2; ++n) acc[a][b][m][n] = (f32x4){0.f, 0.f, 0.f, 0.f};
        cur = nxt; cA = nA; cB = nB; ++ui;
        if constexpr (ALIGN_EPI) { if (wr == 1) PG8_BAR; }
    }
    PG8_WAIT_V(0);
    if constexpr (!ALIGN_EPI) { if (wr == 0) PG8_BAR; }
    PG8_BAR;
    if constexpr (Epi::AFTER_DRAIN) { E.fused(acc, cur, wr, wc, fr, fq, lds, wid, lane); S.done(cur); }
#undef PG8_SA
#undef PG8_SB
#undef PG8_STAGE
#undef PG8_LDA
#undef PG8_LDB
#undef PG8_MMA
#undef PG8_WAIT_V
#undef PG8_WAIT_L
#undef PG8_BAR
#undef PG8_SCHED
}
}
#define GAS __attribute__((address_space(1)))
#define LAS __attribute__((address_space(3)))
typedef unsigned short bf16;
typedef unsigned v4u __attribute__((ext_vector_type(4)));
typedef float f32x4 __attribute__((ext_vector_type(4)));
typedef short bf16x8 __attribute__((ext_vector_type(8)));
typedef GAS unsigned gu32;
typedef GAS unsigned long long gu64;
#define RLX_AGENT __ATOMIC_RELAXED, __HIP_MEMORY_SCOPE_AGENT
#define LDS_WAIT() asm volatile("s_waitcnt lgkmcnt(0)" ::: "memory")
#define VM_WAIT() asm volatile("s_waitcnt vmcnt(0)" ::: "memory")
__device__ __forceinline__ unsigned long long rt() { return __builtin_amdgcn_s_memrealtime(); }
__device__ __forceinline__ unsigned f2bf(float f) { unsigned u = __builtin_bit_cast(unsigned, f); return (u + 0x7fffu + ((u >> 16) & 1u)) >> 16; }
typedef float pk_f32x2_t __attribute__((ext_vector_type(2))); typedef __bf16 pk_bf16x2_t __attribute__((ext_vector_type(2)));
__device__ __forceinline__ unsigned pk2(float lo, float hi) { const pk_f32x2_t v = {lo, hi}; return __builtin_bit_cast(unsigned, __builtin_convertvector(v, pk_bf16x2_t)); }

#define XB_TMO      128
#define XB_XCNT(j)  (256  + 64 * (j))
#define XB_XSUB(j)  (1280 + 64 * (j))
#define XB_XGEN(j)  (2304 + 64 * (j))
#define XB_TOP      3328
#define XB_TOPGEN   3392
#define XCD_BAR_WORDS 3456
#define XB_SPIN_CAP (1u << 18)

__device__ __forceinline__ unsigned xb_ld(unsigned* p)              { return __hip_atomic_load(p, __ATOMIC_RELAXED, __HIP_MEMORY_SCOPE_AGENT); }
__device__ __forceinline__ unsigned xb_add(unsigned* p, unsigned v) { return __hip_atomic_fetch_add(p, v, __ATOMIC_RELAXED, __HIP_MEMORY_SCOPE_AGENT); }
__device__ __forceinline__ unsigned xb_xcc_id() { return (unsigned)__builtin_amdgcn_s_getreg((3 << 11) | 20) & 0xFu; }
#define XB_SPIN(cond, bar) do { unsigned _sp = 0; while (cond) { __builtin_amdgcn_s_sleep(1); \
    if ((++_sp & 255u) == 0u) { if (xb_ld(&(bar)[XB_TMO])) break; if (_sp > XB_SPIN_CAP) { atomicAdd(&(bar)[XB_TMO], 1u); break; } } } } while (0)

struct XcdBarrier {
    unsigned* bar; unsigned x;
    volatile LAS unsigned* st;
};

__device__ __forceinline__ XcdBarrier xcd_barrier_post(unsigned* bar, volatile LAS unsigned* st) {
    XcdBarrier b; b.bar = bar; b.x = xb_xcc_id(); b.st = st;
    if (threadIdx.x == 0) (void)xb_add(&bar[XB_XCNT(b.x)], 1u);
    return b;
}
__device__ __forceinline__ void xcd_barrier_complete(unsigned* bar, unsigned x, unsigned& nloc, unsigned& nx) {
    const unsigned G = gridDim.x * gridDim.y * gridDim.z;
    unsigned sum, cnt, mine, sp = 0u;
    for (;;) {
        sum = 0u; cnt = 0u; mine = 0u;
#pragma unroll
        for (unsigned j = 0; j < 16; ++j) { const unsigned c = xb_ld(&bar[XB_XCNT(j)]); sum += c; cnt += (c > 0u) ? 1u : 0u; mine = (j == x) ? c : mine; }
        if (sum == G) break;
        __builtin_amdgcn_s_sleep(1);
        if ((++sp & 255u) == 0u) { if (xb_ld(&bar[XB_TMO])) break; if (sp > XB_SPIN_CAP) { atomicAdd(&bar[XB_TMO], 1u); break; } }
    }
    nloc = mine > 0u ? mine : 1u; nx = cnt > 0u ? cnt : 1u;
}

__device__ __forceinline__ void xcd_barrier(const XcdBarrier& b) {
    asm volatile("s_waitcnt vmcnt(0)" ::: "memory");
    __syncthreads();
    if (threadIdx.x == 0) {
        unsigned* bar = b.bar;
        __builtin_amdgcn_s_waitcnt(0);
        unsigned nloc = b.st[0], nx = b.st[1];
        if (nloc == 0u) { xcd_barrier_complete(bar, b.x, nloc, nx); b.st[0] = nloc; b.st[1] = nx; }
        const unsigned old = xb_add(&bar[XB_XSUB(b.x)], 1u);
        const unsigned gen = old / nloc;
        if (old + 1u == (gen + 1u) * nloc) {
            __builtin_amdgcn_fence(__ATOMIC_RELEASE, "agent");
            asm volatile("s_waitcnt vmcnt(0)" ::: "memory");
            const unsigned og = xb_add(&bar[XB_TOP], 1u);
            const unsigned tg = og / nx;
            if (og + 1u == (tg + 1u) * nx) xb_add(&bar[XB_TOPGEN], 1u);
            else XB_SPIN(xb_ld(&bar[XB_TOPGEN]) == tg, bar);
            __builtin_amdgcn_fence(__ATOMIC_ACQUIRE, "agent");
            xb_add(&bar[XB_XGEN(b.x)], 1u);
            asm volatile("s_waitcnt vmcnt(0)" ::: "memory");
        } else {
            XB_SPIN(xb_ld(&bar[XB_XGEN(b.x)]) == gen, bar);
            __builtin_amdgcn_fence(__ATOMIC_ACQUIRE, "agent");
            asm volatile("s_waitcnt vmcnt(0)" ::: "memory");
        }
    }
    __syncthreads();
}


constexpr int NWAVES = 8;
constexpr int NBATCH = 8, SEQ = 4096, M = NBATCH * SEQ, D = 1024, DIN = 2560, DA = 512, DL = 512, NH = 8, HD = 64;
constexpr int DFF = 2816, NE = 8, DFE = 3584;
constexpr int SORT_ROWS = 2 * M + NE * 256, NT_MAX = SORT_ROWS / 256;
constexpr int CHUNK_TILES = 128, NCHUNK = (NT_MAX + CHUNK_TILES - 1) / CHUNK_TILES;
constexpr float ALPHA = 1.4142135623730951f, LN_EPS = 1e-5f, RMS_EPS = 1e-6f;
constexpr float LOG2E = 1.4426950408889634f, QSCALE = 0.125f * LOG2E;
constexpr int PH_PRO = 0, PH_L0 = 1, PH_L1 = 9;
constexpr int PH_DISPATCH = 14, PH_MOE0 = 15, PH_COMBINE = PH_MOE0 + 2 * NCHUNK, NPH = PH_COMBINE + 1;
constexpr size_t MiB = 1u << 20;
constexpr size_t WS_CTL = 0, CTL_ZERO_BYTES = 1 * MiB;
constexpr size_t WS_TOKE = 1 * MiB, WS_TOKP = WS_TOKE + 256 * 1024, WS_TOKPOS = WS_TOKP + 256 * 1024, WS_SEG = WS_TOKPOS + 256 * 1024;
constexpr size_t WS_LRUW = 2 * MiB;
constexpr size_t WS_LSE = 3 * MiB, WS_AGG = 6 * MiB;
constexpr size_t WS_WIN = 8 * MiB, WS_WOUT = 18 * MiB, WS_WGU = 22 * MiB, WS_WD = 33 * MiB, WS_MGU = 39 * MiB, WS_MD = 95 * MiB;
constexpr size_t WS_XB = 207 * MiB;
constexpr size_t WS_Q = 271 * MiB, WS_K = 303 * MiB, WS_V = 335 * MiB, WS_U = 367 * MiB, WS_G = 399 * MiB;
constexpr size_t WS_O0 = 39 * MiB, WS_O1 = 71 * MiB, WS_O2 = 103 * MiB;
constexpr size_t WS_LA = 135 * MiB, WS_BE = 167 * MiB;
constexpr size_t WS_Y = WS_Q;
constexpr size_t WS_HB = 271 * MiB, WS_X8 = 359 * MiB;
constexpr int TAIL_KS = 512, TAIL_NS = DFE / TAIL_KS, TAIL_TILES = NT_MAX - (NCHUNK - 1) * CHUNK_TILES;
constexpr size_t WS_PART = 8 * MiB;
static_assert(WS_PART + (size_t)TAIL_NS * TAIL_TILES * 256 * D * 2 <= 39 * MiB, "tail partials");
constexpr size_t WS_HCA = 151 * MiB, WS_XS8 = 271 * MiB, WS_YS = 337 * MiB, WS_END = 469 * MiB;
constexpr float MOE_HSCALE = 8.0f, MOE_DSCALE = 128.0f;
constexpr float MOE_WSCALE = 32.0f;
static_assert(WS_MGU + (size_t)NE * 2 * DFE * D <= WS_MD && WS_MD + (size_t)NE * D * DFE <= WS_HCA && WS_HCA + (size_t)TAIL_TILES * 256 * DFE <= WS_XB && (size_t)CHUNK_TILES * 256 * DFE <= (size_t)M * D * 4 && WS_XS8 + (size_t)SORT_ROWS * D <= WS_YS && WS_YS + (size_t)SORT_ROWS * D * 2 <= WS_END, "d_ws map");
constexpr int CW_TMO = 0, CW_CODE = 1, CW_BAR = 4096;
constexpr unsigned long long PROBE_MASK = 0ull; constexpr unsigned PROBE_K = 8; constexpr int PROBE_SEAM = -1;
constexpr int RING_OFF = 0, RING_BYTES = 131072;
constexpr int LDSCTL_OFF = RING_BYTES, MISC_OFF = LDSCTL_OFF + 320;
constexpr int LDS_BYTES = 147456;

typedef int v4i __attribute__((ext_vector_type(4)));
typedef unsigned v2u __attribute__((ext_vector_type(2)));
typedef float f32x2 __attribute__((ext_vector_type(2)));
struct Frame {
    LAS unsigned char* lds;
    volatile LAS unsigned* MISC;
    gu32* ctl;
    int tid, lane, wave;
    int vcu, G;
    unsigned long long pt0, pacc;
};
__device__ __forceinline__ int fresh_lane() { int l; asm volatile("v_mbcnt_lo_u32_b32 %0, -1, 0\n\tv_mbcnt_hi_u32_b32 %0, -1, %0" : "=v"(l)); return l; }
struct Args { const float* in[24]; float* out; unsigned char* ws; int ph_lo, ph_hi, li, pad; };

__device__ __forceinline__ float wave_sum(float v) {
#pragma unroll
    for (int o = 1; o < 64; o <<= 1) v += __shfl_xor(v, o);
    return v;
}
__device__ __forceinline__ float bf2f(bf16 h) { return __uint_as_float((unsigned)h << 16); }
__device__ __forceinline__ float bflo(unsigned w) { return __uint_as_float(w << 16); }
__device__ __forceinline__ float bfhi(unsigned w) { return __uint_as_float(w & 0xffff0000u); }

__device__ __forceinline__ void transpose_item(const float* W, int N, bf16* WT, int ldt, int dst_row0, LAS float* scr, int kb, int nb, int lane) {
    const int k0 = 64 * kb, n0 = 32 * nb;
    f32x4 v[8];
#pragma unroll
    for (int i = 0; i < 8; ++i) v[i] = *(const GAS f32x4*)(W + (size_t)(k0 + 8 * i + (lane >> 3)) * N + n0 + 4 * (lane & 7));
#pragma unroll
    for (int i = 0; i < 8; ++i) { LAS float* d = scr + (8 * i + (lane >> 3)) * 33 + 4 * (lane & 7); d[0] = v[i].x; d[1] = v[i].y; d[2] = v[i].z; d[3] = v[i].w; }
    LDS_WAIT(); asm volatile("" ::: "memory");
    const int c = lane & 7;
#pragma unroll
    for (int j = 0; j < 4; ++j) { const int n = (lane >> 3) + 8 * j; const LAS float* s = scr + (8 * c) * 33 + n;
        v4u o; o.x = pk2(s[0 * 33], s[1 * 33]); o.y = pk2(s[2 * 33], s[3 * 33]); o.z = pk2(s[4 * 33], s[5 * 33]); o.w = pk2(s[6 * 33], s[7 * 33]);
        *(GAS v4u*)(WT + (size_t)(dst_row0 + n) * ldt + k0 + 8 * c) = o; }
    LDS_WAIT(); asm volatile("" ::: "memory");
}
__device__ __forceinline__ unsigned pk4_fp8(float a, float b, float c, float d) {
    a = __builtin_fminf(__builtin_fmaxf(a, -448.f), 448.f); b = __builtin_fminf(__builtin_fmaxf(b, -448.f), 448.f); c = __builtin_fminf(__builtin_fmaxf(c, -448.f), 448.f); d = __builtin_fminf(__builtin_fmaxf(d, -448.f), 448.f);
    unsigned w = 0u; w = __builtin_amdgcn_cvt_pk_fp8_f32(a, b, w, false); w = __builtin_amdgcn_cvt_pk_fp8_f32(c, d, w, true); return w;
}
__device__ __forceinline__ void transpose_item_fp8(const float* W, int N, unsigned char* WT8, int ldt, int dst_row0, LAS float* scr, int kb, int nb, int lane, float scale) {
    const int k0 = 64 * kb, n0 = 32 * nb;
    f32x4 v[8];
#pragma unroll
    for (int i = 0; i < 8; ++i) v[i] = *(const GAS f32x4*)(W + (size_t)(k0 + 8 * i + (lane >> 3)) * N + n0 + 4 * (lane & 7));
#pragma unroll
    for (int i = 0; i < 8; ++i) { LAS float* d = scr + (8 * i + (lane >> 3)) * 33 + 4 * (lane & 7); d[0] = v[i].x * scale; d[1] = v[i].y * scale; d[2] = v[i].z * scale; d[3] = v[i].w * scale; }
    LDS_WAIT(); asm volatile("" ::: "memory");
    const int c = lane & 3;
#pragma unroll
    for (int j = 0; j < 2; ++j) { const int n = (lane >> 2) + 16 * j; const LAS float* s = scr + (16 * c) * 33 + n;
        v4u o; o.x = pk4_fp8(s[0 * 33], s[1 * 33], s[2 * 33], s[3 * 33]); o.y = pk4_fp8(s[4 * 33], s[5 * 33], s[6 * 33], s[7 * 33]);
        o.z = pk4_fp8(s[8 * 33], s[9 * 33], s[10 * 33], s[11 * 33]); o.w = pk4_fp8(s[12 * 33], s[13 * 33], s[14 * 33], s[15 * 33]);
        *(GAS v4u*)(WT8 + (size_t)(dst_row0 + n) * ldt + k0 + 16 * c) = o; }
    LDS_WAIT(); asm volatile("" ::: "memory");
}
__device__ __forceinline__ void tr_gu8(const float* W, int K, int N, unsigned char* WT8, int half, LAS float* scr, int item, int lane, float scale) {
    const int nblk = N / 32, kb = item / nblk, nb = item % nblk, n0 = 32 * nb; transpose_item_fp8(W, N, WT8, K, (n0 >> 7) * 256 + half * 128 + (n0 & 127), scr, kb, nb, lane, scale);
}
__device__ __forceinline__ void tr_plain8(const float* W, int K, int N, unsigned char* WT8, LAS float* scr, int item, int lane, float scale) {
    const int nblk = N / 32, kb = item / nblk, nb = item % nblk; transpose_item_fp8(W, N, WT8, K, 32 * nb, scr, kb, nb, lane, scale);
}
__device__ __forceinline__ void tr_plain(const float* W, int K, int N, bf16* WT, LAS float* scr, int item, int lane) {
    const int nblk = N / 32, kb = item / nblk, nb = item % nblk; transpose_item(W, N, WT, K, 32 * nb, scr, kb, nb, lane);
}
__device__ __forceinline__ void tr_gu(const float* W, int K, int N, bf16* WT, int half, LAS float* scr, int item, int lane) {
    const int nblk = N / 32, kb = item / nblk, nb = item % nblk, n0 = 32 * nb; transpose_item(W, N, WT, K, (n0 >> 7) * 256 + half * 128 + (n0 & 127), scr, kb, nb, lane);
}

__device__ __forceinline__ void phase_prologue(Frame& F, const Args& a) {
    LAS float* scr = (LAS float*)(F.lds + RING_OFF + F.wave * 16384);
    const int gw = F.vcu * NWAVES + F.wave, NGW = F.G * NWAVES;
    unsigned char* ws = a.ws;
    constexpr int I_WIN = (D / 64) * (DIN / 32), I_WOUT = (D / 64) * (D / 32), I_GU = (D / 64) * (DFF / 32), I_DN = (DFF / 64) * (D / 32), I_LRU = 64;
    constexpr int NITEMS = 2 * I_WIN + 2 * I_WOUT + 2 * I_GU + I_DN + I_LRU;
    for (int it = gw; it < NITEMS; it += NGW) {
        int r = it;
        if (r < 2 * I_WIN) { const int l = r / I_WIN; r -= l * I_WIN; tr_plain(a.in[1] + (size_t)l * D * DIN, D, DIN, (bf16*)(ws + WS_WIN) + (size_t)l * DIN * D, scr, r, F.lane); continue; } r -= 2 * I_WIN;
        if (r < 2 * I_WOUT) { const int l = r / I_WOUT; r -= l * I_WOUT; tr_plain(a.in[12] + (size_t)l * D * D, D, D, (bf16*)(ws + WS_WOUT) + (size_t)l * D * D, scr, r, F.lane); continue; } r -= 2 * I_WOUT;
        if (r < I_GU) { tr_gu(a.in[17], D, DFF, (bf16*)(ws + WS_WGU), 0, scr, r, F.lane); continue; } r -= I_GU;
        if (r < I_GU) { tr_gu(a.in[18], D, DFF, (bf16*)(ws + WS_WGU), 1, scr, r, F.lane); continue; } r -= I_GU;
        if (r < I_DN) { tr_plain8(a.in[19], DFF, D, ws + WS_WD, scr, r, F.lane, MOE_DSCALE); continue; } r -= I_DN;
        { const int mi = r >> 1, it2 = r & 1, l = mi >> 4, gate = (mi >> 3) & 1, g = mi & 7;
          const float* src = (gate ? a.in[6] : a.in[4]) + (size_t)(l * 8 + g) * 4096; tr_plain(src, 64, 64, (bf16*)(ws + WS_LRUW) + (size_t)mi * 4096, scr, it2, F.lane); }
    }
    const float* x = a.in[0]; bf16* XBp = (bf16*)(ws + WS_XB);
    for (int m = gw; m < M; m += NGW) {
        const GAS f32x4* xr = (const GAS f32x4*)(x + (size_t)m * D) + F.lane; GAS unsigned long long* o8 = (GAS unsigned long long*)(XBp + (size_t)m * D) + F.lane;
#pragma unroll
        for (int j = 0; j < 4; ++j) { const f32x4 v = xr[64 * j]; o8[64 * j] = (unsigned long long)pk2(v.x, v.y) | ((unsigned long long)pk2(v.z, v.w) << 32); }
    }
}
__device__ __forceinline__ void phase_moe_cvt(Frame& F, const Args& a) {
    LAS float* scr = (LAS float*)(F.lds + RING_OFF + 32768 + F.wave * 8704);
    const int gw = F.vcu * NWAVES + F.wave, NGW = F.G * NWAVES;
    constexpr int I_MG = (D / 64) * (DFE / 32), I_MD = (DFE / 64) * (D / 32), I_E = 2 * I_MG + I_MD;
    for (int it = gw; it < NE * I_E; it += NGW) {
        const int e = it / I_E; int r = it - e * I_E;
        unsigned char* gu = a.ws + WS_MGU + (size_t)e * (2 * DFE) * D; unsigned char* dn = a.ws + WS_MD + (size_t)e * D * DFE;
        if (r < I_MG) { tr_gu8(a.in[21] + (size_t)e * D * DFE, D, DFE, gu, 0, scr, r, F.lane, MOE_WSCALE); continue; } r -= I_MG;
        if (r < I_MG) { tr_gu8(a.in[22] + (size_t)e * D * DFE, D, DFE, gu, 1, scr, r, F.lane, MOE_WSCALE); continue; } r -= I_MG;
        tr_plain8(a.in[23] + (size_t)e * DFE * D, DFE, D, dn, scr, r, F.lane, MOE_DSCALE);
    }
}
template <bool ROUTE>
__device__ __forceinline__ void phase_ln(Frame& F, bf16* XBp, const float* g, const float* b, const float* rw, int* tok_e, float* tok_p, unsigned char* X8 = nullptr) {
    const int gw = F.vcu * NWAVES + F.wave, NGW = F.G * NWAVES;
    LAS f32x4* rws = (LAS f32x4*)(F.lds + RING_OFF);
    if (ROUTE) { for (int i = F.tid; i < 2048; i += NWAVES * 64) rws[i] = ((const GAS f32x4*)rw)[i]; LDS_WAIT(); __syncthreads(); }
    f32x4 gv[4], bv[4];
#pragma unroll
    for (int j = 0; j < 2; ++j) { gv[2 * j] = ((const GAS f32x4*)g)[2 * F.lane + 128 * j]; gv[2 * j + 1] = ((const GAS f32x4*)g)[2 * F.lane + 128 * j + 1]; bv[2 * j] = ((const GAS f32x4*)b)[2 * F.lane + 128 * j]; bv[2 * j + 1] = ((const GAS f32x4*)b)[2 * F.lane + 128 * j + 1]; }
    v4u nx[2], ny[2];
    { const GAS v4u* xr = (const GAS v4u*)(XBp + (size_t)(gw < M ? gw : 0) * D) + F.lane; nx[0] = xr[0]; nx[1] = xr[64]; }
    { const int m1 = (gw + NGW < M) ? gw + NGW : 0; const GAS v4u* xr = (const GAS v4u*)(XBp + (size_t)m1 * D) + F.lane; ny[0] = xr[0]; ny[1] = xr[64]; }
    for (int m = gw; m < M; m += NGW) {
        const v4u r0 = nx[0], r1 = nx[1];
        nx[0] = ny[0]; nx[1] = ny[1];
        { const int mn = (m + 2 * NGW < M) ? m + 2 * NGW : m; const GAS v4u* xr = (const GAS v4u*)(XBp + (size_t)mn * D) + F.lane; ny[0] = xr[0]; ny[1] = xr[64]; }
        f32x4 v[4];
        v[0] = (f32x4){bflo(r0.x), bfhi(r0.x), bflo(r0.y), bfhi(r0.y)}; v[1] = (f32x4){bflo(r0.z), bfhi(r0.z), bflo(r0.w), bfhi(r0.w)};
        v[2] = (f32x4){bflo(r1.x), bfhi(r1.x), bflo(r1.y), bfhi(r1.y)}; v[3] = (f32x4){bflo(r1.z), bfhi(r1.z), bflo(r1.w), bfhi(r1.w)};
        float s = 0.f;
#pragma unroll
        for (int j = 0; j < 4; ++j) s += (v[j].x + v[j].y) + (v[j].z + v[j].w);
        const float mean = wave_sum(s) * (1.f / D); float s2 = 0.f;
#pragma unroll
        for (int j = 0; j < 4; ++j) { v[j] = v[j] - mean; s2 += (v[j].x * v[j].x + v[j].y * v[j].y) + (v[j].z * v[j].z + v[j].w * v[j].w); }
        const float rstd = 1.f / sqrtf(wave_sum(s2) * (1.f / D) + LN_EPS);
#pragma unroll
        for (int j = 0; j < 4; ++j) v[j] = v[j] * rstd * gv[j] + bv[j];
        GAS v4u* xw = (GAS v4u*)(XBp + (size_t)m * D) + F.lane;
        xw[0] = (v4u){pk2(v[0].x, v[0].y), pk2(v[0].z, v[0].w), pk2(v[1].x, v[1].y), pk2(v[1].z, v[1].w)};
        xw[64] = (v4u){pk2(v[2].x, v[2].y), pk2(v[2].z, v[2].w), pk2(v[3].x, v[3].y), pk2(v[3].z, v[3].w)};
        if (X8) { GAS v2u* x8 = (GAS v2u*)(X8 + (size_t)m * D) + F.lane;
            x8[0] = (v2u){pk4_fp8(v[0].x, v[0].y, v[0].z, v[0].w), pk4_fp8(v[1].x, v[1].y, v[1].z, v[1].w)}; x8[64] = (v2u){pk4_fp8(v[2].x, v[2].y, v[2].z, v[2].w), pk4_fp8(v[3].x, v[3].y, v[3].z, v[3].w)}; }
        if (ROUTE) {
            f32x4 la = {0.f, 0.f, 0.f, 0.f}, lb = {0.f, 0.f, 0.f, 0.f};
#pragma unroll
            for (int j = 0; j < 4; ++j)
#pragma unroll
                for (int i = 0; i < 4; ++i) { const int c = 8 * F.lane + 512 * (j >> 1) + 4 * (j & 1) + i; const f32x4 w0 = rws[2 * c], w1 = rws[2 * c + 1]; la += w0 * v[j][i]; lb += w1 * v[j][i]; }
            float lg[8];
            lg[0] = wave_sum(la.x); lg[1] = wave_sum(la.y); lg[2] = wave_sum(la.z); lg[3] = wave_sum(la.w); lg[4] = wave_sum(lb.x); lg[5] = wave_sum(lb.y); lg[6] = wave_sum(lb.z); lg[7] = wave_sum(lb.w);
            int e0 = 0; float v0 = lg[0];
#pragma unroll
            for (int e = 1; e < 8; ++e) if (lg[e] > v0) { v0 = lg[e]; e0 = e; }
            int e1 = -1; float v1 = -INFINITY;
#pragma unroll
            for (int e = 0; e < 8; ++e) if (e != e0 && lg[e] > v1) { v1 = lg[e]; e1 = e; }
            if (F.lane == 0) { const float p1 = expf(v1 - v0), den = 1.f + p1; tok_e[2 * m] = e0; tok_e[2 * m + 1] = e1; tok_p[2 * m] = 1.f / den; tok_p[2 * m + 1] = p1 / den; }
        }
    }
}
__device__ __forceinline__ void phase_dispatch(Frame& F, const int* tok_e, int* tok_pos, int* segtab, const bf16* XBp, unsigned char* XS8) {
    LAS int* s_tot = (LAS int*)(F.lds + RING_OFF); LAS int* s_bef = s_tot + 8; LAS int* s_w = s_tot + 16; LAS int* s_pos = s_tot + 32;
    for (int tile = blockIdx.x; tile < M / 128; tile += F.G) {
        __syncthreads();
        if (F.tid < 32) s_tot[F.tid] = 0;
        __syncthreads();
        int tot[8], bef[8];
#pragma unroll
        for (int e = 0; e < 8; ++e) { tot[e] = 0; bef[e] = 0; }
        const GAS v4i* te4 = (const GAS v4i*)tok_e;
        for (int i4 = F.tid; i4 < 2 * M / 4; i4 += NWAVES * 64) { const v4i ev = te4[i4]; const int before = (2 * i4 < tile * 128) ? 1 : 0;
#pragma unroll
            for (int e = 0; e < 8; ++e) { const int hit = (ev.x == e) + (ev.y == e) + (ev.z == e) + (ev.w == e); tot[e] += hit; bef[e] += before ? hit : 0; } }
#pragma unroll
        for (int e = 0; e < 8; ++e) { int a = tot[e], b = bef[e];
#pragma unroll
            for (int o = 1; o < 64; o <<= 1) { a += __shfl_xor(a, o); b += __shfl_xor(b, o); }
            if (F.lane == 0) { __hip_atomic_fetch_add(&s_tot[e], a, __ATOMIC_RELAXED, __HIP_MEMORY_SCOPE_WORKGROUP); __hip_atomic_fetch_add(&s_bef[e], b, __ATOMIC_RELAXED, __HIP_MEMORY_SCOPE_WORKGROUP); } }
        int e0 = -1, e1 = -1, rk0 = 0, rk1 = 0; const int tok = tile * 128 + F.tid;
        if (F.wave < 2) { e0 = tok_e[2 * tok]; e1 = tok_e[2 * tok + 1];
#pragma unroll
            for (int e = 0; e < 8; ++e) { const bool has = (e0 == e) || (e1 == e); const unsigned long long mask = __ballot(has); const int rk = __popcll(mask & ((1ull << F.lane) - 1ull));
                if (e0 == e) rk0 = rk; if (e1 == e) rk1 = rk; if (F.lane == 0) s_w[F.wave * 8 + e] = __popcll(mask); } }
        LDS_WAIT(); __syncthreads();
        int seg[9]; seg[0] = 0;
#pragma unroll
        for (int e = 0; e < 8; ++e) seg[e + 1] = seg[e] + ((s_tot[e] + 255) & ~255);
        if (F.wave < 2) { int p0 = 0, p1 = 0;
#pragma unroll
            for (int e = 0; e < 8; ++e) { const int wp = (F.wave == 1) ? s_w[e] : 0; if (e0 == e) p0 = seg[e] + s_bef[e] + wp + rk0; if (e1 == e) p1 = seg[e] + s_bef[e] + wp + rk1; }
            tok_pos[2 * tok] = p0; tok_pos[2 * tok + 1] = p1; s_pos[2 * F.tid] = p0; s_pos[2 * F.tid + 1] = p1; }
        if (tile == 0) {
#pragma unroll
            for (int k = 0; k < 9; ++k) if (F.tid == k) segtab[k] = seg[k] >> 8;
        }
        LDS_WAIT(); __syncthreads();
        for (int i0 = F.wave * 16; i0 < F.wave * 16 + 16; i0 += 4) { v4u ra[4], rb[4];
#pragma unroll
            for (int j = 0; j < 4; ++j) { const GAS v4u* src = (const GAS v4u*)(XBp + (size_t)(tile * 128 + i0 + j) * D) + F.lane; ra[j] = src[0]; rb[j] = src[64]; }
#pragma unroll
            for (int j = 0; j < 4; ++j) { const int p0 = s_pos[2 * (i0 + j)], p1 = s_pos[2 * (i0 + j) + 1];
                v2u qa, qb;
                qa.x = pk4_fp8(bflo(ra[j].x), bfhi(ra[j].x), bflo(ra[j].y), bfhi(ra[j].y)); qa.y = pk4_fp8(bflo(ra[j].z), bfhi(ra[j].z), bflo(ra[j].w), bfhi(ra[j].w));
                qb.x = pk4_fp8(bflo(rb[j].x), bfhi(rb[j].x), bflo(rb[j].y), bfhi(rb[j].y)); qb.y = pk4_fp8(bflo(rb[j].z), bfhi(rb[j].z), bflo(rb[j].w), bfhi(rb[j].w));
                GAS v2u* d0 = (GAS v2u*)(XS8 + (size_t)p0 * D) + F.lane; d0[0] = qa; d0[64] = qb;
                GAS v2u* d1 = (GAS v2u*)(XS8 + (size_t)p1 * D) + F.lane; d1[0] = qa; d1[64] = qb; } }
    }
}
__device__ __forceinline__ void phase_combine(Frame& F, const bf16* XBp, float* outp, const bf16* YS, const int* tok_pos, const float* tok_p, const float* g, const float* b, const bf16* PART, const int mode, const int tail_row0, const int gw, const int NGW) {
    f32x4 gv[4], bv[4];
#pragma unroll
    for (int j = 0; j < 4; ++j) { gv[j] = ((const GAS f32x4*)g)[F.lane + 64 * j]; bv[j] = ((const GAS f32x4*)b)[F.lane + 64 * j]; }
    for (int m = gw; m < M; m += NGW) {
        const int p0 = __builtin_amdgcn_readfirstlane(tok_pos[2 * m]), p1 = __builtin_amdgcn_readfirstlane(tok_pos[2 * m + 1]);
        const bool in_tail = (p0 >= tail_row0) || (p1 >= tail_row0);
        if ((mode == 1 && in_tail) || (mode == 2 && !in_tail)) continue;
        const float w0 = tok_p[2 * m], w1 = tok_p[2 * m + 1];
        const GAS v2u* xr = (const GAS v2u*)(XBp + (size_t)m * D) + F.lane;
        const GAS v2u* y0 = (const GAS v2u*)(YS + (size_t)p0 * D) + F.lane; const GAS v2u* y1 = (const GAS v2u*)(YS + (size_t)p1 * D) + F.lane;
        f32x4 v[4]; float s = 0.f;
#pragma unroll
        for (int j = 0; j < 4; ++j) { const v2u x = xr[64 * j]; f32x4 ya, yc;
            if (p0 >= tail_row0) { ya = (f32x4){0.f, 0.f, 0.f, 0.f};
#pragma unroll
                for (int ks = 0; ks < TAIL_NS; ++ks) { const v2u q = ((const GAS v2u*)(PART + ((size_t)ks * TAIL_TILES * 256 + (p0 - tail_row0)) * D) + F.lane)[64 * j]; ya += (f32x4){bflo(q.x), bfhi(q.x), bflo(q.y), bfhi(q.y)}; } }
            else { const v2u q = y0[64 * j]; ya = (f32x4){bflo(q.x), bfhi(q.x), bflo(q.y), bfhi(q.y)}; }
            if (p1 >= tail_row0) { yc = (f32x4){0.f, 0.f, 0.f, 0.f};
#pragma unroll
                for (int ks = 0; ks < TAIL_NS; ++ks) { const v2u q = ((const GAS v2u*)(PART + ((size_t)ks * TAIL_TILES * 256 + (p1 - tail_row0)) * D) + F.lane)[64 * j]; yc += (f32x4){bflo(q.x), bfhi(q.x), bflo(q.y), bfhi(q.y)}; } }
            else { const v2u q = y1[64 * j]; yc = (f32x4){bflo(q.x), bfhi(q.x), bflo(q.y), bfhi(q.y)}; }
            v[j].x = ALPHA * bflo(x.x) + (w0 * ya.x + w1 * yc.x); v[j].y = ALPHA * bfhi(x.x) + (w0 * ya.y + w1 * yc.y);
            v[j].z = ALPHA * bflo(x.y) + (w0 * ya.z + w1 * yc.z); v[j].w = ALPHA * bfhi(x.y) + (w0 * ya.w + w1 * yc.w);
            s += (v[j].x + v[j].y) + (v[j].z + v[j].w); }
        const float mean = wave_sum(s) * (1.f / D); float s2 = 0.f;
#pragma unroll
        for (int j = 0; j < 4; ++j) { v[j] = v[j] - mean; s2 += (v[j].x * v[j].x + v[j].y * v[j].y) + (v[j].z * v[j].z + v[j].w * v[j].w); }
        const float rstd = 1.f / sqrtf(wave_sum(s2) * (1.f / D) + LN_EPS);
        GAS f32x4* ow = (GAS f32x4*)(outp + (size_t)m * D) + F.lane;
#pragma unroll
        for (int j = 0; j < 4; ++j) ow[64 * j] = v[j] * rstd * gv[j] + bv[j];
    }
}

namespace att {
typedef float f32x16 __attribute__((ext_vector_type(16)));
typedef short s16x4 __attribute__((ext_vector_type(4)));
constexpr int NTASK = NBATCH * NH * 48;
constexpr int K_PITCH = 144, V_OFF = 384 * K_PITCH, V_DBS = 384 * 64 + 64, BIAS_OFF = V_OFF + 2 * V_DBS, TAB_OFF = BIAS_OFF + 528, NEG_OFF = TAB_OFF + 5 * 4 * 64 * 16, ATT_LDS = NEG_OFF + 4 * 64 * 16;
static_assert(ATT_LDS <= RING_BYTES && (TAB_OFF % 16) == 0, "attention LDS");
__device__ __forceinline__ int t5_bucket(int dist) {
    if (dist < 16) return dist;
    int b = 16;
    b += dist >= 22; b += dist >= 30; b += dist >= 40; b += dist >= 54; b += dist >= 73; b += dist >= 99; b += dist >= 134; b += dist >= 182;
    b += dist >= 246; b += dist >= 332; b += dist >= 450; b += dist >= 609; b += dist >= 825; b += dist >= 1117; b += dist >= 1513;
    return b;
}
__device__ __forceinline__ s16x4 vtr(LAS const unsigned char* p) { typedef short v4i16_t __attribute__((ext_vector_type(4))); return __builtin_bit_cast(s16x4, __builtin_amdgcn_ds_read_tr16_b64_v4i16((LAS v4i16_t*)p)); }
struct Task { int head, p, b, r, k, dil; };
__device__ __forceinline__ Task decode(int n, int head) { Task t; t.head = head; t.p = n >> 7; t.b = (n >> 4) & 7; const int q16 = n & 15, npair = 16 >> (2 * t.p); t.r = q16 / npair; t.k = q16 - t.r * npair; t.dil = 1 << (2 * t.p); return t; }

#define PBR(k) do { if (PROBE_MASK >> 32) { const unsigned long long t_ = rt(); if ((PROBE_MASK >> (k)) & 1ull) F.pacc += t_ - F.pt0; F.pt0 = t_; } } while (0)
__device__ __forceinline__ void attn_phase(Frame& F, const bf16* Qg, const bf16* Kg, const bf16* Vg, const float* rel_bias, bf16* O0, bf16* O1, bf16* O2, float* LSE) {
    LAS unsigned char* lds = F.lds + RING_OFF;
    LAS float* bias_l = (LAS float*)(lds + BIAS_OFF);
    LAS f32x4* tab = (LAS f32x4*)(lds + TAB_OFF);
    const int w = F.wave, l = F.lane, q_rel = l & 31, hh = l >> 5;
    const int head = (int)blockIdx.x & 7, jwg = (int)blockIdx.x >> 3, nwg = (F.G + 7 - head) >> 3;
    const int T0 = jwg, T1 = NTASK / 8;
    v4u kreg[6], vreg[6]; bf16x8 qn[4];
    int cur_hp = -1;
#define ATT_LOAD(T_) do { const Task t_ = decode(T_, head); const size_t rb_ = (size_t)t_.b * SEQ * DA + t_.head * HD; \
        _Pragma("unroll") for (int n = 0; n < 6; ++n) { const int ci = F.tid + 512 * n, kk = ci >> 3, c = ci & 7, li = 256 * t_.k - 128 + kk; \
            const bool ok_ = li >= 0; const size_t off = rb_ + (size_t)((ok_ ? li : 0) * t_.dil + t_.r) * DA + c * 8;     \
            const v4u kx_ = *(const GAS v4u*)(Kg + off), vx_ = *(const GAS v4u*)(Vg + off); kreg[n] = ok_ ? kx_ : (v4u){0u, 0u, 0u, 0u}; vreg[n] = ok_ ? vx_ : (v4u){0u, 0u, 0u, 0u}; } \
        const bf16* qp_ = Qg + rb_ + (size_t)((256 * t_.k + 32 * w + q_rel) * t_.dil + t_.r) * DA + 8 * hh; \
        _Pragma("unroll") for (int s = 0; s < 4; ++s) qn[s] = *(const GAS bf16x8*)(qp_ + 16 * s); } while (0)
    if (T0 < T1) ATT_LOAD(T0);
    for (int T = T0; T < T1; T += nwg) {
        const Task t = decode(T, head);
        const int hp = t.p;
        if (PROBE_MASK >> 32) F.pt0 = rt();
        __syncthreads();
#pragma unroll
        for (int n = 0; n < 6; ++n) { const int ci = F.tid + 512 * n, kk = ci >> 3, c = ci & 7;
            *(LAS v4u*)(lds + kk * K_PITCH + c * 16) = kreg[n];
            *(LAS v4u*)(lds + V_OFF + (c >> 2) * V_DBS + kk * 64 + (c & 3) * 16) = vreg[n]; }
        bf16x8 qf[4];
#pragma unroll
        for (int s = 0; s < 4; ++s) qf[s] = qn[s];
        if (hp != cur_hp) {
            if (F.tid < 129) bias_l[F.tid] = rel_bias[t5_bucket(F.tid * t.dil) * NH + t.head] * LOG2E;
            LDS_WAIT(); __syncthreads();
            for (int idx = F.tid; idx < 5 * 4 * 64; idx += NWAVES * 64) { const int ln = idx & 63, e4 = (idx >> 6) & 3, i = idx >> 8, qr = ln & 31, h2 = ln >> 5;
                f32x4 tv;
#pragma unroll
                for (int j = 0; j < 4; ++j) { const int k_rel = j + 8 * e4 + 4 * h2; int delta = 128 - 32 * i + qr - k_rel; const bool ok = (i != 0 || k_rel >= qr) && (i != 4 || k_rel <= qr);
                    delta = delta < 0 ? 0 : (delta > 128 ? 128 : delta); tv[j] = ok ? bias_l[delta] : -1e30f; }
                tab[idx] = tv; }
            for (int idx = F.tid; idx < 4 * 64; idx += NWAVES * 64) ((LAS f32x4*)(lds + NEG_OFF))[idx] = (f32x4){-1e30f, -1e30f, -1e30f, -1e30f};
            cur_hp = hp;
        }
        LDS_WAIT(); __syncthreads();
        PBR(32);
        if (T + nwg < T1) ATT_LOAD(T + nwg);
        f32x16 st[5];
        const LAS unsigned char* kbase = lds + (32 * w + q_rel) * K_PITCH + 16 * hh;
        const LAS f32x4* negt = (const LAS f32x4*)(lds + NEG_OFF) + l;
        float mx = -1e30f;
#pragma unroll
        for (int i = 0; i < 5; ++i) {
            const LAS f32x4* tp = (t.k == 0 && w + i < 4) ? negt : tab + (i * 4) * 64 + l;
#pragma unroll
            for (int e4 = 0; e4 < 4; ++e4) { const f32x4 tv = tp[e4 * 64];
#pragma unroll
                for (int j = 0; j < 4; ++j) st[i][4 * e4 + j] = tv[j]; }
#pragma unroll
            for (int s = 0; s < 4; ++s) { const bf16x8 kf = *(const LAS bf16x8*)(kbase + i * (32 * K_PITCH) + s * 32); st[i] = __builtin_amdgcn_mfma_f32_32x32x16_bf16(kf, qf[s], st[i], 0, 0, 0); }
        }
#pragma unroll
        for (int i = 0; i < 5; ++i)
#pragma unroll
            for (int e = 0; e < 16; ++e) mx = fmaxf(mx, st[i][e]);
        mx = fmaxf(mx, __shfl_xor(mx, 32));
        PBR(33);
        float ls[5];
#pragma unroll
        for (int i = 0; i < 5; ++i) { float a0 = 0.f, a1 = 0.f;
#pragma unroll
            for (int e = 0; e < 16; e += 2) { const float p0 = __builtin_amdgcn_exp2f(st[i][e] - mx), p1 = __builtin_amdgcn_exp2f(st[i][e + 1] - mx); st[i][e] = p0; st[i][e + 1] = p1; a0 += p0; a1 += p1; }
            ls[i] = a0 + a1; }
        float lsum = (ls[0] + ls[1]) + (ls[2] + ls[3]) + ls[4];
        lsum += __shfl_xor(lsum, 32);
        PBR(34);
        f32x16 o[2];
#pragma unroll
        for (int e = 0; e < 16; ++e) { o[0][e] = 0.f; o[1][e] = 0.f; }
        const LAS unsigned char* vb = lds + V_OFF + (32 * w + 4 * hh + ((l & 15) >> 2)) * 64 + (16 * ((l >> 4) & 1) + 4 * (l & 3)) * 2;
#pragma unroll
        for (int i = 0; i < 5; ++i)
#pragma unroll
            for (int s2 = 0; s2 < 2; ++s2) {
                v4u pw; pw.x = pk2(st[i][8 * s2 + 0], st[i][8 * s2 + 1]); pw.y = pk2(st[i][8 * s2 + 2], st[i][8 * s2 + 3]);
                pw.z = pk2(st[i][8 * s2 + 4], st[i][8 * s2 + 5]); pw.w = pk2(st[i][8 * s2 + 6], st[i][8 * s2 + 7]);
                const bf16x8 pf = __builtin_bit_cast(bf16x8, pw);
#pragma unroll
                for (int db = 0; db < 2; ++db) { const s16x4 lo = vtr(vb + db * V_DBS + i * 2048 + s2 * 1024), hi = vtr(vb + db * V_DBS + i * 2048 + s2 * 1024 + 512);
                    const bf16x8 vf = (bf16x8){lo[0], lo[1], lo[2], lo[3], hi[0], hi[1], hi[2], hi[3]};
                    o[db] = __builtin_amdgcn_mfma_f32_32x32x16_bf16(vf, pf, o[db], 0, 0, 0); }
            }
        PBR(35);
        const float inv = 1.0f / lsum;
        const size_t rowbase = (size_t)t.b * SEQ * DA + t.head * HD; const int qtok = (256 * t.k + 32 * w + q_rel) * t.dil + t.r;
        bf16* Op = (t.p == 0) ? O0 : (t.p == 1) ? O1 : O2;
        bf16* orow = Op + rowbase + (size_t)qtok * DA + 8 * hh;
#pragma unroll
        for (int db = 0; db < 2; ++db)
#pragma unroll
            for (int g = 0; g < 4; g += 2) {
                unsigned ax = pk2(o[db][4 * g] * inv, o[db][4 * g + 1] * inv), ay = pk2(o[db][4 * g + 2] * inv, o[db][4 * g + 3] * inv);
                unsigned bx = pk2(o[db][4 * g + 4] * inv, o[db][4 * g + 5] * inv), by = pk2(o[db][4 * g + 6] * inv, o[db][4 * g + 7] * inv);
                { const auto r = __builtin_amdgcn_permlane32_swap(ax, bx, false, false); ax = r[0]; bx = r[1]; }
                { const auto r = __builtin_amdgcn_permlane32_swap(ay, by, false, false); ay = r[0]; by = r[1]; }
                *(GAS v4u*)(orow + 32 * db + 8 * g) = (v4u){ax, ay, bx, by}; }
        if (hh == 0) LSE[((size_t)t.p * M + (size_t)t.b * SEQ + qtok) * NH + t.head] = mx + __builtin_amdgcn_logf(lsum);
        PBR(36);
    }
#undef ATT_LOAD
}
__device__ __forceinline__ void merge_attn_phase(Frame& F, const bf16* O0, const bf16* O1, const bf16* O2, const float* LSE, const float* g_attn, bf16* Y) {
    const int gw = F.vcu * NWAVES + F.wave, NGW = F.G * NWAVES, head = F.lane >> 3;
    const f32x4 g0 = ((const GAS f32x4*)g_attn)[2 * F.lane], g1 = ((const GAS f32x4*)g_attn)[2 * F.lane + 1];
    v4u na, nb, nc; float nl0, nl1, nl2;
#define MRG_LOAD(m_) do { const int mm_ = (m_) < M ? (m_) : 0; na = ((const GAS v4u*)(O0 + (size_t)mm_ * DA))[F.lane]; nb = ((const GAS v4u*)(O1 + (size_t)mm_ * DA))[F.lane]; nc = ((const GAS v4u*)(O2 + (size_t)mm_ * DA))[F.lane]; \
        nl0 = LSE[((size_t)0 * M + mm_) * NH + head]; nl1 = LSE[((size_t)1 * M + mm_) * NH + head]; nl2 = LSE[((size_t)2 * M + mm_) * NH + head]; } while (0)
    MRG_LOAD(gw);
    for (int m = gw; m < M; m += NGW) {
        const v4u a = na, b = nb, c = nc; const float l0 = nl0, l1 = nl1, l2 = nl2;
        MRG_LOAD(m + NGW);
        const float mx = fmaxf(l0, fmaxf(l1, l2));
        float w0 = __builtin_amdgcn_exp2f(l0 - mx), w1 = __builtin_amdgcn_exp2f(l1 - mx), w2 = __builtin_amdgcn_exp2f(l2 - mx);
        const float inv = 1.0f / (w0 + w1 + w2); w0 *= inv; w1 *= inv; w2 *= inv;
        float v[8]; float ss = 0.f;
#pragma unroll
        for (int j = 0; j < 4; ++j) { v[2 * j] = w0 * bflo(a[j]) + w1 * bflo(b[j]) + w2 * bflo(c[j]); v[2 * j + 1] = w0 * bfhi(a[j]) + w1 * bfhi(b[j]) + w2 * bfhi(c[j]); ss += v[2 * j] * v[2 * j] + v[2 * j + 1] * v[2 * j + 1]; }
        const float rs = 1.0f / sqrtf(wave_sum(ss) * (1.0f / DA) + RMS_EPS);
        v4u ov; ov.x = pk2(v[0] * rs * g0.x, v[1] * rs * g0.y); ov.y = pk2(v[2] * rs * g0.z, v[3] * rs * g0.w); ov.z = pk2(v[4] * rs * g1.x, v[5] * rs * g1.y); ov.w = pk2(v[6] * rs * g1.z, v[7] * rs * g1.w);
        ((GAS v4u*)(Y + (size_t)m * D))[F.lane] = ov;
    }
#undef MRG_LOAD
}
}

namespace lru {
constexpr int TAB_OFF = 0, STG_OFF = 10240, STG_WAVE = 16 * 68 * 4, GST_OFF = STG_OFF + NWAVES * STG_WAVE, GST_WAVE = 16 * 64 * 2, VST_OFF = GST_OFF + NWAVES * GST_WAVE, VST_WAVE = 64 * 64 * 2,
              SS_OFF = VST_OFF + NWAVES * VST_WAVE, LRU_LDS = SS_OFF + 2048;
static_assert(LRU_LDS <= RING_BYTES && (SS_OFF % 16) == 0 && (STG_OFF % 16) == 0, "LRU LDS");
constexpr int NUNIT = NBATCH * (SEQ / 64);
constexpr int FT_PITCH = 144, FT_WAVE = 64 * FT_PITCH;
static_assert(NWAVES * FT_WAVE + 2048 <= RING_BYTES, "LRU final LDS");
__device__ __forceinline__ float sigmoidf_fast(float x) { return __builtin_amdgcn_rcpf(1.0f + __builtin_amdgcn_exp2f(-LOG2E * x)); }

template <bool FINAL>
__device__ __forceinline__ void lru_phase(Frame& F, const int layer, const Args& a, const bf16* Ug, const bf16* Gg, float* AGG, bf16* Y, bf16* LAo, bf16* BEo) {
    LAS unsigned char* lds = F.lds + RING_OFF;
    LAS float* convw = (LAS float*)(lds + TAB_OFF);
    LAS float* convb = convw + 2048;
    __syncthreads();
    for (int i = F.tid; i < 2048; i += NWAVES * 64) convw[i] = a.in[2][layer * 2048 + i];
    if (F.tid < 512) convb[F.tid] = a.in[3][layer * 512 + F.tid];
    LDS_WAIT(); __syncthreads();
    const int g = F.wave, l = F.lane, c16 = l & 15, lg = l >> 4;
    float nba[4], nbx[4], c2[4];
#pragma unroll
    for (int t = 0; t < 4; ++t) { const int ch = 64 * g + 16 * t + c16; nba[t] = -LOG2E * a.in[5][layer * 512 + ch]; nbx[t] = -LOG2E * a.in[7][layer * 512 + ch]; c2[t] = -8.0f * LOG2E * log1pf(expf(-a.in[8][layer * 512 + ch])); }
    bf16x8 wf[2][4][2];
    { const bf16* Wbase = (const bf16*)(a.ws + WS_LRUW) + (size_t)(layer * 16 + g) * 4096 + c16 * 64 + 8 * lg;
#pragma unroll
      for (int gate = 0; gate < 2; ++gate)
#pragma unroll
        for (int t = 0; t < 4; ++t)
#pragma unroll
            for (int s = 0; s < 2; ++s) wf[gate][t][s] = *(const GAS bf16x8*)(Wbase + (size_t)gate * 8 * 4096 + t * 16 * 64 + s * 32); }
    LAS float* stg = (LAS float*)(lds + STG_OFF + g * STG_WAVE);
    LAS bf16* gst = (LAS bf16*)(lds + GST_OFF + g * GST_WAVE);
    LAS bf16* vst = (LAS bf16*)(lds + VST_OFF + g * VST_WAVE);
    LAS float* ssl = (LAS float*)(lds + SS_OFF);
    LAS float* stg_c = stg + (4 * lg) * 68 + c16;
    LAS bf16* gst_c = gst + (4 * lg) * 64 + c16;
    LAS bf16* vst_c = vst + (4 * lg) * 64 + c16;
    LAS float* ssl_w = ssl + (4 * lg) * 8 + g;
    for (int unit = blockIdx.x; unit < NUNIT; unit += F.G) {
        const int b = unit >> 6, c = unit & 63; const size_t tok0 = (size_t)b * SEQ + 64 * c;
        v4u un[2][4]; v4u gn[2];
#define LRU_LOAD(ss_) do { const int ts_ = 64 * c + 16 * (ss_) + c16; const size_t row_ = tok0 + 16 * (ss_) + c16; \
            _Pragma("unroll") for (int s = 0; s < 2; ++s) _Pragma("unroll") for (int w = 0; w < 4; ++w) { \
                const bool ok_ = ts_ - 3 + w >= 0; const v4u x_ = *(const GAS v4u*)(Ug + (ok_ ? row_ - 3 + w : row_) * DL + 64 * g + 32 * s + 8 * lg);     \
                un[s][w] = ok_ ? x_ : (v4u){0u, 0u, 0u, 0u}; } \
            if (FINAL) { const bf16* gp_ = Gg + (tok0 + 16 * (ss_) + (l >> 2)) * DL + 64 * g + (l & 3) * 16; gn[0] = *(const GAS v4u*)gp_; gn[1] = *(const GAS v4u*)(gp_ + 8); } } while (0)
        LRU_LOAD(0);
        float hc[4], At[4];
#pragma unroll
        for (int t = 0; t < 4; ++t) { hc[t] = 0.f; At[t] = 1.f; }
        if (FINAL) {
#pragma unroll 4
            for (int cc = 0; cc < c; ++cc) {
#pragma unroll
                for (int t = 0; t < 4; ++t) { const f32x2 ab = *(const GAS f32x2*)(AGG + ((size_t)(b * 64 + cc) * 512 + 64 * g + 16 * t + c16) * 2); hc[t] = ab.x * hc[t] + ab.y; } }
        }
#pragma unroll
        for (int ss = 0; ss < 4; ++ss) {
            if (FINAL) { *(LAS v4u*)(gst + (l >> 2) * 64 + (l & 3) * 16) = gn[0]; *(LAS v4u*)(gst + (l >> 2) * 64 + (l & 3) * 16 + 8) = gn[1]; }
            bf16x8 af[2];
#pragma unroll
            for (int s = 0; s < 2; ++s) { const int cb = 64 * g + 32 * s + 8 * lg;
                f32x4 u0 = *(const LAS f32x4*)(convb + cb), u1 = *(const LAS f32x4*)(convb + cb + 4);
#pragma unroll
                for (int w = 0; w < 4; ++w) { const v4u x = un[s][w];
                    const f32x4 w0 = *(const LAS f32x4*)(convw + w * 512 + cb), w1 = *(const LAS f32x4*)(convw + w * 512 + cb + 4);
                    u0.x += w0.x * bflo(x.x); u0.y += w0.y * bfhi(x.x); u0.z += w0.z * bflo(x.y); u0.w += w0.w * bfhi(x.y);
                    u1.x += w1.x * bflo(x.z); u1.y += w1.y * bfhi(x.z); u1.z += w1.z * bflo(x.w); u1.w += w1.w * bfhi(x.w); }
                *(LAS f32x4*)(stg + c16 * 68 + 32 * s + 8 * lg) = u0; *(LAS f32x4*)(stg + c16 * 68 + 32 * s + 8 * lg + 4) = u1;
                v4u pw; pw.x = pk2(u0.x, u0.y); pw.y = pk2(u0.z, u0.w); pw.z = pk2(u1.x, u1.y); pw.w = pk2(u1.z, u1.w); af[s] = __builtin_bit_cast(bf16x8, pw); }
            if (ss < 3) LRU_LOAD(ss + 1);
            f32x4 acc[2][4];
#pragma unroll
            for (int gate = 0; gate < 2; ++gate)
#pragma unroll
                for (int t = 0; t < 4; ++t) { acc[gate][t] = (f32x4){0.f, 0.f, 0.f, 0.f};
#pragma unroll
                    for (int s = 0; s < 2; ++s) acc[gate][t] = __builtin_amdgcn_mfma_f32_16x16x32_bf16(af[s], wf[gate][t][s], acc[gate][t], 0, 0, 0); }
            float ssq[4] = {0.f, 0.f, 0.f, 0.f};
#pragma unroll
            for (int t = 0; t < 4; ++t) {
                float aj[4], bj[4], l2[4];
#pragma unroll
                for (int r = 0; r < 4; ++r) { const float uu = stg_c[r * 68 + 16 * t];
                    const float rr = __builtin_amdgcn_rcpf(1.0f + __builtin_amdgcn_exp2f(__builtin_fmaf(acc[0][t][r], -LOG2E, nba[t])));
                    const float ig = __builtin_amdgcn_rcpf(1.0f + __builtin_amdgcn_exp2f(__builtin_fmaf(acc[1][t][r], -LOG2E, nbx[t])));
                    l2[r] = rr * c2[t]; aj[r] = __builtin_amdgcn_exp2f(l2[r]);
                    bj[r] = __builtin_amdgcn_sqrtf(__builtin_fmaf(-aj[r], aj[r], 1.0f)) * (ig * uu); }
                if (!FINAL) {
                    const size_t lo = (((((size_t)unit * 8 + g) * 4 + ss) * 4 + t) * 64 + l) * 4;
                    *(GAS v2u*)(LAo + lo) = (v2u){pk2(l2[0], l2[1]), pk2(l2[2], l2[3])}; *(GAS v2u*)(BEo + lo) = (v2u){pk2(bj[0], bj[1]), pk2(bj[2], bj[3])}; }
                float hl[4], cum[4]; hl[0] = bj[0]; cum[0] = aj[0];
#pragma unroll
                for (int r = 1; r < 4; ++r) { hl[r] = aj[r] * hl[r - 1] + bj[r]; cum[r] = cum[r - 1] * aj[r]; }
                float A = cum[3], B = hl[3];
                float pA = __shfl(A, (l + 48) & 63), pB = __shfl(B, (l + 48) & 63);
                if (lg >= 1) { B = A * pB + B; A = A * pA; }
                pA = __shfl(A, (l + 32) & 63); pB = __shfl(B, (l + 32) & 63);
                if (lg >= 2) { B = A * pB + B; A = A * pA; }
                float eA = __shfl(A, (l + 48) & 63), eB = __shfl(B, (l + 48) & 63); if (lg == 0) { eA = 1.0f; eB = 0.0f; }
                const float hin = eA * hc[t] + eB;
                const float tA = __shfl(A, 48 + c16), tB = __shfl(B, 48 + c16);
                hc[t] = tA * hc[t] + tB; At[t] *= tA;
                if (FINAL) {
#pragma unroll
                    for (int r = 0; r < 4; ++r) { const float h = hl[r] + cum[r] * hin; const float gx = bf2f(gst_c[r * 64 + 16 * t]);
                        const float z2 = 1.5957691216057308f * (gx + 0.044715f * gx * gx * gx); const float vv = gx * sigmoidf_fast(z2) * h;
                        vst_c[(16 * ss + r) * 64 + 16 * t] = (bf16)f2bf(vv); ssq[r] += vv * vv; }
                }
            }
            if (FINAL) {
#pragma unroll
                for (int r = 0; r < 4; ++r) { float q = ssq[r]; q += __shfl_xor(q, 1); q += __shfl_xor(q, 2); q += __shfl_xor(q, 4); q += __shfl_xor(q, 8); if (c16 == 0) ssl_w[(16 * ss + r) * 8] = q; }
            }
        }
#undef LRU_LOAD
        if (!FINAL) {
            if (lg == 0) {
#pragma unroll
                for (int t = 0; t < 4; ++t) *(GAS f32x2*)(AGG + ((size_t)(b * 64 + c) * 512 + 64 * g + 16 * t + c16) * 2) = (f32x2){At[t], hc[t]}; }
        } else {
            LDS_WAIT(); __syncthreads();
            f32x4 gq[4];
#pragma unroll
            for (int j = 0; j < 4; ++j) gq[j] = ((const GAS f32x4*)(a.in[11] + layer * 512 + 64 * g + (l & 3) * 16))[j];
#pragma unroll
            for (int ss = 0; ss < 4; ++ss) { const int tl = 16 * ss + (l >> 2);
                const f32x4 s0 = *(const LAS f32x4*)(ssl + tl * 8), s1 = *(const LAS f32x4*)(ssl + tl * 8 + 4);
                const float rs = 1.0f / sqrtf(((s0.x + s0.y) + (s0.z + s0.w) + (s1.x + s1.y) + (s1.z + s1.w)) * (1.0f / DL) + RMS_EPS);
                const v4u y0 = *(const LAS v4u*)(vst + tl * 64 + (l & 3) * 16), y1 = *(const LAS v4u*)(vst + tl * 64 + (l & 3) * 16 + 8);
                v4u o0, o1;
                o0.x = pk2(bflo(y0.x) * rs * gq[0].x, bfhi(y0.x) * rs * gq[0].y); o0.y = pk2(bflo(y0.y) * rs * gq[0].z, bfhi(y0.y) * rs * gq[0].w);
                o0.z = pk2(bflo(y0.z) * rs * gq[1].x, bfhi(y0.z) * rs * gq[1].y); o0.w = pk2(bflo(y0.w) * rs * gq[1].z, bfhi(y0.w) * rs * gq[1].w);
                o1.x = pk2(bflo(y1.x) * rs * gq[2].x, bfhi(y1.x) * rs * gq[2].y); o1.y = pk2(bflo(y1.y) * rs * gq[2].z, bfhi(y1.y) * rs * gq[2].w);
                o1.z = pk2(bflo(y1.z) * rs * gq[3].x, bfhi(y1.z) * rs * gq[3].y); o1.w = pk2(bflo(y1.w) * rs * gq[3].z, bfhi(y1.w) * rs * gq[3].w);
                GAS v4u* dst = (GAS v4u*)(Y + (tok0 + tl) * D + DL + 64 * g + (l & 3) * 16); dst[0] = o0; dst[1] = o1; }
            __syncthreads();
        }
    }
}

__device__ __forceinline__ void lru_final_phase(Frame& F, const int layer, const Args& a, const bf16* Gg, const float* AGG, const bf16* LAi, const bf16* BEi, bf16* Y) {
    LAS unsigned char* lds = F.lds + RING_OFF;
    const int g = F.wave, l = F.lane;
    LAS unsigned char* tile = lds + g * FT_WAVE;
    LAS float* ssl = (LAS float*)(lds + NWAVES * FT_WAVE);
    f32x4 gq[2];
#pragma unroll
    for (int j = 0; j < 2; ++j) gq[j] = ((const GAS f32x4*)(a.in[11] + layer * 512 + 64 * g + (l & 7) * 8))[j];
    __syncthreads();
    for (int u0 = blockIdx.x, it = 0; u0 < NUNIT; u0 += F.G, ++it) {
        const int unit = (it & 1) ? (u0 ^ 63) : u0;
        const int b = unit >> 6, c = unit & 63; const size_t tok0 = (size_t)b * SEQ + 64 * c;
        v4u gr[8];
#pragma unroll
        for (int j = 0; j < 8; ++j) gr[j] = *(const GAS v4u*)(Gg + (tok0 + 8 * j + (l >> 3)) * DL + 64 * g + (l & 7) * 8);
        const GAS v2u* lap = (const GAS v2u*)(LAi + ((((size_t)unit * 8 + g) * 4) * 4 + (l >> 4)) * 256 + (l & 15) * 4); const GAS v2u* bep = (const GAS v2u*)(BEi + ((((size_t)unit * 8 + g) * 4) * 4 + (l >> 4)) * 256 + (l & 15) * 4);
        v2u la8[8], be8[8];
#pragma unroll
        for (int j = 0; j < 8; ++j) { la8[j] = lap[(j >> 2) * 4 * 64 + (j & 3) * 16]; be8[j] = bep[(j >> 2) * 4 * 64 + (j & 3) * 16]; }
        float h = 0.f;
        { const GAS f32x2* ap = (const GAS f32x2*)(AGG + ((size_t)(b * 64) * 512 + 64 * g + l) * 2);
          int cc = 0;
          for (; cc + 16 <= c; cc += 16) { f32x2 ab[16];
#pragma unroll
              for (int j = 0; j < 16; ++j) ab[j] = ap[(size_t)(cc + j) * 512];
#pragma unroll
              for (int j = 0; j < 16; ++j) h = ab[j].x * h + ab[j].y; }
          { f32x2 ab[16];
#pragma unroll
              for (int j = 0; j < 16; ++j) ab[j] = ap[(size_t)((cc + j < c) ? cc + j : 0) * 512];
#pragma unroll
              for (int j = 0; j < 16; ++j) if (cc + j < c) h = ab[j].x * h + ab[j].y; } }
#pragma unroll
        for (int j = 0; j < 8; ++j) *(LAS v4u*)(tile + (8 * j + (l >> 3)) * FT_PITCH + (l & 7) * 16) = gr[j];
        LAS bf16* col = (LAS bf16*)(tile + 2 * l);
#pragma unroll
        for (int half = 0; half < 2; ++half) {
            if (half == 1) {
#pragma unroll
                for (int j = 0; j < 8; ++j) { la8[j] = lap[(2 + (j >> 2)) * 4 * 64 + (j & 3) * 16]; be8[j] = bep[(2 + (j >> 2)) * 4 * 64 + (j & 3) * 16]; } }
#pragma unroll
            for (int j = 0; j < 8; ++j)
#pragma unroll
                for (int e = 0; e < 4; ++e) { const int tt = 32 * half + 4 * j + e; const unsigned lw = la8[j][e >> 1], bw = be8[j][e >> 1];
                    const float l2 = (e & 1) ? bfhi(lw) : bflo(lw), be = (e & 1) ? bfhi(bw) : bflo(bw);
                    h = __builtin_amdgcn_exp2f(l2) * h + be;
                    const float gx = bf2f(col[tt * (FT_PITCH / 2)]);
                    const float z2 = 1.5957691216057308f * (gx + 0.044715f * gx * gx * gx);
                    col[tt * (FT_PITCH / 2)] = (bf16)pk2(gx * sigmoidf_fast(z2) * h, 0.f); }
        }
        { float q = 0.f;
#pragma unroll
          for (int j = 0; j < 8; ++j) { const v4u y = *(const LAS v4u*)(tile + l * FT_PITCH + 16 * j);
#pragma unroll
              for (int e = 0; e < 4; ++e) { const float x0 = bflo(y[e]), x1 = bfhi(y[e]); q += x0 * x0 + x1 * x1; } }
          ssl[l * 8 + g] = q; }
        LDS_WAIT(); __syncthreads();
#pragma unroll
        for (int j = 0; j < 8; ++j) { const int tl = 8 * j + (l >> 3);
            const f32x4 s0 = *(const LAS f32x4*)(ssl + tl * 8), s1 = *(const LAS f32x4*)(ssl + tl * 8 + 4);
            const float rs = 1.0f / sqrtf(((s0.x + s0.y) + (s0.z + s0.w) + (s1.x + s1.y) + (s1.z + s1.w)) * (1.0f / DL) + RMS_EPS);
            const v4u y = *(const LAS v4u*)(tile + tl * FT_PITCH + (l & 7) * 16);
            v4u o; o.x = pk2(bflo(y.x) * rs * gq[0].x, bfhi(y.x) * rs * gq[0].y); o.y = pk2(bflo(y.y) * rs * gq[0].z, bfhi(y.y) * rs * gq[0].w);
            o.z = pk2(bflo(y.z) * rs * gq[1].x, bfhi(y.z) * rs * gq[1].y); o.w = pk2(bflo(y.w) * rs * gq[1].z, bfhi(y.w) * rs * gq[1].w);
            *(GAS v4u*)(Y + (tok0 + tl) * D + DL + 64 * g + (l & 7) * 8) = o; }
        __syncthreads();
    }
}
}

#define PB_BEGIN(k) do { F.lane = fresh_lane(); if (PROBE_MASK && ((PROBE_MASK >> (k)) & 1ull)) F.pt0 = rt(); } while (0)
#define PB_END(k) do { if (PROBE_MASK && ((PROBE_MASK >> (k)) & 1ull)) F.pacc += rt() - F.pt0; } while (0)
#define IN(k) (lo <= (k) && (k) < hi)
#define SEAM(k) do { if (IN(k) && IN((k) + 1)) { if ((PROBE_MASK & (1ull << 37)) && (PROBE_SEAM < 0 || PROBE_SEAM == (k))) { const unsigned long long t_ = rt(); xcd_barrier(bar); F.pacc += rt() - t_; } else xcd_barrier(bar); } } while (0)
template <int layer>
__device__ __forceinline__ void run_layer(Frame& F, const Args& args, const XcdBarrier& bar, const int lo, const int hi) {
    unsigned char* ws = args.ws; bf16* XBp = (bf16*)(ws + WS_XB);
        const int pb = layer ? PH_L1 : PH_L0;
        PB_BEGIN(pb + 0);
        if (IN(pb + 0)) {
            pg8::Gemm g{XBp, (const bf16*)(ws + WS_WIN) + (size_t)layer * DIN * D, M, DIN, D}; pg8::StaticOrder S; S.init(M, DIN, F.G, (int)blockIdx.x);
            pg8::EpiBf16<0> E{(bf16*)(ws + WS_Q), DA, nullptr, DA, (size_t)M * DA, QSCALE};
            pg8::gemm_phase<pg8::EpiBf16<0>, pg8::StaticOrder, true, true>(F.lds + RING_OFF, g, S, E);
        }
        SEAM(pb + 0);
        PB_END(pb + 0);
        PB_BEGIN(pb + 1);
        if (IN(pb + 1)) { PB_BEGIN(27); att::attn_phase(F, (const bf16*)(ws + WS_Q), (const bf16*)(ws + WS_K), (const bf16*)(ws + WS_V), args.in[9], (bf16*)(ws + WS_O0), (bf16*)(ws + WS_O1), (bf16*)(ws + WS_O2), (float*)(ws + WS_LSE)); PB_END(27);
            PB_BEGIN(28); lru::lru_phase<false>(F, layer, args, (const bf16*)(ws + WS_U), (const bf16*)(ws + WS_G), (float*)(ws + WS_AGG), nullptr, (bf16*)(ws + WS_LA), (bf16*)(ws + WS_BE)); PB_END(28); }
        SEAM(pb + 1);
        PB_END(pb + 1);
        PB_BEGIN(pb + 2);
        if (IN(pb + 2)) { PB_BEGIN(29); att::merge_attn_phase(F, (const bf16*)(ws + WS_O0), (const bf16*)(ws + WS_O1), (const bf16*)(ws + WS_O2), (const float*)(ws + WS_LSE), args.in[10] + layer * DA, (bf16*)(ws + WS_Y)); PB_END(29);
            PB_BEGIN(30); lru::lru_final_phase(F, layer, args, (const bf16*)(ws + WS_G), (const float*)(ws + WS_AGG), (const bf16*)(ws + WS_LA), (const bf16*)(ws + WS_BE), (bf16*)(ws + WS_Y)); PB_END(30); }
        SEAM(pb + 2);
        PB_END(pb + 2);
        PB_BEGIN(pb + 3);
        if (IN(pb + 3)) {
            pg8::Gemm g{(const bf16*)(ws + WS_Y), (const bf16*)(ws + WS_WOUT) + (size_t)layer * D * D, M, D, D}; pg8::StaticOrder S; S.init(M, D, F.G, (int)blockIdx.x);
            pg8::EpiResBf16 E{XBp, XBp, D, ALPHA, 1.0f};
            pg8::gemm_phase<pg8::EpiResBf16, pg8::StaticOrder, true, true>(F.lds + RING_OFF, g, S, E);
        }
        SEAM(pb + 3);
        PB_END(pb + 3);
        PB_BEGIN(pb + 4);
        if (IN(pb + 4)) {
            if (layer == 0) phase_ln<false>(F, XBp, args.in[13], args.in[14], nullptr, nullptr, nullptr);
            else { phase_ln<true>(F, XBp, args.in[13] + D, args.in[14] + D, args.in[20], (int*)(ws + WS_TOKE), (float*)(ws + WS_TOKP)); PB_BEGIN(26); phase_moe_cvt(F, args); PB_END(26); }
        }
        SEAM(pb + 4);
        PB_END(pb + 4);
        if (layer == 0) {
            PB_BEGIN(pb + 5);
            if (IN(pb + 5)) {
                pg8::Gemm g{XBp, (const bf16*)(ws + WS_WGU), M, 2 * DFF, D}; pg8::StaticOrder S; S.init(M, 2 * DFF, F.G, (int)blockIdx.x);
                pg8::EpiSwiGLU8 E{ws + WS_HB, DFF, 1.0f, MOE_HSCALE};
                pg8::gemm_phase<pg8::EpiSwiGLU8, pg8::StaticOrder, true, true>(F.lds + RING_OFF, g, S, E);
            }
            SEAM(pb + 5);
            PB_END(pb + 5);
            PB_BEGIN(pb + 6);
            if (IN(pb + 6)) {
                pg8::Gemm g{(const bf16*)(ws + WS_HB), (const bf16*)(ws + WS_WD), M, D, DFF / 2}; pg8::StaticOrder S; S.init(M, D, F.G, (int)blockIdx.x);
                pg8::EpiResBf16 E{XBp, XBp, D, ALPHA, 1.0f / (MOE_HSCALE * MOE_DSCALE)};
                pg8::gemm_phase<pg8::EpiResBf16, pg8::StaticOrder, true, true, true>(F.lds + RING_OFF, g, S, E);
            }
            SEAM(pb + 6);
            PB_END(pb + 6);
            PB_BEGIN(pb + 7);
            if (IN(pb + 7)) phase_ln<false>(F, XBp, args.in[15], args.in[16], nullptr, nullptr, nullptr);
            SEAM(pb + 7);
            PB_END(pb + 7);
        }
}

__global__ void __launch_bounds__(NWAVES * 64, 2) fwd(Args args) {
    extern __shared__ __attribute__((aligned(16))) unsigned char lds[];
    Frame F;
    F.lds = (LAS unsigned char*)lds;
    F.MISC = (volatile LAS unsigned*)(F.lds + MISC_OFF);
    F.tid = threadIdx.x; F.lane = F.tid & 63; F.wave = __builtin_amdgcn_readfirstlane(F.tid >> 6);
    F.pt0 = 0ull; F.pacc = 0ull;
    F.G = gridDim.x; { const int bx = blockIdx.x; F.vcu = (F.G % 8 == 0) ? (bx % 8) * (F.G / 8) + bx / 8 : bx; }
    unsigned char* ws = args.ws;
    F.ctl = (gu32*)(ws + WS_CTL);
    for (int u = F.tid; u < (LDS_BYTES - LDSCTL_OFF) / 4; u += NWAVES * 64) ((LAS unsigned*)(F.lds + LDSCTL_OFF))[u] = 0u;
    __syncthreads();
    const int lo = args.ph_lo, hi = args.ph_hi;
    const bool use_bar = (hi - lo) > 1;
    XcdBarrier bar; bar.bar = (unsigned*)(F.ctl + CW_BAR) + args.li * XCD_BAR_WORDS; bar.x = 0; bar.st = nullptr;
    if (use_bar) bar = xcd_barrier_post((unsigned*)(F.ctl + CW_BAR) + args.li * XCD_BAR_WORDS, F.MISC + 8);
    float* out = args.out;
    bf16* XBp = (bf16*)(ws + WS_XB);

    PB_BEGIN(PH_PRO);
    if (IN(PH_PRO)) phase_prologue(F, args);
    SEAM(PH_PRO);
    PB_END(PH_PRO);

    run_layer<0>(F, args, bar, lo, hi);
    run_layer<1>(F, args, bar, lo, hi);
    PB_BEGIN(PH_DISPATCH);
    if (IN(PH_DISPATCH)) phase_dispatch(F, (const int*)(ws + WS_TOKE), (int*)(ws + WS_TOKPOS), (int*)(ws + WS_SEG), XBp, ws + WS_XS8);
    SEAM(PH_DISPATCH);
    PB_END(PH_DISPATCH);
    for (int c = 0; c < NCHUNK - 1; ++c) {
        const int pg = PH_MOE0 + 2 * c;
        if (IN(pg) || IN(pg + 1)) {
            pg8::MoeOrder S; S.G = F.G; S.c = (int)blockIdx.x; S.base = c * CHUNK_TILES;
            const GAS int* st = (const GAS int*)(ws + WS_SEG);
#pragma unroll
            for (int k = 0; k < 9; ++k) S.segt[k] = __builtin_amdgcn_readfirstlane(st[k]);
            const int nT = S.segt[8]; S.nrows = nT - S.base; if (S.nrows > CHUNK_TILES) S.nrows = CHUNK_TILES; if (S.nrows < 0) S.nrows = 0;
            unsigned char* HCv = (unsigned char*)out - (size_t)S.base * 256 * DFE;
            S.split_pm = -1; S.adiff = 0;
            PB_BEGIN(pg);
            if (IN(pg)) {
                S.nN = 2 * DFE / 256; S.estride_b = (size_t)2 * DFE * D;
                pg8::Gemm g{(const bf16*)(ws + WS_XS8), (const bf16*)(ws + WS_MGU), SORT_ROWS, 2 * DFE, D / 2};
                pg8::EpiSwiGLU8 E{HCv, DFE, 1.0f / MOE_WSCALE, MOE_HSCALE};
                pg8::gemm_phase<pg8::EpiSwiGLU8, pg8::MoeOrder, true, true, true>(F.lds + RING_OFF, g, S, E);
            }
            SEAM(pg);
            PB_END(pg);
            PB_BEGIN(pg + 1);
            if (IN(pg + 1)) {
                S.nN = D / 256; S.estride_b = (size_t)D * DFE;
                pg8::Gemm g{(const bf16*)HCv, (const bf16*)(ws + WS_MD), SORT_ROWS, D, DFE / 2};
                pg8::EpiBf16S E{(bf16*)(ws + WS_YS), D, 1.0f / (MOE_HSCALE * MOE_DSCALE)};
                pg8::gemm_phase<pg8::EpiBf16S, pg8::MoeOrder, true, true, true>(F.lds + RING_OFF, g, S, E);
            }
            SEAM(pg + 1);
            PB_END(pg + 1);
        }
    }
    {
        constexpr int pg = PH_MOE0 + 2 * (NCHUNK - 1), TAIL_ROW0 = (NCHUNK - 1) * CHUNK_TILES * 256;
        pg8::MoeOrder S; S.G = F.G; S.c = (int)blockIdx.x; S.base = (NCHUNK - 1) * CHUNK_TILES; S.nrows = 0; S.split_pm = -1; S.adiff = 0;
        unsigned char* HCv = ws + WS_HCA - (size_t)S.base * 256 * DFE;
        if (IN(pg) || IN(pg + 1)) {
            const GAS int* st = (const GAS int*)(ws + WS_SEG);
#pragma unroll
            for (int k = 0; k < 9; ++k) S.segt[k] = __builtin_amdgcn_readfirstlane(st[k]);
            S.nrows = S.segt[8] - S.base; if (S.nrows > CHUNK_TILES) S.nrows = CHUNK_TILES; if (S.nrows < 0) S.nrows = 0;
        }
        PB_BEGIN(pg);
        if (IN(pg)) {
            S.nN = 2 * DFE / 256; S.estride_b = (size_t)2 * DFE * D;
            pg8::Gemm g{(const bf16*)(ws + WS_XS8), (const bf16*)(ws + WS_MGU), SORT_ROWS, 2 * DFE, D / 2};
            pg8::EpiSwiGLU8 E{HCv, DFE, 1.0f / MOE_WSCALE, MOE_HSCALE};
            pg8::gemm_phase<pg8::EpiSwiGLU8, pg8::MoeOrder, true, true, true>(F.lds + RING_OFF, g, S, E);
        }
        SEAM(pg);
        PB_END(pg);
        PB_BEGIN(pg + 1);
        if (IN(pg + 1)) {
            {
                pg8::MoeSplitK S2; S2.base = S.base; S2.nrows = S.nrows; S2.nN = D / 256; S2.nS = TAIL_NS; S2.KS = TAIL_KS / 2; S2.G = F.G; S2.c = (int)blockIdx.x; S2.estride_b = (size_t)D * DFE;
#pragma unroll
                for (int k2 = 0; k2 < 9; ++k2) S2.segt[k2] = S.segt[k2];
                pg8::Gemm g{(const bf16*)HCv, (const bf16*)(ws + WS_MD), SORT_ROWS, D, TAIL_KS / 2, DFE / 2};
                pg8::EpiPart E{(bf16*)(ws + WS_PART), D, S.base, TAIL_TILES, 1.0f / (MOE_HSCALE * MOE_DSCALE)};
                pg8::gemm_phase<pg8::EpiPart, pg8::MoeSplitK, true, true, true>(F.lds + RING_OFF, g, S2, E);
            }
            phase_combine(F, XBp, out, (const bf16*)(ws + WS_YS), (const int*)(ws + WS_TOKPOS), (const float*)(ws + WS_TOKP), args.in[15] + D, args.in[16] + D, (const bf16*)(ws + WS_PART), 1, TAIL_ROW0, F.vcu * NWAVES + F.wave, F.G * NWAVES);
        }
        SEAM(pg + 1);
        PB_END(pg + 1);
        PB_BEGIN(PH_COMBINE);
        if (IN(PH_COMBINE)) phase_combine(F, XBp, out, (const bf16*)(ws + WS_YS), (const int*)(ws + WS_TOKPOS), (const float*)(ws + WS_TOKP), args.in[15] + D, args.in[16] + D, (const bf16*)(ws + WS_PART), 2, TAIL_ROW0, F.vcu * NWAVES + F.wave, F.G * NWAVES);
        PB_END(PH_COMBINE);
        if (PROBE_MASK && blockIdx.x == 0 && F.tid == 0) { const unsigned long long te = rt() + (unsigned long long)PROBE_K * F.pacc; while (rt() < te) __builtin_amdgcn_s_sleep(8); }
    }
#undef IN
#undef SEAM
}

extern "C" void kernel_launch(void* const* d_in, const int* in_sizes, int n_in, void* d_out, int out_size, void* d_ws, size_t ws_size, hipStream_t stream) {
    static int grid = 0;
    if (grid == 0) {
        if (n_in != 24 || in_sizes[0] != M * D || out_size != M * D || ws_size < WS_END) { fprintf(stderr, "kernel_launch: unexpected problem (n_in %d, out %d, ws %zu < %zu)\n", n_in, out_size, ws_size, (size_t)WS_END); grid = -1; return; }
        int dev = 0, cus = 0, per_cu = 0;
        if (hipGetDevice(&dev) != hipSuccess || hipDeviceGetAttribute(&cus, hipDeviceAttributeMultiprocessorCount, dev) != hipSuccess) { grid = -1; return; }
        if (hipFuncSetAttribute((const void*)fwd, hipFuncAttributeMaxDynamicSharedMemorySize, LDS_BYTES) != hipSuccess) { fprintf(stderr, "kernel_launch: hipFuncSetAttribute failed\n"); grid = -1; return; }
        if (hipOccupancyMaxActiveBlocksPerMultiprocessor(&per_cu, (const void*)fwd, NWAVES * 64, LDS_BYTES) != hipSuccess || per_cu < 1) fprintf(stderr, "kernel_launch: occupancy query says %d\n", per_cu);
        (void)hipGetLastError();
        grid = cus;
    }
    if (grid < 0) return;
    (void)hipMemsetAsync((char*)d_ws + WS_CTL, 0, CTL_ZERO_BYTES, stream);
    Args a{};
    for (int i = 0; i < 24; ++i) a.in[i] = (const float*)d_in[i];
    a.out = (float*)d_out; a.ws = (unsigned char*)d_ws;
    int li = 0;
    auto launch = [&](int lo, int hi) { a.ph_lo = lo; a.ph_hi = hi; a.li = li++; hipLaunchKernelGGL(fwd, dim3(grid), dim3(NWAVES * 64), LDS_BYTES, stream, a); };
    auto each = [&](int lo, int hi) { for (int p = lo; p < hi; ++p) launch(p, p + 1); };
#if defined(MK_PER_PHASE)
    each(PH_PRO, NPH);
#else
    launch(PH_PRO, NPH);
#endif
}
```

```cpp
#include <hip/hip_runtime.h>
#include <cstdio>
#include <cstdint>
#include <cmath>
namespace pg8 {
#define PG8_LAS __attribute__((address_space(3)))
typedef unsigned short bf16_t;
typedef short bf16x8 __attribute__((ext_vector_type(8)));
typedef float f32x4 __attribute__((ext_vector_type(4)));
typedef unsigned u32x4 __attribute__((ext_vector_type(4)));
typedef int i32x4 __attribute__((ext_vector_type(4)));
typedef int i32x8 __attribute__((ext_vector_type(8)));
constexpr int BM = 256, BK = 64, HALF = 128, HTB = HALF * BK * 2  , STAGE_BYTES = 8 * HTB, NXCD = 8, WGM = 8;

__host__ __device__ __forceinline__ int lds_byte(int r, int c) { const int st = (r >> 4) * 2 + (c >> 5), rr = r & 15, cc = c & 31, ob = rr * 64 + cc * 2; return st * 1024 + (ob ^ (((ob >> 9) & 1) << 5)); }
__host__ __device__ __forceinline__ void stage_rc(int b, int& R, int& C) { const int st = b / 1024, sb = b % 1024, swz = sb ^ (((sb >> 9) & 1) << 5); R = (st >> 1) * 16 + swz / 64; C = (st & 1) * 32 + (swz % 64) / 2; }
__host__ __device__ __forceinline__ int perm32(int rho) { const int n = rho >> 4, i = rho & 15; return 8 * (i >> 2) + 4 * n + (i & 3); }

struct Unit { int pm, pn; size_t boffb, aoffb; int ks; };
struct Gemm { const bf16_t* A; const bf16_t* Bt; int M, N, K; int ld; };

struct StaticOrder {
    int nM, nN, nwg, G, c;
    __host__ __device__ void init(int M, int N, int G_, int c_) { nM = M / BM; nN = N / BM; nwg = nM * nN; G = G_; c = c_; }
    __host__ __device__ bool next(int i, Unit& u) const {
        const long L = (long)i * G + c; if (L >= nwg) return false;
        int wgid = (int)L; { const int q = nwg / NXCD, r = nwg % NXCD, xcd = wgid % NXCD, off = wgid / NXCD; wgid = (xcd < r ? xcd * (q + 1) : r * (q + 1) + (xcd - r) * q) + off; }
        const int nig = WGM * nN, gid = wgid / nig, fm = gid * WGM, gsz = (nM - fm) < WGM ? (nM - fm) : WGM;
        u.pm = fm + ((wgid % nig) % gsz); u.pn = (wgid % nig) / gsz; u.boffb = 0; u.aoffb = 0; u.ks = 0; return true;
    }
    __device__ __forceinline__ void a_ready(const Unit&) const {}
    __device__ __forceinline__ void done(const Unit&) const {}
};

__device__ __forceinline__ unsigned cvt_pk_bf16(float lo, float hi) { unsigned r; asm volatile("v_cvt_pk_bf16_f32 %0, %1, %2" : "=v"(r) : "v"(lo), "v"(hi)); return r; }
typedef float f32x2 __attribute__((ext_vector_type(2)));
__device__ __forceinline__ f32x2 gelu_pk(f32x2 v) {
    const f32x2 av = __builtin_elementwise_abs(v), d = av * 0.2316418882f + 1.0f;
    f32x2 t; t.x = __builtin_amdgcn_rcpf(d.x); t.y = __builtin_amdgcn_rcpf(d.y);
    f32x2 q = t * 0.5307027145f + (-0.7265760135f); q = q * t + 0.7107068705f; q = q * t + (-0.142248368f); q = q * t + 0.127414796f; q = q * t;
    const f32x2 s = (v * v) * (-0.72134752044f);
    f32x2 e; e.x = __builtin_amdgcn_exp2f(s.x); e.y = __builtin_amdgcn_exp2f(s.y);
    const f32x2 m = v * (q * e), r = v - m;
    f32x2 o; o.x = v.x < 0.f ? m.x : r.x; o.y = v.y < 0.f ? m.y : r.y; return o;
}

template <int ACT  > struct EpiBf16 {
    static constexpr bool PERM = true, AFTER_DRAIN = false; static_assert(ACT == 0 || ACT == 1, "EpiBf16: ACT is 0 (none) or 1 (gelu_pk)");
    bf16_t* O; int ldc; const float* bias; int split_cols; size_t split_stride; float scale0;
    __device__ __forceinline__ void operator()(const f32x4 (&acc)[2][2][4][2], const Unit& u, int wr, int wc, int fr, int fq) const {
        const int row0 = u.pm * BM + wr * 64 + fr; int colt = u.pn * BM; bf16_t* base = O;
        float sc = 1.f; if (split_cols) { const int t = colt / split_cols; base += (size_t)t * split_stride; colt -= t * split_cols; if (t == 0) sc = scale0; }
        const int col0 = colt + wc * 32 + 8 * fq, bcol0 = u.pn * BM + wc * 32 + 8 * fq;
        f32x4 bv[2][2];
#pragma unroll
        for (int bj = 0; bj < 2; ++bj)
#pragma unroll
            for (int n = 0; n < 2; ++n) bv[bj][n] = bias ? *(const f32x4*)(bias + bcol0 + bj * HALF + 4 * n) : (f32x4){0.f, 0.f, 0.f, 0.f};
#pragma unroll
        for (int ai = 0; ai < 2; ++ai)
#pragma unroll
            for (int m = 0; m < 4; ++m) { bf16_t* rowp = base + (size_t)(row0 + ai * HALF + m * 16) * ldc + col0;
#pragma unroll
                for (int bj = 0; bj < 2; ++bj) { f32x4 v0 = acc[ai][bj][m][0] + bv[bj][0], v1 = acc[ai][bj][m][1] + bv[bj][1];
                    if (ACT == 1) { f32x2 a = gelu_pk((f32x2){v0[0], v0[1]}), b = gelu_pk((f32x2){v0[2], v0[3]}), c = gelu_pk((f32x2){v1[0], v1[1]}), d = gelu_pk((f32x2){v1[2], v1[3]});
                        v0 = (f32x4){a.x, a.y, b.x, b.y}; v1 = (f32x4){c.x, c.y, d.x, d.y}; }
                    v0 = v0 * sc; v1 = v1 * sc; u32x4 w; w.x = cvt_pk_bf16(v0[0], v0[1]); w.y = cvt_pk_bf16(v0[2], v0[3]); w.z = cvt_pk_bf16(v1[0], v1[1]); w.w = cvt_pk_bf16(v1[2], v1[3]);
                    *(u32x4*)(rowp + bj * HALF) = w; } }
    }
};

struct EpiSwiGLU {
    static constexpr bool PERM = true, AFTER_DRAIN = false;
    bf16_t* O; int ldc; bf16_t* O2; int split_pm; float wscale;
    __device__ __forceinline__ static float silu_mul(float g, float u) { return g * __builtin_amdgcn_rcpf(1.0f + __builtin_amdgcn_exp2f(g * -1.4426950408889634f)) * u; }
    __device__ __forceinline__ void operator()(const f32x4 (&acc)[2][2][4][2], const Unit& u, int wr, int wc, int fr, int fq) const {
        const int row0 = u.pm * BM + wr * 64 + fr, col0 = u.pn * HALF + wc * 32 + 8 * fq;
#pragma unroll
        for (int ai = 0; ai < 2; ++ai)
#pragma unroll
            for (int m = 0; m < 4; ++m) { bf16_t* rowp = ((split_pm >= 0 && u.pm >= split_pm) ? O2 : O) + (size_t)(row0 + ai * HALF + m * 16) * ldc + col0;
                const f32x4 g0 = acc[ai][0][m][0] * wscale, g1 = acc[ai][0][m][1] * wscale, u0 = acc[ai][1][m][0] * wscale, u1 = acc[ai][1][m][1] * wscale;
                u32x4 w; w.x = cvt_pk_bf16(silu_mul(g0[0], u0[0]), silu_mul(g0[1], u0[1])); w.y = cvt_pk_bf16(silu_mul(g0[2], u0[2]), silu_mul(g0[3], u0[3]));
                w.z = cvt_pk_bf16(silu_mul(g1[0], u1[0]), silu_mul(g1[1], u1[1])); w.w = cvt_pk_bf16(silu_mul(g1[2], u1[2]), silu_mul(g1[3], u1[3]));
                *(u32x4*)rowp = w; }
    }
};
struct EpiResF32 {
    static constexpr bool PERM = false, AFTER_DRAIN = false;
    const float* R; float* out; int ldc; float alpha;
    __device__ __forceinline__ void operator()(const f32x4 (&acc)[2][2][4][2], const Unit& u, int wr, int wc, int fr, int fq) const {
        const int col0 = u.pn * BM + wc * 32 + 4 * fq;
#pragma unroll
        for (int ai = 0; ai < 2; ++ai)
#pragma unroll
            for (int m = 0; m < 4; ++m) { const size_t off = (size_t)(u.pm * BM + ai * HALF + wr * 64 + m * 16 + fr) * ldc + col0;
#pragma unroll
                for (int bj = 0; bj < 2; ++bj)
#pragma unroll
                    for (int n = 0; n < 2; ++n) { const f32x4 rs = *(const f32x4*)(R + off + bj * HALF + n * 16); *(f32x4*)(out + off + bj * HALF + n * 16) = rs * alpha + acc[ai][bj][m][n]; }
                if (m & 1) asm volatile("" ::: "memory"); }
    }
};
__device__ __forceinline__ unsigned pk4_e4m3(float a, float b, float c, float d) {
    a = __builtin_fminf(__builtin_fmaxf(a, -448.f), 448.f); b = __builtin_fminf(__builtin_fmaxf(b, -448.f), 448.f); c = __builtin_fminf(__builtin_fmaxf(c, -448.f), 448.f); d = __builtin_fminf(__builtin_fmaxf(d, -448.f), 448.f);
    unsigned w = 0u; w = __builtin_amdgcn_cvt_pk_fp8_f32(a, b, w, false); w = __builtin_amdgcn_cvt_pk_fp8_f32(c, d, w, true); return w;
}
struct EpiSwiGLU8 {
    static constexpr bool PERM = true, AFTER_DRAIN = false;
    unsigned char* O; int ldc; float wscale, hscale;
    __device__ __forceinline__ void operator()(const f32x4 (&acc)[2][2][4][2], const Unit& u, int wr, int wc, int fr, int fq) const {
        const int row0 = u.pm * BM + wr * 64 + fr, col0 = u.pn * HALF + wc * 32 + 8 * fq;
        typedef unsigned u32x2 __attribute__((ext_vector_type(2)));
#pragma unroll
        for (int ai = 0; ai < 2; ++ai)
#pragma unroll
            for (int m = 0; m < 4; ++m) { unsigned char* rowp = O + (size_t)(row0 + ai * HALF + m * 16) * ldc + col0;
                const f32x4 g0 = acc[ai][0][m][0] * wscale, g1 = acc[ai][0][m][1] * wscale, u0 = acc[ai][1][m][0] * (wscale * hscale), u1 = acc[ai][1][m][1] * (wscale * hscale);
                u32x2 w; w.x = pk4_e4m3(EpiSwiGLU::silu_mul(g0[0], u0[0]), EpiSwiGLU::silu_mul(g0[1], u0[1]), EpiSwiGLU::silu_mul(g0[2], u0[2]), EpiSwiGLU::silu_mul(g0[3], u0[3]));
                w.y = pk4_e4m3(EpiSwiGLU::silu_mul(g1[0], u1[0]), EpiSwiGLU::silu_mul(g1[1], u1[1]), EpiSwiGLU::silu_mul(g1[2], u1[2]), EpiSwiGLU::silu_mul(g1[3], u1[3]));
                *(u32x2*)rowp = w; }
    }
};
struct EpiBf16S {
    static constexpr bool PERM = true, AFTER_DRAIN = false;
    bf16_t* O; int ldc; float s;
    __device__ __forceinline__ void operator()(const f32x4 (&acc)[2][2][4][2], const Unit& u, int wr, int wc, int fr, int fq) const {
        const int row0 = u.pm * BM + wr * 64 + fr, col0 = u.pn * BM + wc * 32 + 8 * fq;
#pragma unroll
        for (int ai = 0; ai < 2; ++ai)
#pragma unroll
            for (int m = 0; m < 4; ++m) { bf16_t* rowp = O + (size_t)(row0 + ai * HALF + m * 16) * ldc + col0;
#pragma unroll
                for (int bj = 0; bj < 2; ++bj) { const f32x4 v0 = acc[ai][bj][m][0] * s, v1 = acc[ai][bj][m][1] * s;
                    u32x4 w; w.x = cvt_pk_bf16(v0[0], v0[1]); w.y = cvt_pk_bf16(v0[2], v0[3]); w.z = cvt_pk_bf16(v1[0], v1[1]); w.w = cvt_pk_bf16(v1[2], v1[3]);
                    *(u32x4*)(rowp + bj * HALF) = w; } }
    }
};
struct EpiResBf16 {
    static constexpr bool PERM = true, AFTER_DRAIN = false;
    const bf16_t* R; bf16_t* out; int ldc; float alpha; float s;
    __device__ __forceinline__ void operator()(const f32x4 (&acc)[2][2][4][2], const Unit& u, int wr, int wc, int fr, int fq) const {
        const int row0 = u.pm * BM + wr * 64 + fr, col0 = u.pn * BM + wc * 32 + 8 * fq;
#pragma unroll
        for (int ai = 0; ai < 2; ++ai)
#pragma unroll
            for (int m = 0; m < 4; ++m) { const size_t off = (size_t)(row0 + ai * HALF + m * 16) * ldc + col0;
#pragma unroll
                for (int bj = 0; bj < 2; ++bj) { const u32x4 rv = *(const u32x4*)(R + off + bj * HALF); const f32x4 v0 = acc[ai][bj][m][0] * s, v1 = acc[ai][bj][m][1] * s;
                    u32x4 w;
                    w.x = cvt_pk_bf16(alpha * __uint_as_float(rv.x << 16) + v0[0], alpha * __uint_as_float(rv.x & 0xffff0000u) + v0[1]);
                    w.y = cvt_pk_bf16(alpha * __uint_as_float(rv.y << 16) + v0[2], alpha * __uint_as_float(rv.y & 0xffff0000u) + v0[3]);
                    w.z = cvt_pk_bf16(alpha * __uint_as_float(rv.z << 16) + v1[0], alpha * __uint_as_float(rv.z & 0xffff0000u) + v1[1]);
                    w.w = cvt_pk_bf16(alpha * __uint_as_float(rv.w << 16) + v1[2], alpha * __uint_as_float(rv.w & 0xffff0000u) + v1[3]);
                    *(u32x4*)(out + off + bj * HALF) = w; }
                if (m & 1) asm volatile("" ::: "memory"); }
    }
};
constexpr int MOE_SUB = 64;
struct MoeOrder {
    int base, nrows, nN, G, c; int segt[9]; size_t estride_b; int split_pm; size_t adiff;
    __device__ __forceinline__ bool next(int i, Unit& u) const {
        const long L = (long)i * G + c; if (L >= (long)nrows * nN) return false;
        if (nrows % MOE_SUB) { u.pm = base + (int)(L % nrows); u.pn = (int)(L / nrows); }
        else { const int per = MOE_SUB * nN, sc = (int)(L / per), Lr = (int)(L % per); u.pm = base + sc * MOE_SUB + Lr % MOE_SUB; u.pn = Lr / MOE_SUB; }
        int e = 0;
#pragma unroll
        for (int k = 1; k < 8; ++k) e += (u.pm >= segt[k]) ? 1 : 0;
        u.boffb = (size_t)e * estride_b; u.aoffb = (split_pm >= 0 && u.pm >= split_pm) ? adiff : 0; u.ks = 0; return true;
    }
    __device__ __forceinline__ void a_ready(const Unit&) const {}
    __device__ __forceinline__ void done(const Unit&) const {}
};
struct MoeSplitK {
    int base, nrows, nN, nS, KS, G, c; int segt[9]; size_t estride_b;
    __device__ __forceinline__ bool next(int i, Unit& u) const {
        const long L = (long)i * G + c; if (L >= (long)nrows * nN * nS) return false;
        u.ks = (int)(L % nS); const int rest = (int)(L / nS); u.pm = base + rest % nrows; u.pn = rest / nrows;
        int e = 0;
#pragma unroll
        for (int k = 1; k < 8; ++k) e += (u.pm >= segt[k]) ? 1 : 0;
        u.boffb = (size_t)e * estride_b + (size_t)u.ks * KS * 2; u.aoffb = (size_t)u.ks * KS * 2; return true;
    }
    __device__ __forceinline__ void a_ready(const Unit&) const {}
    __device__ __forceinline__ void done(const Unit&) const {}
};
struct EpiPart {
    static constexpr bool PERM = true, AFTER_DRAIN = false;
    bf16_t* P; int ldc, base, ptiles; float s;
    __device__ __forceinline__ void operator()(const f32x4 (&acc)[2][2][4][2], const Unit& u, int wr, int wc, int fr, int fq) const {
        const int row0 = (u.ks * ptiles + (u.pm - base)) * BM + wr * 64 + fr, col0 = u.pn * BM + wc * 32 + 8 * fq;
#pragma unroll
        for (int ai = 0; ai < 2; ++ai)
#pragma unroll
            for (int m = 0; m < 4; ++m) { bf16_t* rowp = P + (size_t)(row0 + ai * HALF + m * 16) * ldc + col0;
#pragma unroll
                for (int bj = 0; bj < 2; ++bj) { const f32x4 v0 = acc[ai][bj][m][0] * s, v1 = acc[ai][bj][m][1] * s;
                    u32x4 w; w.x = cvt_pk_bf16(v0[0], v0[1]); w.y = cvt_pk_bf16(v0[2], v0[3]); w.z = cvt_pk_bf16(v1[0], v1[1]); w.w = cvt_pk_bf16(v1[2], v1[3]);
                    *(u32x4*)(rowp + bj * HALF) = w; } }
    }
};

template <class Epi, class Sched, bool ALIGN_EPI = false, bool SP2 = false, bool FP8 = false>
__device__ __forceinline__ void gemm_phase(PG8_LAS unsigned char* lds, const Gemm g, const Sched& S, const Epi& E) {
    const int tid = threadIdx.x, wid = __builtin_amdgcn_readfirstlane(tid >> 6), lane = tid & 63, wr = wid >> 2, wc = wid & 3, fr = lane & 15, fq = lane >> 4;
    const int K = g.K, nt = K / BK, LD = g.ld ? g.ld : g.K;
    unsigned voffA[2], voffB[2];
#pragma unroll
    for (int i = 0; i < 2; ++i) { int R, C; stage_rc(tid * 16 + i * 8192, R, C); const int Rb = Epi::PERM ? ((R & ~31) + perm32(R & 31)) : R;
        voffA[i] = (unsigned)(R * LD + C) * 2u; voffB[i] = (unsigned)(Rb * LD + C) * 2u; }
    const size_t kstep = (size_t)(BK * 2);
    const size_t hstep = (size_t)HALF * LD * 2;
    const size_t tstep = 2 * hstep;
    const unsigned ldsw = (unsigned)wid * 1024u;
    const int aoff = lds_byte(wr * 64 + fr, fq * 8), boff = lds_byte(wc * 32 + fr, fq * 8);
#define PG8_SA(b, h) (((b) * 2 + (h)) * HTB)
#define PG8_SB(b, h) ((4 + (b) * 2 + (h)) * HTB)
#define PG8_STAGE(bufoff, gbase, voff) do { _Pragma("unroll") for (int _i = 0; _i < 2; ++_i) \
        __builtin_amdgcn_global_load_lds((const unsigned*)((const char*)(gbase) + (voff)[_i]), (PG8_LAS unsigned*)(lds + (bufoff) + ldsw + _i * 8192), 16, 0, 0); } while (0)
#define PG8_LDA(dst, b, h) do { if constexpr (FP8) { _Pragma("unroll") for (int m = 0; m < 4; ++m) { const i32x4 lo_ = *(const PG8_LAS i32x4*)(lds + PG8_SA(b, h) + aoff + m * 2048), hi_ = *(const PG8_LAS i32x4*)(lds + PG8_SA(b, h) + aoff + m * 2048 + 1024); \
            dst##8[m] = __builtin_shufflevector(lo_, hi_, 0, 1, 2, 3, 4, 5, 6, 7); } } \
        else { _Pragma("unroll") for (int m = 0; m < 4; ++m) _Pragma("unroll") for (int k = 0; k < 2; ++k) dst[m][k] = *(const PG8_LAS bf16x8*)(lds + PG8_SA(b, h) + aoff + m * 2048 + k * 1024); } } while (0)
#define PG8_LDB(dst, b, h) do { if constexpr (FP8) { _Pragma("unroll") for (int n = 0; n < 2; ++n) { const i32x4 lo_ = *(const PG8_LAS i32x4*)(lds + PG8_SB(b, h) + boff + n * 2048), hi_ = *(const PG8_LAS i32x4*)(lds + PG8_SB(b, h) + boff + n * 2048 + 1024); \
            dst##8[n] = __builtin_shufflevector(lo_, hi_, 0, 1, 2, 3, 4, 5, 6, 7); } } \
        else { _Pragma("unroll") for (int n = 0; n < 2; ++n) _Pragma("unroll") for (int k = 0; k < 2; ++k) dst[n][k] = *(const PG8_LAS bf16x8*)(lds + PG8_SB(b, h) + boff + n * 2048 + k * 1024); } } while (0)
#define PG8_MMA(ai, bj, At, Bt) do { __builtin_amdgcn_s_setprio(1); \
        if constexpr (FP8) { _Pragma("unroll") for (int m = 0; m < 4; ++m) _Pragma("unroll") for (int n = 0; n < 2; ++n) \
            asm volatile("v_mfma_scale_f32_16x16x128_f8f6f4 %0, %1, %2, %0, %3, %3 op_sel_hi:[0,0,0]" : "+v"(acc[ai][bj][m][n]) : "v"(Bt##8[n]), "v"(At##8[m]), "v"(fp8_one)); } \
        else { _Pragma("unroll") for (int m = 0; m < 4; ++m) _Pragma("unroll") for (int n = 0; n < 2; ++n) _Pragma("unroll") for (int k = 0; k < 2; ++k) \
            acc[ai][bj][m][n] = __builtin_amdgcn_mfma_f32_16x16x32_bf16(Bt[n][k], At[m][k], acc[ai][bj][m][n], 0, 0, 0); } \
        __builtin_amdgcn_s_setprio(0); } while (0)
#define PG8_WAIT_V(n) asm volatile("s_waitcnt vmcnt(" #n ")" ::: "memory")
#define PG8_WAIT_L(n) asm volatile("s_waitcnt lgkmcnt(" #n ")" ::: "memory")
#define PG8_BAR __builtin_amdgcn_s_barrier()
#define PG8_SCHED __builtin_amdgcn_sched_barrier(0)
    Unit cur, nxt; int ui = 0;
    if (!S.next(0, cur)) return;
    f32x4 acc[2][2][4][2];
#pragma unroll
    for (int a = 0; a < 2; ++a)
#pragma unroll
        for (int b = 0; b < 2; ++b)
#pragma unroll
            for (int m = 0; m < 4; ++m)
#pragma unroll
                for (int n = 0; n < 2; ++n) acc[a][b][m][n] = (f32x4){0.f, 0.f, 0.f, 0.f};
    bf16x8 At[4][2], B0[2][2], B1[2][2];
    i32x8 At8[4], B08[2], B18[2];
    int fp8_one = 0x7F7F7F7F; if constexpr (FP8) asm volatile("" : "+v"(fp8_one));
    const char* cA = (const char*)g.A + (size_t)cur.pm * tstep + cur.aoffb; const char* cB = (const char*)g.Bt + (size_t)cur.pn * tstep + cur.boffb;
    S.a_ready(cur);
    if constexpr (SP2) {
        PG8_STAGE(PG8_SB(0, 0), cB, voffB); PG8_STAGE(PG8_SB(0, 1), cB + hstep, voffB); PG8_STAGE(PG8_SA(0, 0), cA, voffA); PG8_STAGE(PG8_SA(0, 1), cA + hstep, voffA);
        if (wr == 1) PG8_BAR;
        PG8_WAIT_V(2); PG8_BAR;
        PG8_STAGE(PG8_SB(1, 0), cB + kstep, voffB); PG8_STAGE(PG8_SA(1, 0), cA + kstep, voffA); PG8_STAGE(PG8_SB(1, 1), cB + hstep + kstep, voffB);
        PG8_WAIT_V(6); PG8_BAR;
    } else {
        PG8_STAGE(PG8_SB(0, 0), cB, voffB); PG8_STAGE(PG8_SA(0, 0), cA, voffA); PG8_STAGE(PG8_SB(0, 1), cB + hstep, voffB); PG8_STAGE(PG8_SA(0, 1), cA + hstep, voffA);
        if (wr == 1) PG8_BAR;
        PG8_WAIT_V(4); PG8_BAR;
        PG8_STAGE(PG8_SB(1, 0), cB + kstep, voffB); PG8_STAGE(PG8_SA(1, 0), cA + kstep, voffA); PG8_STAGE(PG8_SB(1, 1), cB + hstep + kstep, voffB);
        PG8_WAIT_V(6); PG8_BAR;
    }
    for (;;) {
        const bool has_next = S.next(ui + 1, nxt);
        const char* nA = has_next ? (const char*)g.A + (size_t)nxt.pm * tstep + nxt.aoffb : cA; const char* nB = has_next ? (const char*)g.Bt + (size_t)nxt.pn * tstep + nxt.boffb : cB;
#pragma unroll 1
        for (int t = 0; t < nt; t += 2) {
            const bool last = (t == nt - 2);
            const char* a1 = cA + (size_t)(t + 1) * kstep;
            const char* a2 = last ? nA : cA + (size_t)(t + 2) * kstep; const char* b2 = last ? nB : cB + (size_t)(t + 2) * kstep;
            const char* a3 = a2 + kstep; const char* b3 = b2 + kstep;
            if (last && has_next) S.a_ready(nxt);
            if constexpr (SP2) {
            PG8_LDB(B0, 0, 0); PG8_LDB(B1, 0, 1); PG8_SCHED; PG8_LDA(At, 0, 0); PG8_STAGE(PG8_SA(1, 1), a1 + hstep, voffA);
            PG8_WAIT_V(8); PG8_WAIT_L(0); PG8_BAR; PG8_MMA(0, 0, At, B0); PG8_MMA(0, 1, At, B1); PG8_BAR; PG8_SCHED;
            PG8_LDA(At, 0, 1); PG8_STAGE(PG8_SB(0, 0), b2, voffB); PG8_STAGE(PG8_SB(0, 1), b2 + hstep, voffB); PG8_STAGE(PG8_SA(0, 0), a2, voffA);
            PG8_WAIT_V(8); PG8_WAIT_L(0); PG8_BAR; PG8_MMA(1, 0, At, B0); PG8_MMA(1, 1, At, B1); PG8_BAR; PG8_SCHED;
            PG8_LDB(B0, 1, 0); PG8_LDB(B1, 1, 1); PG8_SCHED; PG8_LDA(At, 1, 0); PG8_STAGE(PG8_SA(0, 1), a2 + hstep, voffA);
            PG8_WAIT_V(8); PG8_WAIT_L(0); PG8_BAR; PG8_MMA(0, 0, At, B0); PG8_MMA(0, 1, At, B1); PG8_BAR; PG8_SCHED;
            PG8_LDA(At, 1, 1); PG8_STAGE(PG8_SB(1, 0), b3, voffB); PG8_STAGE(PG8_SB(1, 1), b3 + hstep, voffB); PG8_STAGE(PG8_SA(1, 0), a3, voffA);
            PG8_WAIT_V(8); PG8_WAIT_L(0); PG8_BAR; PG8_MMA(1, 0, At, B0); PG8_MMA(1, 1, At, B1); PG8_BAR; PG8_SCHED;
            } else {
            PG8_LDB(B0, 0, 0); PG8_SCHED; PG8_LDA(At, 0, 0); PG8_STAGE(PG8_SA(1, 1), a1 + hstep, voffA);
            PG8_WAIT_L(8); PG8_BAR; PG8_WAIT_L(0); PG8_MMA(0, 0, At, B0); PG8_BAR; PG8_SCHED;
            PG8_LDB(B1, 0, 1); PG8_STAGE(PG8_SB(0, 0), b2, voffB);
            PG8_BAR; PG8_WAIT_L(0); PG8_MMA(0, 1, At, B1); PG8_BAR;
            PG8_LDA(At, 0, 1); PG8_STAGE(PG8_SA(0, 0), a2, voffA);
            PG8_BAR; PG8_WAIT_L(0); PG8_MMA(1, 0, At, B0); PG8_BAR; PG8_SCHED;
            PG8_STAGE(PG8_SB(0, 1), b2 + hstep, voffB);
            PG8_WAIT_V(6); PG8_BAR; PG8_MMA(1, 1, At, B1); PG8_BAR;
            PG8_LDB(B0, 1, 0); PG8_SCHED; PG8_LDA(At, 1, 0); PG8_STAGE(PG8_SA(0, 1), a2 + hstep, voffA);
            PG8_WAIT_L(8); PG8_BAR; PG8_WAIT_L(0); PG8_MMA(0, 0, At, B0); PG8_BAR; PG8_SCHED;
            PG8_LDB(B1, 1, 1); PG8_STAGE(PG8_SB(1, 0), b3, voffB);
            PG8_BAR; PG8_WAIT_L(0); PG8_MMA(0, 1, At, B1); PG8_BAR;
            PG8_LDA(At, 1, 1); PG8_STAGE(PG8_SA(1, 0), a3, voffA);
            PG8_BAR; PG8_WAIT_L(0); PG8_MMA(1, 0, At, B0); PG8_BAR; PG8_SCHED;
            PG8_STAGE(PG8_SB(1, 1), b3 + hstep, voffB);
            PG8_WAIT_V(6); PG8_BAR; PG8_MMA(1, 1, At, B1); PG8_BAR;
            }
        }
        if constexpr (FP8) asm volatile("s_nop 15\n\ts_nop 15" ::: "memory");
        if constexpr (ALIGN_EPI) { if (wr == 0) PG8_BAR; }
        if constexpr (!Epi::AFTER_DRAIN) { E(acc, cur, wr, wc, fr, fq); S.done(cur); }
        if (!has_next) break;
#pragma unroll
        for (int a = 0; a < 2; ++a)
#pragma unroll
            for (int b = 0; b < 2; ++b)
#pragma unroll
                for (int m = 0; m < 4; ++m)
#pragma unroll
                    for (int n = 0; n < 2; ++n) acc[a][b][m][n] = (f32x4){0.f, 0.f, 0.f, 0.f};
        cur = nxt; cA = nA; cB = nB; ++ui;
        if constexpr (ALIGN_EPI) { if (wr == 1) PG8_BAR; }
    }
    PG8_WAIT_V(0);
    if constexpr (!ALIGN_EPI) { if (wr == 0) PG8_BAR; }
    PG8_BAR;
    if constexpr (Epi::AFTER_DRAIN) { E.fused(acc, cur, wr, wc, fr, fq, lds, wid, lane); S.done(cur); }
#undef PG8_SA
#undef PG8_SB
#undef PG8_STAGE
#undef PG8_LDA
#undef PG8_LDB
#undef PG8_MMA
#undef PG8_WAIT_V
#undef PG8_WAIT_L
#undef PG8_BAR
#undef PG8_SCHED
}
}
#define GAS __attribute__((address_space(1)))
#define LAS __attribute__((address_space(3)))
typedef unsigned short bf16;
typedef unsigned v4u __attribute__((ext_vector_type(4)));
typedef float f32x4 __attribute__((ext_vector_type(4)));
typedef short bf16x8 __attribute__((ext_vector_type(8)));
typedef GAS unsigned gu32;
typedef GAS unsigned long long gu64;
#define RLX_AGENT __ATOMIC_RELAXED, __HIP_MEMORY_SCOPE_AGENT
#define LDS_WAIT() asm volatile("s_waitcnt lgkmcnt(0)" ::: "memory")
#define VM_WAIT() asm volatile("s_waitcnt vmcnt(0)" ::: "memory")
__device__ __forceinline__ unsigned long long rt() { return __builtin_amdgcn_s_memrealtime(); }
__device__ __forceinline__ unsigned f2bf(float f) { unsigned u = __builtin_bit_cast(unsigned, f); return (u + 0x7fffu + ((u >> 16) & 1u)) >> 16; }
typedef float pk_f32x2_t __attribute__((ext_vector_type(2))); typedef __bf16 pk_bf16x2_t __attribute__((ext_vector_type(2)));
__device__ __forceinline__ unsigned pk2(float lo, float hi) { const pk_f32x2_t v = {lo, hi}; return __builtin_bit_cast(unsigned, __builtin_convertvector(v, pk_bf16x2_t)); }

#define XB_TMO      128
#define XB_XCNT(j)  (256  + 64 * (j))
#define XB_XSUB(j)  (1280 + 64 * (j))
#define XB_XGEN(j)  (2304 + 64 * (j))
#define XB_TOP      3328
#define XB_TOPGEN   3392
#define XCD_BAR_WORDS 3456
#define XB_SPIN_CAP (1u << 18)

__device__ __forceinline__ unsigned xb_ld(unsigned* p)              { return __hip_atomic_load(p, __ATOMIC_RELAXED, __HIP_MEMORY_SCOPE_AGENT); }
__device__ __forceinline__ unsigned xb_add(unsigned* p, unsigned v) { return __hip_atomic_fetch_add(p, v, __ATOMIC_RELAXED, __HIP_MEMORY_SCOPE_AGENT); }
__device__ __forceinline__ unsigned xb_xcc_id() { return (unsigned)__builtin_amdgcn_s_getreg((3 << 11) | 20) & 0xFu; }
#define XB_SPIN(cond, bar) do { unsigned _sp = 0; while (cond) { __builtin_amdgcn_s_sleep(1); \
    if ((++_sp & 255u) == 0u) { if (xb_ld(&(bar)[XB_TMO])) break; if (_sp > XB_SPIN_CAP) { atomicAdd(&(bar)[XB_TMO], 1u); break; } } } } while (0)

struct XcdBarrier {
    unsigned* bar; unsigned x;
    volatile LAS unsigned* st;
};

__device__ __forceinline__ XcdBarrier xcd_barrier_post(unsigned* bar, volatile LAS unsigned* st) {
    XcdBarrier b; b.bar = bar; b.x = xb_xcc_id(); b.st = st;
    if (threadIdx.x == 0) (void)xb_add(&bar[XB_XCNT(b.x)], 1u);
    return b;
}
__device__ __forceinline__ void xcd_barrier_complete(unsigned* bar, unsigned x, unsigned& nloc, unsigned& nx) {
    const unsigned G = gridDim.x * gridDim.y * gridDim.z;
    unsigned sum, cnt, mine, sp = 0u;
    for (;;) {
        sum = 0u; cnt = 0u; mine = 0u;
#pragma unroll
        for (unsigned j = 0; j < 16; ++j) { const unsigned c = xb_ld(&bar[XB_XCNT(j)]); sum += c; cnt += (c > 0u) ? 1u : 0u; mine = (j == x) ? c : mine; }
        if (sum == G) break;
        __builtin_amdgcn_s_sleep(1);
        if ((++sp & 255u) == 0u) { if (xb_ld(&bar[XB_TMO])) break; if (sp > XB_SPIN_CAP) { atomicAdd(&bar[XB_TMO], 1u); break; } }
    }
    nloc = mine > 0u ? mine : 1u; nx = cnt > 0u ? cnt : 1u;
}

__device__ __forceinline__ void xcd_barrier(const XcdBarrier& b) {
    asm volatile("s_waitcnt vmcnt(0)" ::: "memory");
    __syncthreads();
    if (threadIdx.x == 0) {
        unsigned* bar = b.bar;
        __builtin_amdgcn_s_waitcnt(0);
        unsigned nloc = b.st[0], nx = b.st[1];
        if (nloc == 0u) { xcd_barrier_complete(bar, b.x, nloc, nx); b.st[0] = nloc; b.st[1] = nx; }
        const unsigned old = xb_add(&bar[XB_XSUB(b.x)], 1u);
        const unsigned gen = old / nloc;
        if (old + 1u == (gen + 1u) * nloc) {
            __builtin_amdgcn_fence(__ATOMIC_RELEASE, "agent");
            asm volatile("s_waitcnt vmcnt(0)" ::: "memory");
            const unsigned og = xb_add(&bar[XB_TOP], 1u);
            const unsigned tg = og / nx;
            if (og + 1u == (tg + 1u) * nx) xb_add(&bar[XB_TOPGEN], 1u);
            else XB_SPIN(xb_ld(&bar[XB_TOPGEN]) == tg, bar);
            __builtin_amdgcn_fence(__ATOMIC_ACQUIRE, "agent");
            xb_add(&bar[XB_XGEN(b.x)], 1u);
            asm volatile("s_waitcnt vmcnt(0)" ::: "memory");
        } else {
            XB_SPIN(xb_ld(&bar[XB_XGEN(b.x)]) == gen, bar);
            __builtin_amdgcn_fence(__ATOMIC_ACQUIRE, "agent");
            asm volatile("s_waitcnt vmcnt(0)" ::: "memory");
        }
    }
    __syncthreads();
}


constexpr int NWAVES = 8;
constexpr int NBATCH = 8, SEQ = 4096, M = NBATCH * SEQ, D = 1024, DIN = 2560, DA = 512, DL = 512, NH = 8, HD = 64;
constexpr int DFF = 2816, NE = 8, DFE = 3584;
constexpr int SORT_ROWS = 2 * M + NE * 256, NT_MAX = SORT_ROWS / 256;
constexpr int CHUNK_TILES = 128, NCHUNK = (NT_MAX + CHUNK_TILES - 1) / CHUNK_TILES;
constexpr float ALPHA = 1.4142135623730951f, LN_EPS = 1e-5f, RMS_EPS = 1e-6f;
constexpr float LOG2E = 1.4426950408889634f, QSCALE = 0.125f * LOG2E;
constexpr int PH_PRO = 0, PH_L0 = 1, PH_L1 = 9;
constexpr int PH_DISPATCH = 14, PH_MOE0 = 15, PH_COMBINE = PH_MOE0 + 2 * NCHUNK, NPH = PH_COMBINE + 1;
constexpr size_t MiB = 1u << 20;
constexpr size_t WS_CTL = 0, CTL_ZERO_BYTES = 1 * MiB;
constexpr size_t WS_TOKE = 1 * MiB, WS_TOKP = WS_TOKE + 256 * 1024, WS_TOKPOS = WS_TOKP + 256 * 1024, WS_SEG = WS_TOKPOS + 256 * 1024;
constexpr size_t WS_LRUW = 2 * MiB;
constexpr size_t WS_LSE = 3 * MiB, WS_AGG = 6 * MiB;
constexpr size_t WS_WIN = 8 * MiB, WS_WOUT = 18 * MiB, WS_WGU = 22 * MiB, WS_WD = 33 * MiB, WS_MGU = 39 * MiB, WS_MD = 95 * MiB;
constexpr size_t WS_XB = 207 * MiB;
constexpr size_t WS_Q = 271 * MiB, WS_K = 303 * MiB, WS_V = 335 * MiB, WS_U = 367 * MiB, WS_G = 399 * MiB;
constexpr size_t WS_O0 = 39 * MiB, WS_O1 = 71 * MiB, WS_O2 = 103 * MiB;
constexpr size_t WS_LA = 135 * MiB, WS_BE = 167 * MiB;
constexpr size_t WS_Y = WS_Q;
constexpr size_t WS_HB = 271 * MiB, WS_X8 = 359 * MiB;
constexpr int TAIL_KS = 512, TAIL_NS = DFE / TAIL_KS, TAIL_TILES = NT_MAX - (NCHUNK - 1) * CHUNK_TILES;
constexpr size_t WS_PART = 8 * MiB;
static_assert(WS_PART + (size_t)TAIL_NS * TAIL_TILES * 256 * D * 2 <= 39 * MiB, "tail partials");
constexpr size_t WS_HCA = 151 * MiB, WS_XS8 = 271 * MiB, WS_YS = 337 * MiB, WS_END = 469 * MiB;
constexpr float MOE_HSCALE = 8.0f, MOE_DSCALE = 128.0f;
constexpr float MOE_WSCALE = 32.0f;
static_assert(WS_MGU + (size_t)NE * 2 * DFE * D <= WS_MD && WS_MD + (size_t)NE * D * DFE <= WS_HCA && WS_HCA + (size_t)TAIL_TILES * 256 * DFE <= WS_XB && (size_t)CHUNK_TILES * 256 * DFE <= (size_t)M * D * 4 && WS_XS8 + (size_t)SORT_ROWS * D <= WS_YS && WS_YS + (size_t)SORT_ROWS * D * 2 <= WS_END, "d_ws map");
constexpr int CW_TMO = 0, CW_CODE = 1, CW_BAR = 4096;
constexpr unsigned long long PROBE_MASK = 0ull; constexpr unsigned PROBE_K = 8; constexpr int PROBE_SEAM = -1;
constexpr int RING_OFF = 0, RING_BYTES = 131072;
constexpr int LDSCTL_OFF = RING_BYTES, MISC_OFF = LDSCTL_OFF + 320;
constexpr int LDS_BYTES = 147456;

typedef int v4i __attribute__((ext_vector_type(4)));
typedef unsigned v2u __attribute__((ext_vector_type(2)));
typedef float f32x2 __attribute__((ext_vector_type(2)));
struct Frame {
    LAS unsigned char* lds;
    volatile LAS unsigned* MISC;
    gu32* ctl;
    int tid, lane, wave;
    int vcu, G;
    unsigned long long pt0, pacc;
};
__device__ __forceinline__ int fresh_lane() { int l; asm volatile("v_mbcnt_lo_u32_b32 %0, -1, 0\n\tv_mbcnt_hi_u32_b32 %0, -1, %0" : "=v"(l)); return l; }
struct Args { const float* in[24]; float* out; unsigned char* ws; int ph_lo, ph_hi, li, pad; };

__device__ __forceinline__ float wave_sum(float v) {
#pragma unroll
    for (int o = 1; o < 64; o <<= 1) v += __shfl_xor(v, o);
    return v;
}
__device__ __forceinline__ float bf2f(bf16 h) { return __uint_as_float((unsigned)h << 16); }
__device__ __forceinline__ float bflo(unsigned w) { return __uint_as_float(w << 16); }
__device__ __forceinline__ float bfhi(unsigned w) { return __uint_as_float(w & 0xffff0000u); }

__device__ __forceinline__ void transpose_item(const float* W, int N, bf16* WT, int ldt, int dst_row0, LAS float* scr, int kb, int nb, int lane) {
    const int k0 = 64 * kb, n0 = 32 * nb;
    f32x4 v[8];
#pragma unroll
    for (int i = 0; i < 8; ++i) v[i] = *(const GAS f32x4*)(W + (size_t)(k0 + 8 * i + (lane >> 3)) * N + n0 + 4 * (lane & 7));
#pragma unroll
    for (int i = 0; i < 8; ++i) { LAS float* d = scr + (8 * i + (lane >> 3)) * 33 + 4 * (lane & 7); d[0] = v[i].x; d[1] = v[i].y; d[2] = v[i].z; d[3] = v[i].w; }
    LDS_WAIT(); asm volatile("" ::: "memory");
    const int c = lane & 7;
#pragma unroll
    for (int j = 0; j < 4; ++j) { const int n = (lane >> 3) + 8 * j; const LAS float* s = scr + (8 * c) * 33 + n;
        v4u o; o.x = pk2(s[0 * 33], s[1 * 33]); o.y = pk2(s[2 * 33], s[3 * 33]); o.z = pk2(s[4 * 33], s[5 * 33]); o.w = pk2(s[6 * 33], s[7 * 33]);
        *(GAS v4u*)(WT + (size_t)(dst_row0 + n) * ldt + k0 + 8 * c) = o; }
    LDS_WAIT(); asm volatile("" ::: "memory");
}
__device__ __forceinline__ unsigned pk4_fp8(float a, float b, float c, float d) {
    a = __builtin_fminf(__builtin_fmaxf(a, -448.f), 448.f); b = __builtin_fminf(__builtin_fmaxf(b, -448.f), 448.f); c = __builtin_fminf(__builtin_fmaxf(c, -448.f), 448.f); d = __builtin_fminf(__builtin_fmaxf(d, -448.f), 448.f);
    unsigned w = 0u; w = __builtin_amdgcn_cvt_pk_fp8_f32(a, b, w, false); w = __builtin_amdgcn_cvt_pk_fp8_f32(c, d, w, true); return w;
}
__device__ __forceinline__ void transpose_item_fp8(const float* W, int N, unsigned char* WT8, int ldt, int dst_row0, LAS float* scr, int kb, int nb, int lane, float scale) {
    const int k0 = 64 * kb, n0 = 32 * nb;
    f32x4 v[8];
#pragma unroll
    for (int i = 0; i < 8; ++i) v[i] = *(const GAS f32x4*)(W + (size_t)(k0 + 8 * i + (lane >> 3)) * N + n0 + 4 * (lane & 7));
#pragma unroll
    for (int i = 0; i < 8; ++i) { LAS float* d = scr + (8 * i + (lane >> 3)) * 33 + 4 * (lane & 7); d[0] = v[i].x * scale; d[1] = v[i].y * scale; d[2] = v[i].z * scale; d[3] = v[i].w * scale; }
    LDS_WAIT(); asm volatile("" ::: "memory");
    const int c = lane & 3;
#pragma unroll
    for (int j = 0; j < 2; ++j) { const int n = (lane >> 2) + 16 * j; const LAS float* s = scr + (16 * c) * 33 + n;
        v4u o; o.x = pk4_fp8(s[0 * 33], s[1 * 33], s[2 * 33], s[3 * 33]); o.y = pk4_fp8(s[4 * 33], s[5 * 33], s[6 * 33], s[7 * 33]);
        o.z = pk4_fp8(s[8 * 33], s[9 * 33], s[10 * 33], s[11 * 33]); o.w = pk4_fp8(s[12 * 33], s[13 * 33], s[14 * 33], s[15 * 33]);
        *(GAS v4u*)(WT8 + (size_t)(dst_row0 + n) * ldt + k0 + 16 * c) = o; }
    LDS_WAIT(); asm volatile("" ::: "memory");
}
__device__ __forceinline__ void tr_gu8(const float* W, int K, int N, unsigned char* WT8, int half, LAS float* scr, int item, int lane, float scale) {
    const int nblk = N / 32, kb = item / nblk, nb = item % nblk, n0 = 32 * nb; transpose_item_fp8(W, N, WT8, K, (n0 >> 7) * 256 + half * 128 + (n0 & 127), scr, kb, nb, lane, scale);
}
__device__ __forceinline__ void tr_plain8(const float* W, int K, int N, unsigned char* WT8, LAS float* scr, int item, int lane, float scale) {
    const int nblk = N / 32, kb = item / nblk, nb = item % nblk; transpose_item_fp8(W, N, WT8, K, 32 * nb, scr, kb, nb, lane, scale);
}
__device__ __forceinline__ void tr_plain(const float* W, int K, int N, bf16* WT, LAS float* scr, int item, int lane) {
    const int nblk = N / 32, kb = item / nblk, nb = item % nblk; transpose_item(W, N, WT, K, 32 * nb, scr, kb, nb, lane);
}
__device__ __forceinline__ void tr_gu(const float* W, int K, int N, bf16* WT, int half, LAS float* scr, int item, int lane) {
    const int nblk = N / 32, kb = item / nblk, nb = item % nblk, n0 = 32 * nb; transpose_item(W, N, WT, K, (n0 >> 7) * 256 + half * 128 + (n0 & 127), scr, kb, nb, lane);
}

__device__ __forceinline__ void phase_prologue(Frame& F, const Args& a) {
    LAS float* scr = (LAS float*)(F.lds + RING_OFF + F.wave * 16384);
    const int gw = F.vcu * NWAVES + F.wave, NGW = F.G * NWAVES;
    unsigned char* ws = a.ws;
    constexpr int I_WIN = (D / 64) * (DIN / 32), I_WOUT = (D / 64) * (D / 32), I_GU = (D / 64) * (DFF / 32), I_DN = (DFF / 64) * (D / 32), I_LRU = 64;
    constexpr int NITEMS = 2 * I_WIN + 2 * I_WOUT + 2 * I_GU + I_DN + I_LRU;
    for (int it = gw; it < NITEMS; it += NGW) {
        int r = it;
        if (r < 2 * I_WIN) { const int l = r / I_WIN; r -= l * I_WIN; tr_plain(a.in[1] + (size_t)l * D * DIN, D, DIN, (bf16*)(ws + WS_WIN) + (size_t)l * DIN * D, scr, r, F.lane); continue; } r -= 2 * I_WIN;
        if (r < 2 * I_WOUT) { const int l = r / I_WOUT; r -= l * I_WOUT; tr_plain(a.in[12] + (size_t)l * D * D, D, D, (bf16*)(ws + WS_WOUT) + (size_t)l * D * D, scr, r, F.lane); continue; } r -= 2 * I_WOUT;
        if (r < I_GU) { tr_gu(a.in[17], D, DFF, (bf16*)(ws + WS_WGU), 0, scr, r, F.lane); continue; } r -= I_GU;
        if (r < I_GU) { tr_gu(a.in[18], D, DFF, (bf16*)(ws + WS_WGU), 1, scr, r, F.lane); continue; } r -= I_GU;
        if (r < I_DN) { tr_plain8(a.in[19], DFF, D, ws + WS_WD, scr, r, F.lane, MOE_DSCALE); continue; } r -= I_DN;
        { const int mi = r >> 1, it2 = r & 1, l = mi >> 4, gate = (mi >> 3) & 1, g = mi & 7;
          const float* src = (gate ? a.in[6] : a.in[4]) + (size_t)(l * 8 + g) * 4096; tr_plain(src, 64, 64, (bf16*)(ws + WS_LRUW) + (size_t)mi * 4096, scr, it2, F.lane); }
    }
    const float* x = a.in[0]; bf16* XBp = (bf16*)(ws + WS_XB);
    for (int m = gw; m < M; m += NGW) {
        const GAS f32x4* xr = (const GAS f32x4*)(x + (size_t)m * D) + F.lane; GAS unsigned long long* o8 = (GAS unsigned long long*)(XBp + (size_t)m * D) + F.lane;
#pragma unroll
        for (int j = 0; j < 4; ++j) { const f32x4 v = xr[64 * j]; o8[64 * j] = (unsigned long long)pk2(v.x, v.y) | ((unsigned long long)pk2(v.z, v.w) << 32); }
    }
}
struct CvtItem { const float* src; unsigned char* dst; int N, ldt; float scale; };
__device__ __forceinline__ CvtItem moe_cvt_item(const Args& a, int it) {
    constexpr int I_MG = (D / 64) * (DFE / 32), I_MD = (DFE / 64) * (D / 32), I_E = 2 * I_MG + I_MD;
    const int e = it / I_E; int r = it - e * I_E;
    CvtItem c;
    if (r < 2 * I_MG) { const int half = r >= I_MG ? 1 : 0; r -= half * I_MG; constexpr int nblk = DFE / 32; const int kb = r / nblk, nb = r - kb * nblk, n0 = 32 * nb;
        c.src = (half ? a.in[22] : a.in[21]) + (size_t)e * D * DFE + (size_t)(64 * kb) * DFE + n0; c.N = DFE;
        c.dst = a.ws + WS_MGU + (size_t)e * (2 * DFE) * D + (size_t)((n0 >> 7) * 256 + half * 128 + (n0 & 127)) * D + 64 * kb; c.ldt = D; c.scale = MOE_WSCALE; }
    else { r -= 2 * I_MG; constexpr int nblk = D / 32; const int kb = r / nblk, nb = r - kb * nblk;
        c.src = a.in[23] + (size_t)e * DFE * D + (size_t)(64 * kb) * D + 32 * nb; c.N = D;
        c.dst = a.ws + WS_MD + (size_t)e * D * DFE + (size_t)(32 * nb) * DFE + 64 * kb; c.ldt = DFE; c.scale = MOE_DSCALE; }
    return c;
}
#define CVT_LOAD(v_, c_) do { _Pragma("unroll") for (int i_ = 0; i_ < 8; ++i_) v_[i_] = *(const GAS f32x4*)((c_).src + (size_t)(8 * i_ + (F.lane >> 3)) * (c_).N + 4 * (F.lane & 7)); } while (0)
__device__ __forceinline__ void phase_moe_cvt(Frame& F, const Args& a) {
    LAS float* scr = (LAS float*)(F.lds + RING_OFF + 32768 + F.wave * 8704);
    const int gw = F.vcu * NWAVES + F.wave, NGW = F.G * NWAVES;
    constexpr int I_MG = (D / 64) * (DFE / 32), I_MD = (DFE / 64) * (D / 32), TOT = NE * (2 * I_MG + I_MD);
    CvtItem c1 = moe_cvt_item(a, gw < TOT ? gw : 0), c2 = moe_cvt_item(a, gw + NGW < TOT ? gw + NGW : 0);
    f32x4 v1[8], v2[8];
    CVT_LOAD(v1, c1); CVT_LOAD(v2, c2);
    for (int it = gw; it < TOT; it += NGW) {
        const CvtItem c = c1; f32x4 v[8];
#pragma unroll
        for (int i = 0; i < 8; ++i) { v[i] = v1[i]; v1[i] = v2[i]; }
        c1 = c2; c2 = moe_cvt_item(a, it + 2 * NGW < TOT ? it + 2 * NGW : it);
        CVT_LOAD(v2, c2);
        const int l = F.lane;
#pragma unroll
        for (int i = 0; i < 8; ++i) { LAS float* d = scr + (8 * i + (l >> 3)) * 33 + 4 * (l & 7); d[0] = v[i].x * c.scale; d[1] = v[i].y * c.scale; d[2] = v[i].z * c.scale; d[3] = v[i].w * c.scale; }
        LDS_WAIT(); asm volatile("" ::: "memory");
        const int cc = l & 3;
#pragma unroll
        for (int j = 0; j < 2; ++j) { const int n = (l >> 2) + 16 * j; const LAS float* s = scr + (16 * cc) * 33 + n;
            v4u o; o.x = pk4_fp8(s[0 * 33], s[1 * 33], s[2 * 33], s[3 * 33]); o.y = pk4_fp8(s[4 * 33], s[5 * 33], s[6 * 33], s[7 * 33]);
            o.z = pk4_fp8(s[8 * 33], s[9 * 33], s[10 * 33], s[11 * 33]); o.w = pk4_fp8(s[12 * 33], s[13 * 33], s[14 * 33], s[15 * 33]);
            *(GAS v4u*)(c.dst + (size_t)n * c.ldt + 16 * cc) = o; }
        LDS_WAIT(); asm volatile("" ::: "memory");
    }
}
#undef CVT_LOAD
template <bool ROUTE>
__device__ __forceinline__ void phase_ln(Frame& F, bf16* XBp, const float* g, const float* b, const float* rw, int* tok_e, float* tok_p, unsigned char* X8 = nullptr) {
    const int gw = F.vcu * NWAVES + F.wave, NGW = F.G * NWAVES;
    LAS f32x4* rws = (LAS f32x4*)(F.lds + RING_OFF);
    if (ROUTE) { for (int i = F.tid; i < 2048; i += NWAVES * 64) rws[i] = ((const GAS f32x4*)rw)[i]; LDS_WAIT(); __syncthreads(); }
    f32x4 gv[4], bv[4];
#pragma unroll
    for (int j = 0; j < 2; ++j) { gv[2 * j] = ((const GAS f32x4*)g)[2 * F.lane + 128 * j]; gv[2 * j + 1] = ((const GAS f32x4*)g)[2 * F.lane + 128 * j + 1]; bv[2 * j] = ((const GAS f32x4*)b)[2 * F.lane + 128 * j]; bv[2 * j + 1] = ((const GAS f32x4*)b)[2 * F.lane + 128 * j + 1]; }
    v4u nx[2], ny[2];
    { const GAS v4u* xr = (const GAS v4u*)(XBp + (size_t)(gw < M ? gw : 0) * D) + F.lane; nx[0] = xr[0]; nx[1] = xr[64]; }
    { const int m1 = (gw + NGW < M) ? gw + NGW : 0; const GAS v4u* xr = (const GAS v4u*)(XBp + (size_t)m1 * D) + F.lane; ny[0] = xr[0]; ny[1] = xr[64]; }
    for (int m = gw; m < M; m += NGW) {
        const v4u r0 = nx[0], r1 = nx[1];
        nx[0] = ny[0]; nx[1] = ny[1];
        { const int mn = (m + 2 * NGW < M) ? m + 2 * NGW : m; const GAS v4u* xr = (const GAS v4u*)(XBp + (size_t)mn * D) + F.lane; ny[0] = xr[0]; ny[1] = xr[64]; }
        f32x4 v[4];
        v[0] = (f32x4){bflo(r0.x), bfhi(r0.x), bflo(r0.y), bfhi(r0.y)}; v[1] = (f32x4){bflo(r0.z), bfhi(r0.z), bflo(r0.w), bfhi(r0.w)};
        v[2] = (f32x4){bflo(r1.x), bfhi(r1.x), bflo(r1.y), bfhi(r1.y)}; v[3] = (f32x4){bflo(r1.z), bfhi(r1.z), bflo(r1.w), bfhi(r1.w)};
        float s = 0.f;
#pragma unroll
        for (int j = 0; j < 4; ++j) s += (v[j].x + v[j].y) + (v[j].z + v[j].w);
        const float mean = wave_sum(s) * (1.f / D); float s2 = 0.f;
#pragma unroll
        for (int j = 0; j < 4; ++j) { v[j] = v[j] - mean; s2 += (v[j].x * v[j].x + v[j].y * v[j].y) + (v[j].z * v[j].z + v[j].w * v[j].w); }
        const float rstd = 1.f / sqrtf(wave_sum(s2) * (1.f / D) + LN_EPS);
#pragma unroll
        for (int j = 0; j < 4; ++j) v[j] = v[j] * rstd * gv[j] + bv[j];
        GAS v4u* xw = (GAS v4u*)(XBp + (size_t)m * D) + F.lane;
        xw[0] = (v4u){pk2(v[0].x, v[0].y), pk2(v[0].z, v[0].w), pk2(v[1].x, v[1].y), pk2(v[1].z, v[1].w)};
        xw[64] = (v4u){pk2(v[2].x, v[2].y), pk2(v[2].z, v[2].w), pk2(v[3].x, v[3].y), pk2(v[3].z, v[3].w)};
        if (X8) { GAS v2u* x8 = (GAS v2u*)(X8 + (size_t)m * D) + F.lane;
            x8[0] = (v2u){pk4_fp8(v[0].x, v[0].y, v[0].z, v[0].w), pk4_fp8(v[1].x, v[1].y, v[1].z, v[1].w)}; x8[64] = (v2u){pk4_fp8(v[2].x, v[2].y, v[2].z, v[2].w), pk4_fp8(v[3].x, v[3].y, v[3].z, v[3].w)}; }
        if (ROUTE) {
            f32x4 la = {0.f, 0.f, 0.f, 0.f}, lb = {0.f, 0.f, 0.f, 0.f};
#pragma unroll
            for (int j = 0; j < 4; ++j)
#pragma unroll
                for (int i = 0; i < 4; ++i) { const int c = 8 * F.lane + 512 * (j >> 1) + 4 * (j & 1) + i; const f32x4 w0 = rws[2 * c], w1 = rws[2 * c + 1]; la += w0 * v[j][i]; lb += w1 * v[j][i]; }
            float lg[8];
            lg[0] = wave_sum(la.x); lg[1] = wave_sum(la.y); lg[2] = wave_sum(la.z); lg[3] = wave_sum(la.w); lg[4] = wave_sum(lb.x); lg[5] = wave_sum(lb.y); lg[6] = wave_sum(lb.z); lg[7] = wave_sum(lb.w);
            int e0 = 0; float v0 = lg[0];
#pragma unroll
            for (int e = 1; e < 8; ++e) if (lg[e] > v0) { v0 = lg[e]; e0 = e; }
            int e1 = -1; float v1 = -INFINITY;
#pragma unroll
            for (int e = 0; e < 8; ++e) if (e != e0 && lg[e] > v1) { v1 = lg[e]; e1 = e; }
            if (F.lane == 0) { const float p1 = expf(v1 - v0), den = 1.f + p1; tok_e[2 * m] = e0; tok_e[2 * m + 1] = e1; tok_p[2 * m] = 1.f / den; tok_p[2 * m + 1] = p1 / den; }
        }
    }
}
__device__ __forceinline__ void phase_dispatch(Frame& F, const int* tok_e, int* tok_pos, int* segtab, const bf16* XBp, unsigned char* XS8) {
    LAS int* s_tot = (LAS int*)(F.lds + RING_OFF); LAS int* s_bef = s_tot + 8; LAS int* s_w = s_tot + 16; LAS int* s_pos = s_tot + 32;
    for (int tile = blockIdx.x; tile < M / 128; tile += F.G) {
        __syncthreads();
        if (F.tid < 32) s_tot[F.tid] = 0;
        __syncthreads();
        int tot[8], bef[8];
#pragma unroll
        for (int e = 0; e < 8; ++e) { tot[e] = 0; bef[e] = 0; }
        const GAS v4i* te4 = (const GAS v4i*)tok_e;
        for (int i4 = F.tid; i4 < 2 * M / 4; i4 += NWAVES * 64) { const v4i ev = te4[i4]; const int before = (2 * i4 < tile * 128) ? 1 : 0;
#pragma unroll
            for (int e = 0; e < 8; ++e) { const int hit = (ev.x == e) + (ev.y == e) + (ev.z == e) + (ev.w == e); tot[e] += hit; bef[e] += before ? hit : 0; } }
#pragma unroll
        for (int e = 0; e < 8; ++e) { int a = tot[e], b = bef[e];
#pragma unroll
            for (int o = 1; o < 64; o <<= 1) { a += __shfl_xor(a, o); b += __shfl_xor(b, o); }
            if (F.lane == 0) { __hip_atomic_fetch_add(&s_tot[e], a, __ATOMIC_RELAXED, __HIP_MEMORY_SCOPE_WORKGROUP); __hip_atomic_fetch_add(&s_bef[e], b, __ATOMIC_RELAXED, __HIP_MEMORY_SCOPE_WORKGROUP); } }
        int e0 = -1, e1 = -1, rk0 = 0, rk1 = 0; const int tok = tile * 128 + F.tid;
        if (F.wave < 2) { e0 = tok_e[2 * tok]; e1 = tok_e[2 * tok + 1];
#pragma unroll
            for (int e = 0; e < 8; ++e) { const bool has = (e0 == e) || (e1 == e); const unsigned long long mask = __ballot(has); const int rk = __popcll(mask & ((1ull << F.lane) - 1ull));
                if (e0 == e) rk0 = rk; if (e1 == e) rk1 = rk; if (F.lane == 0) s_w[F.wave * 8 + e] = __popcll(mask); } }
        LDS_WAIT(); __syncthreads();
        int seg[9]; seg[0] = 0;
#pragma unroll
        for (int e = 0; e < 8; ++e) seg[e + 1] = seg[e] + ((s_tot[e] + 255) & ~255);
        if (F.wave < 2) { int p0 = 0, p1 = 0;
#pragma unroll
            for (int e = 0; e < 8; ++e) { const int wp = (F.wave == 1) ? s_w[e] : 0; if (e0 == e) p0 = seg[e] + s_bef[e] + wp + rk0; if (e1 == e) p1 = seg[e] + s_bef[e] + wp + rk1; }
            tok_pos[2 * tok] = p0; tok_pos[2 * tok + 1] = p1; s_pos[2 * F.tid] = p0; s_pos[2 * F.tid + 1] = p1; }
        if (tile == 0) {
#pragma unroll
            for (int k = 0; k < 9; ++k) if (F.tid == k) segtab[k] = seg[k] >> 8;
        }
        LDS_WAIT(); __syncthreads();
        for (int i0 = F.wave * 16; i0 < F.wave * 16 + 16; i0 += 4) { v4u ra[4], rb[4];
#pragma unroll
            for (int j = 0; j < 4; ++j) { const GAS v4u* src = (const GAS v4u*)(XBp + (size_t)(tile * 128 + i0 + j) * D) + F.lane; ra[j] = src[0]; rb[j] = src[64]; }
#pragma unroll
            for (int j = 0; j < 4; ++j) { const int p0 = s_pos[2 * (i0 + j)], p1 = s_pos[2 * (i0 + j) + 1];
                v2u qa, qb;
                qa.x = pk4_fp8(bflo(ra[j].x), bfhi(ra[j].x), bflo(ra[j].y), bfhi(ra[j].y)); qa.y = pk4_fp8(bflo(ra[j].z), bfhi(ra[j].z), bflo(ra[j].w), bfhi(ra[j].w));
                qb.x = pk4_fp8(bflo(rb[j].x), bfhi(rb[j].x), bflo(rb[j].y), bfhi(rb[j].y)); qb.y = pk4_fp8(bflo(rb[j].z), bfhi(rb[j].z), bflo(rb[j].w), bfhi(rb[j].w));
                GAS v2u* d0 = (GAS v2u*)(XS8 + (size_t)p0 * D) + F.lane; d0[0] = qa; d0[64] = qb;
                GAS v2u* d1 = (GAS v2u*)(XS8 + (size_t)p1 * D) + F.lane; d1[0] = qa; d1[64] = qb; } }
    }
}
__device__ __forceinline__ void phase_combine(Frame& F, const bf16* XBp, float* outp, const bf16* YS, const int* tok_pos, const float* tok_p, const float* g, const float* b, const bf16* PART, const int mode, const int tail_row0, const int gw, const int NGW) {
    f32x4 gv[4], bv[4];
#pragma unroll
    for (int j = 0; j < 4; ++j) { gv[j] = ((const GAS f32x4*)g)[F.lane + 64 * j]; bv[j] = ((const GAS f32x4*)b)[F.lane + 64 * j]; }
    for (int m = gw; m < M; m += NGW) {
        const int p0 = __builtin_amdgcn_readfirstlane(tok_pos[2 * m]), p1 = __builtin_amdgcn_readfirstlane(tok_pos[2 * m + 1]);
        const bool in_tail = (p0 >= tail_row0) || (p1 >= tail_row0);
        if ((mode == 1 && in_tail) || (mode == 2 && !in_tail)) continue;
        const float w0 = tok_p[2 * m], w1 = tok_p[2 * m + 1];
        const GAS v2u* xr = (const GAS v2u*)(XBp + (size_t)m * D) + F.lane;
        const GAS v2u* y0 = (const GAS v2u*)(YS + (size_t)p0 * D) + F.lane; const GAS v2u* y1 = (const GAS v2u*)(YS + (size_t)p1 * D) + F.lane;
        f32x4 v[4]; float s = 0.f;
#pragma unroll
        for (int j = 0; j < 4; ++j) { const v2u x = xr[64 * j]; f32x4 ya, yc;
            if (p0 >= tail_row0) { ya = (f32x4){0.f, 0.f, 0.f, 0.f};
#pragma unroll
                for (int ks = 0; ks < TAIL_NS; ++ks) { const v2u q = ((const GAS v2u*)(PART + ((size_t)ks * TAIL_TILES * 256 + (p0 - tail_row0)) * D) + F.lane)[64 * j]; ya += (f32x4){bflo(q.x), bfhi(q.x), bflo(q.y), bfhi(q.y)}; } }
            else { const v2u q = y0[64 * j]; ya = (f32x4){bflo(q.x), bfhi(q.x), bflo(q.y), bfhi(q.y)}; }
            if (p1 >= tail_row0) { yc = (f32x4){0.f, 0.f, 0.f, 0.f};
#pragma unroll
                for (int ks = 0; ks < TAIL_NS; ++ks) { const v2u q = ((const GAS v2u*)(PART + ((size_t)ks * TAIL_TILES * 256 + (p1 - tail_row0)) * D) + F.lane)[64 * j]; yc += (f32x4){bflo(q.x), bfhi(q.x), bflo(q.y), bfhi(q.y)}; } }
            else { const v2u q = y1[64 * j]; yc = (f32x4){bflo(q.x), bfhi(q.x), bflo(q.y), bfhi(q.y)}; }
            v[j].x = ALPHA * bflo(x.x) + (w0 * ya.x + w1 * yc.x); v[j].y = ALPHA * bfhi(x.x) + (w0 * ya.y + w1 * yc.y);
            v[j].z = ALPHA * bflo(x.y) + (w0 * ya.z + w1 * yc.z); v[j].w = ALPHA * bfhi(x.y) + (w0 * ya.w + w1 * yc.w);
            s += (v[j].x + v[j].y) + (v[j].z + v[j].w); }
        const float mean = wave_sum(s) * (1.f / D); float s2 = 0.f;
#pragma unroll
        for (int j = 0; j < 4; ++j) { v[j] = v[j] - mean; s2 += (v[j].x * v[j].x + v[j].y * v[j].y) + (v[j].z * v[j].z + v[j].w * v[j].w); }
        const float rstd = 1.f / sqrtf(wave_sum(s2) * (1.f / D) + LN_EPS);
        GAS f32x4* ow = (GAS f32x4*)(outp + (size_t)m * D) + F.lane;
#pragma unroll
        for (int j = 0; j < 4; ++j) ow[64 * j] = v[j] * rstd * gv[j] + bv[j];
    }
}

namespace att {
typedef float f32x16 __attribute__((ext_vector_type(16)));
typedef short s16x4 __attribute__((ext_vector_type(4)));
constexpr int NTASK = NBATCH * NH * 48;
constexpr int K_PITCH = 144, V_OFF = 384 * K_PITCH, V_DBS = 384 * 64 + 64, BIAS_OFF = V_OFF + 2 * V_DBS, TAB_OFF = BIAS_OFF + 528, NEG_OFF = TAB_OFF + 5 * 4 * 64 * 16, ATT_LDS = NEG_OFF + 4 * 64 * 16;
static_assert(ATT_LDS <= RING_BYTES && (TAB_OFF % 16) == 0, "attention LDS");
__device__ __forceinline__ int t5_bucket(int dist) {
    if (dist < 16) return dist;
    int b = 16;
    b += dist >= 22; b += dist >= 30; b += dist >= 40; b += dist >= 54; b += dist >= 73; b += dist >= 99; b += dist >= 134; b += dist >= 182;
    b += dist >= 246; b += dist >= 332; b += dist >= 450; b += dist >= 609; b += dist >= 825; b += dist >= 1117; b += dist >= 1513;
    return b;
}
__device__ __forceinline__ s16x4 vtr(LAS const unsigned char* p) { typedef short v4i16_t __attribute__((ext_vector_type(4))); return __builtin_bit_cast(s16x4, __builtin_amdgcn_ds_read_tr16_b64_v4i16((LAS v4i16_t*)p)); }
struct Task { int head, p, b, r, k, dil; };
__device__ __forceinline__ Task decode(int n, int head) { Task t; t.head = head; t.p = n >> 7; t.b = (n >> 4) & 7; const int q16 = n & 15, npair = 16 >> (2 * t.p); t.r = q16 / npair; t.k = q16 - t.r * npair; t.dil = 1 << (2 * t.p); return t; }

#define PBR(k) do { if (PROBE_MASK >> 32) { const unsigned long long t_ = rt(); if ((PROBE_MASK >> (k)) & 1ull) F.pacc += t_ - F.pt0; F.pt0 = t_; } } while (0)
__device__ __forceinline__ void attn_phase(Frame& F, const bf16* Qg, const bf16* Kg, const bf16* Vg, const float* rel_bias, bf16* O0, bf16* O1, bf16* O2, float* LSE) {
    LAS unsigned char* lds = F.lds + RING_OFF;
    LAS float* bias_l = (LAS float*)(lds + BIAS_OFF);
    LAS f32x4* tab = (LAS f32x4*)(lds + TAB_OFF);
    const int w = F.wave, l = F.lane, q_rel = l & 31, hh = l >> 5;
    const int head = (int)blockIdx.x & 7, jwg = (int)blockIdx.x >> 3, nwg = (F.G + 7 - head) >> 3;
    const int T0 = jwg, T1 = NTASK / 8;
    v4u kreg[6], vreg[6]; bf16x8 qn[4];
    int cur_hp = -1;
#define ATT_LOAD(T_) do { const Task t_ = decode(T_, head); const size_t rb_ = (size_t)t_.b * SEQ * DA + t_.head * HD; \
        _Pragma("unroll") for (int n = 0; n < 6; ++n) { const int ci = F.tid + 512 * n, kk = ci >> 3, c = ci & 7, li = 256 * t_.k - 128 + kk; \
            const bool ok_ = li >= 0; const size_t off = rb_ + (size_t)((ok_ ? li : 0) * t_.dil + t_.r) * DA + c * 8;     \
            const v4u kx_ = *(const GAS v4u*)(Kg + off), vx_ = *(const GAS v4u*)(Vg + off); kreg[n] = ok_ ? kx_ : (v4u){0u, 0u, 0u, 0u}; vreg[n] = ok_ ? vx_ : (v4u){0u, 0u, 0u, 0u}; } \
        const bf16* qp_ = Qg + rb_ + (size_t)((256 * t_.k + 32 * w + q_rel) * t_.dil + t_.r) * DA + 8 * hh; \
        _Pragma("unroll") for (int s = 0; s < 4; ++s) qn[s] = *(const GAS bf16x8*)(qp_ + 16 * s); } while (0)
    if (T0 < T1) ATT_LOAD(T0);
    for (int T = T0; T < T1; T += nwg) {
        const Task t = decode(T, head);
        const int hp = t.p;
        if (PROBE_MASK >> 32) F.pt0 = rt();
        __syncthreads();
#pragma unroll
        for (int n = 0; n < 6; ++n) { const int ci = F.tid + 512 * n, kk = ci >> 3, c = ci & 7;
            *(LAS v4u*)(lds + kk * K_PITCH + c * 16) = kreg[n];
            *(LAS v4u*)(lds + V_OFF + (c >> 2) * V_DBS + kk * 64 + (c & 3) * 16) = vreg[n]; }
        bf16x8 qf[4];
#pragma unroll
        for (int s = 0; s < 4; ++s) qf[s] = qn[s];
        if (hp != cur_hp) {
            if (F.tid < 129) bias_l[F.tid] = rel_bias[t5_bucket(F.tid * t.dil) * NH + t.head] * LOG2E;
            LDS_WAIT(); __syncthreads();
            for (int idx = F.tid; idx < 5 * 4 * 64; idx += NWAVES * 64) { const int ln = idx & 63, e4 = (idx >> 6) & 3, i = idx >> 8, qr = ln & 31, h2 = ln >> 5;
                f32x4 tv;
#pragma unroll
                for (int j = 0; j < 4; ++j) { const int k_rel = j + 8 * e4 + 4 * h2; int delta = 128 - 32 * i + qr - k_rel; const bool ok = (i != 0 || k_rel >= qr) && (i != 4 || k_rel <= qr);
                    delta = delta < 0 ? 0 : (delta > 128 ? 128 : delta); tv[j] = ok ? bias_l[delta] : -1e30f; }
                tab[idx] = tv; }
            for (int idx = F.tid; idx < 4 * 64; idx += NWAVES * 64) ((LAS f32x4*)(lds + NEG_OFF))[idx] = (f32x4){-1e30f, -1e30f, -1e30f, -1e30f};
            cur_hp = hp;
        }
        LDS_WAIT(); __syncthreads();
        PBR(32);
        if (T + nwg < T1) ATT_LOAD(T + nwg);
        f32x16 st[5];
        const LAS unsigned char* kbase = lds + (32 * w + q_rel) * K_PITCH + 16 * hh;
        const LAS f32x4* negt = (const LAS f32x4*)(lds + NEG_OFF) + l;
        float mx = -1e30f;
#pragma unroll
        for (int i = 0; i < 5; ++i) {
            const LAS f32x4* tp = (t.k == 0 && w + i < 4) ? negt : tab + (i * 4) * 64 + l;
#pragma unroll
            for (int e4 = 0; e4 < 4; ++e4) { const f32x4 tv = tp[e4 * 64];
#pragma unroll
                for (int j = 0; j < 4; ++j) st[i][4 * e4 + j] = tv[j]; }
#pragma unroll
            for (int s = 0; s < 4; ++s) { const bf16x8 kf = *(const LAS bf16x8*)(kbase + i * (32 * K_PITCH) + s * 32); st[i] = __builtin_amdgcn_mfma_f32_32x32x16_bf16(kf, qf[s], st[i], 0, 0, 0); }
        }
#pragma unroll
        for (int i = 0; i < 5; ++i)
#pragma unroll
            for (int e = 0; e < 16; ++e) mx = fmaxf(mx, st[i][e]);
        mx = fmaxf(mx, __shfl_xor(mx, 32));
        PBR(33);
        float ls[5];
#pragma unroll
        for (int i = 0; i < 5; ++i) { float a0 = 0.f, a1 = 0.f;
#pragma unroll
            for (int e = 0; e < 16; e += 2) { const float p0 = __builtin_amdgcn_exp2f(st[i][e] - mx), p1 = __builtin_amdgcn_exp2f(st[i][e + 1] - mx); st[i][e] = p0; st[i][e + 1] = p1; a0 += p0; a1 += p1; }
            ls[i] = a0 + a1; }
        float lsum = (ls[0] + ls[1]) + (ls[2] + ls[3]) + ls[4];
        lsum += __shfl_xor(lsum, 32);
        PBR(34);
        f32x16 o[2];
#pragma unroll
        for (int e = 0; e < 16; ++e) { o[0][e] = 0.f; o[1][e] = 0.f; }
        const LAS unsigned char* vb = lds + V_OFF + (32 * w + 4 * hh + ((l & 15) >> 2)) * 64 + (16 * ((l >> 4) & 1) + 4 * (l & 3)) * 2;
#pragma unroll
        for (int i = 0; i < 5; ++i)
#pragma unroll
            for (int s2 = 0; s2 < 2; ++s2) {
                v4u pw; pw.x = pk2(st[i][8 * s2 + 0], st[i][8 * s2 + 1]); pw.y = pk2(st[i][8 * s2 + 2], st[i][8 * s2 + 3]);
                pw.z = pk2(st[i][8 * s2 + 4], st[i][8 * s2 + 5]); pw.w = pk2(st[i][8 * s2 + 6], st[i][8 * s2 + 7]);
                const bf16x8 pf = __builtin_bit_cast(bf16x8, pw);
#pragma unroll
                for (int db = 0; db < 2; ++db) { const s16x4 lo = vtr(vb + db * V_DBS + i * 2048 + s2 * 1024), hi = vtr(vb + db * V_DBS + i * 2048 + s2 * 1024 + 512);
                    const bf16x8 vf = (bf16x8){lo[0], lo[1], lo[2], lo[3], hi[0], hi[1], hi[2], hi[3]};
                    o[db] = __builtin_amdgcn_mfma_f32_32x32x16_bf16(vf, pf, o[db], 0, 0, 0); }
            }
        PBR(35);
        const float inv = 1.0f / lsum;
        const size_t rowbase = (size_t)t.b * SEQ * DA + t.head * HD; const int qtok = (256 * t.k + 32 * w + q_rel) * t.dil + t.r;
        bf16* Op = (t.p == 0) ? O0 : (t.p == 1) ? O1 : O2;
        bf16* orow = Op + rowbase + (size_t)qtok * DA + 8 * hh;
#pragma unroll
        for (int db = 0; db < 2; ++db)
#pragma unroll
            for (int g = 0; g < 4; g += 2) {
                unsigned ax = pk2(o[db][4 * g] * inv, o[db][4 * g + 1] * inv), ay = pk2(o[db][4 * g + 2] * inv, o[db][4 * g + 3] * inv);
                unsigned bx = pk2(o[db][4 * g + 4] * inv, o[db][4 * g + 5] * inv), by = pk2(o[db][4 * g + 6] * inv, o[db][4 * g + 7] * inv);
                { const auto r = __builtin_amdgcn_permlane32_swap(ax, bx, false, false); ax = r[0]; bx = r[1]; }
                { const auto r = __builtin_amdgcn_permlane32_swap(ay, by, false, false); ay = r[0]; by = r[1]; }
                *(GAS v4u*)(orow + 32 * db + 8 * g) = (v4u){ax, ay, bx, by}; }
        if (hh == 0) LSE[((size_t)t.p * M + (size_t)t.b * SEQ + qtok) * NH + t.head] = mx + __builtin_amdgcn_logf(lsum);
        PBR(36);
    }
#undef ATT_LOAD
}
__device__ __forceinline__ void merge_attn_phase(Frame& F, const bf16* O0, const bf16* O1, const bf16* O2, const float* LSE, const float* g_attn, bf16* Y) {
    const int gw = F.vcu * NWAVES + F.wave, NGW = F.G * NWAVES, head = F.lane >> 3;
    const f32x4 g0 = ((const GAS f32x4*)g_attn)[2 * F.lane], g1 = ((const GAS f32x4*)g_attn)[2 * F.lane + 1];
    v4u na, nb, nc; float nl0, nl1, nl2;
#define MRG_LOAD(m_) do { const int mm_ = (m_) < M ? (m_) : 0; na = ((const GAS v4u*)(O0 + (size_t)mm_ * DA))[F.lane]; nb = ((const GAS v4u*)(O1 + (size_t)mm_ * DA))[F.lane]; nc = ((const GAS v4u*)(O2 + (size_t)mm_ * DA))[F.lane]; \
        nl0 = LSE[((size_t)0 * M + mm_) * NH + head]; nl1 = LSE[((size_t)1 * M + mm_) * NH + head]; nl2 = LSE[((size_t)2 * M + mm_) * NH + head]; } while (0)
    MRG_LOAD(gw);
    for (int m = gw; m < M; m += NGW) {
        const v4u a = na, b = nb, c = nc; const float l0 = nl0, l1 = nl1, l2 = nl2;
        MRG_LOAD(m + NGW);
        const float mx = fmaxf(l0, fmaxf(l1, l2));
        float w0 = __builtin_amdgcn_exp2f(l0 - mx), w1 = __builtin_amdgcn_exp2f(l1 - mx), w2 = __builtin_amdgcn_exp2f(l2 - mx);
        const float inv = 1.0f / (w0 + w1 + w2); w0 *= inv; w1 *= inv; w2 *= inv;
        float v[8]; float ss = 0.f;
#pragma unroll
        for (int j = 0; j < 4; ++j) { v[2 * j] = w0 * bflo(a[j]) + w1 * bflo(b[j]) + w2 * bflo(c[j]); v[2 * j + 1] = w0 * bfhi(a[j]) + w1 * bfhi(b[j]) + w2 * bfhi(c[j]); ss += v[2 * j] * v[2 * j] + v[2 * j + 1] * v[2 * j + 1]; }
        const float rs = 1.0f / sqrtf(wave_sum(ss) * (1.0f / DA) + RMS_EPS);
        v4u ov; ov.x = pk2(v[0] * rs * g0.x, v[1] * rs * g0.y); ov.y = pk2(v[2] * rs * g0.z, v[3] * rs * g0.w); ov.z = pk2(v[4] * rs * g1.x, v[5] * rs * g1.y); ov.w = pk2(v[6] * rs * g1.z, v[7] * rs * g1.w);
        ((GAS v4u*)(Y + (size_t)m * D))[F.lane] = ov;
    }
#undef MRG_LOAD
}
}

namespace lru {
constexpr int TAB_OFF = 0, STG_OFF = 10240, STG_WAVE = 16 * 68 * 4, GST_OFF = STG_OFF + NWAVES * STG_WAVE, GST_WAVE = 16 * 64 * 2, VST_OFF = GST_OFF + NWAVES * GST_WAVE, VST_WAVE = 64 * 64 * 2,
              SS_OFF = VST_OFF + NWAVES * VST_WAVE, LRU_LDS = SS_OFF + 2048;
static_assert(LRU_LDS <= RING_BYTES && (SS_OFF % 16) == 0 && (STG_OFF % 16) == 0, "LRU LDS");
constexpr int NUNIT = NBATCH * (SEQ / 64);
constexpr int FT_PITCH = 144, FT_WAVE = 64 * FT_PITCH;
static_assert(NWAVES * FT_WAVE + 2048 <= RING_BYTES, "LRU final LDS");
__device__ __forceinline__ float sigmoidf_fast(float x) { return __builtin_amdgcn_rcpf(1.0f + __builtin_amdgcn_exp2f(-LOG2E * x)); }

template <bool FINAL>
__device__ __forceinline__ void lru_phase(Frame& F, const int layer, const Args& a, const bf16* Ug, const bf16* Gg, float* AGG, bf16* Y, bf16* LAo, bf16* BEo) {
    LAS unsigned char* lds = F.lds + RING_OFF;
    LAS float* convw = (LAS float*)(lds + TAB_OFF);
    LAS float* convb = convw + 2048;
    __syncthreads();
    for (int i = F.tid; i < 2048; i += NWAVES * 64) convw[i] = a.in[2][layer * 2048 + i];
    if (F.tid < 512) convb[F.tid] = a.in[3][layer * 512 + F.tid];
    LDS_WAIT(); __syncthreads();
    const int g = F.wave, l = F.lane, c16 = l & 15, lg = l >> 4;
    float nba[4], nbx[4], c2[4];
#pragma unroll
    for (int t = 0; t < 4; ++t) { const int ch = 64 * g + 16 * t + c16; nba[t] = -LOG2E * a.in[5][layer * 512 + ch]; nbx[t] = -LOG2E * a.in[7][layer * 512 + ch]; c2[t] = -8.0f * LOG2E * log1pf(expf(-a.in[8][layer * 512 + ch])); }
    bf16x8 wf[2][4][2];
    { const bf16* Wbase = (const bf16*)(a.ws + WS_LRUW) + (size_t)(layer * 16 + g) * 4096 + c16 * 64 + 8 * lg;
#pragma unroll
      for (int gate = 0; gate < 2; ++gate)
#pragma unroll
        for (int t = 0; t < 4; ++t)
#pragma unroll
            for (int s = 0; s < 2; ++s) wf[gate][t][s] = *(const GAS bf16x8*)(Wbase + (size_t)gate * 8 * 4096 + t * 16 * 64 + s * 32); }
    LAS float* stg = (LAS float*)(lds + STG_OFF + g * STG_WAVE);
    LAS bf16* gst = (LAS bf16*)(lds + GST_OFF + g * GST_WAVE);
    LAS bf16* vst = (LAS bf16*)(lds + VST_OFF + g * VST_WAVE);
    LAS float* ssl = (LAS float*)(lds + SS_OFF);
    LAS float* stg_c = stg + (4 * lg) * 68 + c16;
    LAS bf16* gst_c = gst + (4 * lg) * 64 + c16;
    LAS bf16* vst_c = vst + (4 * lg) * 64 + c16;
    LAS float* ssl_w = ssl + (4 * lg) * 8 + g;
    for (int unit = blockIdx.x; unit < NUNIT; unit += F.G) {
        const int b = unit >> 6, c = unit & 63; const size_t tok0 = (size_t)b * SEQ + 64 * c;
        v4u un[2][4]; v4u gn[2];
#define LRU_LOAD(ss_) do { const int ts_ = 64 * c + 16 * (ss_) + c16; const size_t row_ = tok0 + 16 * (ss_) + c16; \
            _Pragma("unroll") for (int s = 0; s < 2; ++s) _Pragma("unroll") for (int w = 0; w < 4; ++w) { \
                const bool ok_ = ts_ - 3 + w >= 0; const v4u x_ = *(const GAS v4u*)(Ug + (ok_ ? row_ - 3 + w : row_) * DL + 64 * g + 32 * s + 8 * lg);     \
                un[s][w] = ok_ ? x_ : (v4u){0u, 0u, 0u, 0u}; } \
            if (FINAL) { const bf16* gp_ = Gg + (tok0 + 16 * (ss_) + (l >> 2)) * DL + 64 * g + (l & 3) * 16; gn[0] = *(const GAS v4u*)gp_; gn[1] = *(const GAS v4u*)(gp_ + 8); } } while (0)
        LRU_LOAD(0);
        float hc[4], At[4];
#pragma unroll
        for (int t = 0; t < 4; ++t) { hc[t] = 0.f; At[t] = 1.f; }
        if (FINAL) {
#pragma unroll 4
            for (int cc = 0; cc < c; ++cc) {
#pragma unroll
                for (int t = 0; t < 4; ++t) { const f32x2 ab = *(const GAS f32x2*)(AGG + ((size_t)(b * 64 + cc) * 512 + 64 * g + 16 * t + c16) * 2); hc[t] = ab.x * hc[t] + ab.y; } }
        }
#pragma unroll
        for (int ss = 0; ss < 4; ++ss) {
            if (FINAL) { *(LAS v4u*)(gst + (l >> 2) * 64 + (l & 3) * 16) = gn[0]; *(LAS v4u*)(gst + (l >> 2) * 64 + (l & 3) * 16 + 8) = gn[1]; }
            bf16x8 af[2];
#pragma unroll
            for (int s = 0; s < 2; ++s) { const int cb = 64 * g + 32 * s + 8 * lg;
                f32x4 u0 = *(const LAS f32x4*)(convb + cb), u1 = *(const LAS f32x4*)(convb + cb + 4);
#pragma unroll
                for (int w = 0; w < 4; ++w) { const v4u x = un[s][w];
                    const f32x4 w0 = *(const LAS f32x4*)(convw + w * 512 + cb), w1 = *(const LAS f32x4*)(convw + w * 512 + cb + 4);
                    u0.x += w0.x * bflo(x.x); u0.y += w0.y * bfhi(x.x); u0.z += w0.z * bflo(x.y); u0.w += w0.w * bfhi(x.y);
                    u1.x += w1.x * bflo(x.z); u1.y += w1.y * bfhi(x.z); u1.z += w1.z * bflo(x.w); u1.w += w1.w * bfhi(x.w); }
                *(LAS f32x4*)(stg + c16 * 68 + 32 * s + 8 * lg) = u0; *(LAS f32x4*)(stg + c16 * 68 + 32 * s + 8 * lg + 4) = u1;
                v4u pw; pw.x = pk2(u0.x, u0.y); pw.y = pk2(u0.z, u0.w); pw.z = pk2(u1.x, u1.y); pw.w = pk2(u1.z, u1.w); af[s] = __builtin_bit_cast(bf16x8, pw); }
            if (ss < 3) LRU_LOAD(ss + 1);
            f32x4 acc[2][4];
#pragma unroll
            for (int gate = 0; gate < 2; ++gate)
#pragma unroll
                for (int t = 0; t < 4; ++t) { acc[gate][t] = (f32x4){0.f, 0.f, 0.f, 0.f};
#pragma unroll
                    for (int s = 0; s < 2; ++s) acc[gate][t] = __builtin_amdgcn_mfma_f32_16x16x32_bf16(af[s], wf[gate][t][s], acc[gate][t], 0, 0, 0); }
            float ssq[4] = {0.f, 0.f, 0.f, 0.f};
#pragma unroll
            for (int t = 0; t < 4; ++t) {
                float aj[4], bj[4], l2[4];
#pragma unroll
                for (int r = 0; r < 4; ++r) { const float uu = stg_c[r * 68 + 16 * t];
                    const float rr = __builtin_amdgcn_rcpf(1.0f + __builtin_amdgcn_exp2f(__builtin_fmaf(acc[0][t][r], -LOG2E, nba[t])));
                    const float ig = __builtin_amdgcn_rcpf(1.0f + __builtin_amdgcn_exp2f(__builtin_fmaf(acc[1][t][r], -LOG2E, nbx[t])));
                    l2[r] = rr * c2[t]; aj[r] = __builtin_amdgcn_exp2f(l2[r]);
                    bj[r] = __builtin_amdgcn_sqrtf(__builtin_fmaf(-aj[r], aj[r], 1.0f)) * (ig * uu); }
                if (!FINAL) {
                    const size_t lo = (((((size_t)unit * 8 + g) * 4 + ss) * 4 + t) * 64 + l) * 4;
                    *(GAS v2u*)(LAo + lo) = (v2u){pk2(l2[0], l2[1]), pk2(l2[2], l2[3])}; *(GAS v2u*)(BEo + lo) = (v2u){pk2(bj[0], bj[1]), pk2(bj[2], bj[3])}; }
                float hl[4], cum[4]; hl[0] = bj[0]; cum[0] = aj[0];
#pragma unroll
                for (int r = 1; r < 4; ++r) { hl[r] = aj[r] * hl[r - 1] + bj[r]; cum[r] = cum[r - 1] * aj[r]; }
                float A = cum[3], B = hl[3];
                float pA = __shfl(A, (l + 48) & 63), pB = __shfl(B, (l + 48) & 63);
                if (lg >= 1) { B = A * pB + B; A = A * pA; }
                pA = __shfl(A, (l + 32) & 63); pB = __shfl(B, (l + 32) & 63);
                if (lg >= 2) { B = A * pB + B; A = A * pA; }
                float eA = __shfl(A, (l + 48) & 63), eB = __shfl(B, (l + 48) & 63); if (lg == 0) { eA = 1.0f; eB = 0.0f; }
                const float hin = eA * hc[t] + eB;
                const float tA = __shfl(A, 48 + c16), tB = __shfl(B, 48 + c16);
                hc[t] = tA * hc[t] + tB; At[t] *= tA;
                if (FINAL) {
#pragma unroll
                    for (int r = 0; r < 4; ++r) { const float h = hl[r] + cum[r] * hin; const float gx = bf2f(gst_c[r * 64 + 16 * t]);
                        const float z2 = 1.5957691216057308f * (gx + 0.044715f * gx * gx * gx); const float vv = gx * sigmoidf_fast(z2) * h;
                        vst_c[(16 * ss + r) * 64 + 16 * t] = (bf16)f2bf(vv); ssq[r] += vv * vv; }
                }
            }
            if (FINAL) {
#pragma unroll
                for (int r = 0; r < 4; ++r) { float q = ssq[r]; q += __shfl_xor(q, 1); q += __shfl_xor(q, 2); q += __shfl_xor(q, 4); q += __shfl_xor(q, 8); if (c16 == 0) ssl_w[(16 * ss + r) * 8] = q; }
            }
        }
#undef LRU_LOAD
        if (!FINAL) {
            if (lg == 0) {
#pragma unroll
                for (int t = 0; t < 4; ++t) *(GAS f32x2*)(AGG + ((size_t)(b * 64 + c) * 512 + 64 * g + 16 * t + c16) * 2) = (f32x2){At[t], hc[t]}; }
        } else {
            LDS_WAIT(); __syncthreads();
            f32x4 gq[4];
#pragma unroll
            for (int j = 0; j < 4; ++j) gq[j] = ((const GAS f32x4*)(a.in[11] + layer * 512 + 64 * g + (l & 3) * 16))[j];
#pragma unroll
            for (int ss = 0; ss < 4; ++ss) { const int tl = 16 * ss + (l >> 2);
                const f32x4 s0 = *(const LAS f32x4*)(ssl + tl * 8), s1 = *(const LAS f32x4*)(ssl + tl * 8 + 4);
                const float rs = 1.0f / sqrtf(((s0.x + s0.y) + (s0.z + s0.w) + (s1.x + s1.y) + (s1.z + s1.w)) * (1.0f / DL) + RMS_EPS);
                const v4u y0 = *(const LAS v4u*)(vst + tl * 64 + (l & 3) * 16), y1 = *(const LAS v4u*)(vst + tl * 64 + (l & 3) * 16 + 8);
                v4u o0, o1;
                o0.x = pk2(bflo(y0.x) * rs * gq[0].x, bfhi(y0.x) * rs * gq[0].y); o0.y = pk2(bflo(y0.y) * rs * gq[0].z, bfhi(y0.y) * rs * gq[0].w);
                o0.z = pk2(bflo(y0.z) * rs * gq[1].x, bfhi(y0.z) * rs * gq[1].y); o0.w = pk2(bflo(y0.w) * rs * gq[1].z, bfhi(y0.w) * rs * gq[1].w);
                o1.x = pk2(bflo(y1.x) * rs * gq[2].x, bfhi(y1.x) * rs * gq[2].y); o1.y = pk2(bflo(y1.y) * rs * gq[2].z, bfhi(y1.y) * rs * gq[2].w);
                o1.z = pk2(bflo(y1.z) * rs * gq[3].x, bfhi(y1.z) * rs * gq[3].y); o1.w = pk2(bflo(y1.w) * rs * gq[3].z, bfhi(y1.w) * rs * gq[3].w);
                GAS v4u* dst = (GAS v4u*)(Y + (tok0 + tl) * D + DL + 64 * g + (l & 3) * 16); dst[0] = o0; dst[1] = o1; }
            __syncthreads();
        }
    }
}

__device__ __forceinline__ void lru_final_phase(Frame& F, const int layer, const Args& a, const bf16* Gg, const float* AGG, const bf16* LAi, const bf16* BEi, bf16* Y) {
    LAS unsigned char* lds = F.lds + RING_OFF;
    const int g = F.wave, l = F.lane;
    LAS unsigned char* tile = lds + g * FT_WAVE;
    LAS float* ssl = (LAS float*)(lds + NWAVES * FT_WAVE);
    f32x4 gq[2];
#pragma unroll
    for (int j = 0; j < 2; ++j) gq[j] = ((const GAS f32x4*)(a.in[11] + layer * 512 + 64 * g + (l & 7) * 8))[j];
    __syncthreads();
    for (int u0 = blockIdx.x, it = 0; u0 < NUNIT; u0 += F.G, ++it) {
        const int unit = (it & 1) ? (u0 ^ 63) : u0;
        const int b = unit >> 6, c = unit & 63; const size_t tok0 = (size_t)b * SEQ + 64 * c;
        v4u gr[8];
#pragma unroll
        for (int j = 0; j < 8; ++j) gr[j] = *(const GAS v4u*)(Gg + (tok0 + 8 * j + (l >> 3)) * DL + 64 * g + (l & 7) * 8);
        const GAS v2u* lap = (const GAS v2u*)(LAi + ((((size_t)unit * 8 + g) * 4) * 4 + (l >> 4)) * 256 + (l & 15) * 4); const GAS v2u* bep = (const GAS v2u*)(BEi + ((((size_t)unit * 8 + g) * 4) * 4 + (l >> 4)) * 256 + (l & 15) * 4);
        v2u la8[8], be8[8];
#pragma unroll
        for (int j = 0; j < 8; ++j) { la8[j] = lap[(j >> 2) * 4 * 64 + (j & 3) * 16]; be8[j] = bep[(j >> 2) * 4 * 64 + (j & 3) * 16]; }
        float h = 0.f;
        { const GAS f32x2* ap = (const GAS f32x2*)(AGG + ((size_t)(b * 64) * 512 + 64 * g + l) * 2);
          int cc = 0;
          for (; cc + 16 <= c; cc += 16) { f32x2 ab[16];
#pragma unroll
              for (int j = 0; j < 16; ++j) ab[j] = ap[(size_t)(cc + j) * 512];
#pragma unroll
              for (int j = 0; j < 16; ++j) h = ab[j].x * h + ab[j].y; }
          { f32x2 ab[16];
#pragma unroll
              for (int j = 0; j < 16; ++j) ab[j] = ap[(size_t)((cc + j < c) ? cc + j : 0) * 512];
#pragma unroll
              for (int j = 0; j < 16; ++j) if (cc + j < c) h = ab[j].x * h + ab[j].y; } }
#pragma unroll
        for (int j = 0; j < 8; ++j) *(LAS v4u*)(tile + (8 * j + (l >> 3)) * FT_PITCH + (l & 7) * 16) = gr[j];
        LAS bf16* col = (LAS bf16*)(tile + 2 * l);
#pragma unroll
        for (int half = 0; half < 2; ++half) {
            if (half == 1) {
#pragma unroll
                for (int j = 0; j < 8; ++j) { la8[j] = lap[(2 + (j >> 2)) * 4 * 64 + (j & 3) * 16]; be8[j] = bep[(2 + (j >> 2)) * 4 * 64 + (j & 3) * 16]; } }
#pragma unroll
            for (int j = 0; j < 8; ++j)
#pragma unroll
                for (int e = 0; e < 4; ++e) { const int tt = 32 * half + 4 * j + e; const unsigned lw = la8[j][e >> 1], bw = be8[j][e >> 1];
                    const float l2 = (e & 1) ? bfhi(lw) : bflo(lw), be = (e & 1) ? bfhi(bw) : bflo(bw);
                    h = __builtin_amdgcn_exp2f(l2) * h + be;
                    const float gx = bf2f(col[tt * (FT_PITCH / 2)]);
                    const float z2 = 1.5957691216057308f * (gx + 0.044715f * gx * gx * gx);
                    col[tt * (FT_PITCH / 2)] = (bf16)pk2(gx * sigmoidf_fast(z2) * h, 0.f); }
        }
        { float q = 0.f;
#pragma unroll
          for (int j = 0; j < 8; ++j) { const v4u y = *(const LAS v4u*)(tile + l * FT_PITCH + 16 * j);
#pragma unroll
              for (int e = 0; e < 4; ++e) { const float x0 = bflo(y[e]), x1 = bfhi(y[e]); q += x0 * x0 + x1 * x1; } }
          ssl[l * 8 + g] = q; }
        LDS_WAIT(); __syncthreads();
#pragma unroll
        for (int j = 0; j < 8; ++j) { const int tl = 8 * j + (l >> 3);
            const f32x4 s0 = *(const LAS f32x4*)(ssl + tl * 8), s1 = *(const LAS f32x4*)(ssl + tl * 8 + 4);
            const float rs = 1.0f / sqrtf(((s0.x + s0.y) + (s0.z + s0.w) + (s1.x + s1.y) + (s1.z + s1.w)) * (1.0f / DL) + RMS_EPS);
            const v4u y = *(const LAS v4u*)(tile + tl * FT_PITCH + (l & 7) * 16);
            v4u o; o.x = pk2(bflo(y.x) * rs * gq[0].x, bfhi(y.x) * rs * gq[0].y); o.y = pk2(bflo(y.y) * rs * gq[0].z, bfhi(y.y) * rs * gq[0].w);
            o.z = pk2(bflo(y.z) * rs * gq[1].x, bfhi(y.z) * rs * gq[1].y); o.w = pk2(bflo(y.w) * rs * gq[1].z, bfhi(y.w) * rs * gq[1].w);
            *(GAS v4u*)(Y + (tok0 + tl) * D + DL + 64 * g + (l & 7) * 8) = o; }
        __syncthreads();
    }
}
}

#define PB_BEGIN(k) do { F.lane = fresh_lane(); if (PROBE_MASK && ((PROBE_MASK >> (k)) & 1ull)) F.pt0 = rt(); } while (0)
#define PB_END(k) do { if (PROBE_MASK && ((PROBE_MASK >> (k)) & 1ull)) F.pacc += rt() - F.pt0; } while (0)
#define IN(k) (lo <= (k) && (k) < hi)
#define SEAM(k) do { if (IN(k) && IN((k) + 1)) { if ((PROBE_MASK & (1ull << 37)) && (PROBE_SEAM < 0 || PROBE_SEAM == (k))) { const unsigned long long t_ = rt(); xcd_barrier(bar); F.pacc += rt() - t_; } else xcd_barrier(bar); } } while (0)
template <int layer>
__device__ __forceinline__ void run_layer(Frame& F, const Args& args, const XcdBarrier& bar, const int lo, const int hi) {
    unsigned char* ws = args.ws; bf16* XBp = (bf16*)(ws + WS_XB);
        const int pb = layer ? PH_L1 : PH_L0;
        PB_BEGIN(pb + 0);
        if (IN(pb + 0)) {
            pg8::Gemm g{XBp, (const bf16*)(ws + WS_WIN) + (size_t)layer * DIN * D, M, DIN, D}; pg8::StaticOrder S; S.init(M, DIN, F.G, (int)blockIdx.x);
            pg8::EpiBf16<0> E{(bf16*)(ws + WS_Q), DA, nullptr, DA, (size_t)M * DA, QSCALE};
            pg8::gemm_phase<pg8::EpiBf16<0>, pg8::StaticOrder, true, true>(F.lds + RING_OFF, g, S, E);
        }
        SEAM(pb + 0);
        PB_END(pb + 0);
        PB_BEGIN(pb + 1);
        if (IN(pb + 1)) { PB_BEGIN(27); att::attn_phase(F, (const bf16*)(ws + WS_Q), (const bf16*)(ws + WS_K), (const bf16*)(ws + WS_V), args.in[9], (bf16*)(ws + WS_O0), (bf16*)(ws + WS_O1), (bf16*)(ws + WS_O2), (float*)(ws + WS_LSE)); PB_END(27);
            PB_BEGIN(28); lru::lru_phase<false>(F, layer, args, (const bf16*)(ws + WS_U), (const bf16*)(ws + WS_G), (float*)(ws + WS_AGG), nullptr, (bf16*)(ws + WS_LA), (bf16*)(ws + WS_BE)); PB_END(28); }
        SEAM(pb + 1);
        PB_END(pb + 1);
        PB_BEGIN(pb + 2);
        if (IN(pb + 2)) { PB_BEGIN(29); att::merge_attn_phase(F, (const bf16*)(ws + WS_O0), (const bf16*)(ws + WS_O1), (const bf16*)(ws + WS_O2), (const float*)(ws + WS_LSE), args.in[10] + layer * DA, (bf16*)(ws + WS_Y)); PB_END(29);
            PB_BEGIN(30); lru::lru_final_phase(F, layer, args, (const bf16*)(ws + WS_G), (const float*)(ws + WS_AGG), (const bf16*)(ws + WS_LA), (const bf16*)(ws + WS_BE), (bf16*)(ws + WS_Y)); PB_END(30); }
        SEAM(pb + 2);
        PB_END(pb + 2);
        PB_BEGIN(pb + 3);
        if (IN(pb + 3)) {
            pg8::Gemm g{(const bf16*)(ws + WS_Y), (const bf16*)(ws + WS_WOUT) + (size_t)layer * D * D, M, D, D}; pg8::StaticOrder S; S.init(M, D, F.G, (int)blockIdx.x);
            pg8::EpiResBf16 E{XBp, XBp, D, ALPHA, 1.0f};
            pg8::gemm_phase<pg8::EpiResBf16, pg8::StaticOrder, true, true>(F.lds + RING_OFF, g, S, E);
        }
        SEAM(pb + 3);
        PB_END(pb + 3);
        PB_BEGIN(pb + 4);
        if (IN(pb + 4)) {
            if (layer == 0) phase_ln<false>(F, XBp, args.in[13], args.in[14], nullptr, nullptr, nullptr);
            else { phase_ln<true>(F, XBp, args.in[13] + D, args.in[14] + D, args.in[20], (int*)(ws + WS_TOKE), (float*)(ws + WS_TOKP)); PB_BEGIN(26); phase_moe_cvt(F, args); PB_END(26); }
        }
        SEAM(pb + 4);
        PB_END(pb + 4);
        if (layer == 0) {
            PB_BEGIN(pb + 5);
            if (IN(pb + 5)) {
                pg8::Gemm g{XBp, (const bf16*)(ws + WS_WGU), M, 2 * DFF, D}; pg8::StaticOrder S; S.init(M, 2 * DFF, F.G, (int)blockIdx.x);
                pg8::EpiSwiGLU8 E{ws + WS_HB, DFF, 1.0f, MOE_HSCALE};
                pg8::gemm_phase<pg8::EpiSwiGLU8, pg8::StaticOrder, true, true>(F.lds + RING_OFF, g, S, E);
            }
            SEAM(pb + 5);
            PB_END(pb + 5);
            PB_BEGIN(pb + 6);
            if (IN(pb + 6)) {
                pg8::Gemm g{(const bf16*)(ws + WS_HB), (const bf16*)(ws + WS_WD), M, D, DFF / 2}; pg8::StaticOrder S; S.init(M, D, F.G, (int)blockIdx.x);
                pg8::EpiResBf16 E{XBp, XBp, D, ALPHA, 1.0f / (MOE_HSCALE * MOE_DSCALE)};
                pg8::gemm_phase<pg8::EpiResBf16, pg8::StaticOrder, true, true, true>(F.lds + RING_OFF, g, S, E);
            }
            SEAM(pb + 6);
            PB_END(pb + 6);
            PB_BEGIN(pb + 7);
            if (IN(pb + 7)) phase_ln<false>(F, XBp, args.in[15], args.in[16], nullptr, nullptr, nullptr);
            SEAM(pb + 7);
            PB_END(pb + 7);
        }
}

__global__ void __launch_bounds__(NWAVES * 64, 2) fwd(Args args) {
    extern __shared__ __attribute__((aligned(16))) unsigned char lds[];
    Frame F;
    F.lds = (LAS unsigned char*)lds;
    F.MISC = (volatile LAS unsigned*)(F.lds + MISC_OFF);
    F.tid = threadIdx.x; F.lane = F.tid & 63; F.wave = __builtin_amdgcn_readfirstlane(F.tid >> 6);
    F.pt0 = 0ull; F.pacc = 0ull;
    F.G = gridDim.x; { const int bx = blockIdx.x; F.vcu = (F.G % 8 == 0) ? (bx % 8) * (F.G / 8) + bx / 8 : bx; }
    unsigned char* ws = args.ws;
    F.ctl = (gu32*)(ws + WS_CTL);
    for (int u = F.tid; u < (LDS_BYTES - LDSCTL_OFF) / 4; u += NWAVES * 64) ((LAS unsigned*)(F.lds + LDSCTL_OFF))[u] = 0u;
    __syncthreads();
    const int lo = args.ph_lo, hi = args.ph_hi;
    const bool use_bar = (hi - lo) > 1;
    XcdBarrier bar; bar.bar = (unsigned*)(F.ctl + CW_BAR) + args.li * XCD_BAR_WORDS; bar.x = 0; bar.st = nullptr;
    if (use_bar) bar = xcd_barrier_post((unsigned*)(F.ctl + CW_BAR) + args.li * XCD_BAR_WORDS, F.MISC + 8);
    float* out = args.out;
    bf16* XBp = (bf16*)(ws + WS_XB);

    PB_BEGIN(PH_PRO);
    if (IN(PH_PRO)) phase_prologue(F, args);
    SEAM(PH_PRO);
    PB_END(PH_PRO);

    run_layer<0>(F, args, bar, lo, hi);
    run_layer<1>(F, args, bar, lo, hi);
    PB_BEGIN(PH_DISPATCH);
    if (IN(PH_DISPATCH)) phase_dispatch(F, (const int*)(ws + WS_TOKE), (int*)(ws + WS_TOKPOS), (int*)(ws + WS_SEG), XBp, ws + WS_XS8);
    SEAM(PH_DISPATCH);
    PB_END(PH_DISPATCH);
    for (int c = 0; c < NCHUNK - 1; ++c) {
        const int pg = PH_MOE0 + 2 * c;
        if (IN(pg) || IN(pg + 1)) {
            pg8::MoeOrder S; S.G = F.G; S.c = (int)blockIdx.x; S.base = c * CHUNK_TILES;
            const GAS int* st = (const GAS int*)(ws + WS_SEG);
#pragma unroll
            for (int k = 0; k < 9; ++k) S.segt[k] = __builtin_amdgcn_readfirstlane(st[k]);
            const int nT = S.segt[8]; S.nrows = nT - S.base; if (S.nrows > CHUNK_TILES) S.nrows = CHUNK_TILES; if (S.nrows < 0) S.nrows = 0;
            unsigned char* HCv = (unsigned char*)out - (size_t)S.base * 256 * DFE;
            S.split_pm = -1; S.adiff = 0;
            PB_BEGIN(pg);
            if (IN(pg)) {
                S.nN = 2 * DFE / 256; S.estride_b = (size_t)2 * DFE * D;
                pg8::Gemm g{(const bf16*)(ws + WS_XS8), (const bf16*)(ws + WS_MGU), SORT_ROWS, 2 * DFE, D / 2};
                pg8::EpiSwiGLU8 E{HCv, DFE, 1.0f / MOE_WSCALE, MOE_HSCALE};
                pg8::gemm_phase<pg8::EpiSwiGLU8, pg8::MoeOrder, true, true, true>(F.lds + RING_OFF, g, S, E);
            }
            SEAM(pg);
            PB_END(pg);
            PB_BEGIN(pg + 1);
            if (IN(pg + 1)) {
                S.nN = D / 256; S.estride_b = (size_t)D * DFE;
                pg8::Gemm g{(const bf16*)HCv, (const bf16*)(ws + WS_MD), SORT_ROWS, D, DFE / 2};
                pg8::EpiBf16S E{(bf16*)(ws + WS_YS), D, 1.0f / (MOE_HSCALE * MOE_DSCALE)};
                pg8::gemm_phase<pg8::EpiBf16S, pg8::MoeOrder, true, true, true>(F.lds + RING_OFF, g, S, E);
            }
            SEAM(pg + 1);
            PB_END(pg + 1);
        }
    }
    {
        constexpr int pg = PH_MOE0 + 2 * (NCHUNK - 1), TAIL_ROW0 = (NCHUNK - 1) * CHUNK_TILES * 256;
        pg8::MoeOrder S; S.G = F.G; S.c = (int)blockIdx.x; S.base = (NCHUNK - 1) * CHUNK_TILES; S.nrows = 0; S.split_pm = -1; S.adiff = 0;
        unsigned char* HCv = ws + WS_HCA - (size_t)S.base * 256 * DFE;
        if (IN(pg) || IN(pg + 1)) {
            const GAS int* st = (const GAS int*)(ws + WS_SEG);
#pragma unroll
            for (int k = 0; k < 9; ++k) S.segt[k] = __builtin_amdgcn_readfirstlane(st[k]);
            S.nrows = S.segt[8] - S.base; if (S.nrows > CHUNK_TILES) S.nrows = CHUNK_TILES; if (S.nrows < 0) S.nrows = 0;
        }
        PB_BEGIN(pg);
        if (IN(pg)) {
            S.nN = 2 * DFE / 256; S.estride_b = (size_t)2 * DFE * D;
            pg8::Gemm g{(const bf16*)(ws + WS_XS8), (const bf16*)(ws + WS_MGU), SORT_ROWS, 2 * DFE, D / 2};
            pg8::EpiSwiGLU8 E{HCv, DFE, 1.0f / MOE_WSCALE, MOE_HSCALE};
            pg8::gemm_phase<pg8::EpiSwiGLU8, pg8::MoeOrder, true, true, true>(F.lds + RING_OFF, g, S, E);
        }
        SEAM(pg);
        PB_END(pg);
        PB_BEGIN(pg + 1);
        if (IN(pg + 1)) {
            {
                pg8::MoeSplitK S2; S2.base = S.base; S2.nrows = S.nrows; S2.nN = D / 256; S2.nS = TAIL_NS; S2.KS = TAIL_KS / 2; S2.G = F.G; S2.c = (int)blockIdx.x; S2.estride_b = (size_t)D * DFE;
#pragma unroll
                for (int k2 = 0; k2 < 9; ++k2) S2.segt[k2] = S.segt[k2];
                pg8::Gemm g{(const bf16*)HCv, (const bf16*)(ws + WS_MD), SORT_ROWS, D, TAIL_KS / 2, DFE / 2};
                pg8::EpiPart E{(bf16*)(ws + WS_PART), D, S.base, TAIL_TILES, 1.0f / (MOE_HSCALE * MOE_DSCALE)};
                pg8::gemm_phase<pg8::EpiPart, pg8::MoeSplitK, true, true, true>(F.lds + RING_OFF, g, S2, E);
            }
            phase_combine(F, XBp, out, (const bf16*)(ws + WS_YS), (const int*)(ws + WS_TOKPOS), (const float*)(ws + WS_TOKP), args.in[15] + D, args.in[16] + D, (const bf16*)(ws + WS_PART), 1, TAIL_ROW0, F.vcu * NWAVES + F.wave, F.G * NWAVES);
        }
        SEAM(pg + 1);
        PB_END(pg + 1);
        PB_BEGIN(PH_COMBINE);
        if (IN(PH_COMBINE)) phase_combine(F, XBp, out, (const bf16*)(ws + WS_YS), (const int*)(ws + WS_TOKPOS), (const float*)(ws + WS_TOKP), args.in[15] + D, args.in[16] + D, (const bf16*)(ws + WS_PART), 2, TAIL_ROW0, F.vcu * NWAVES + F.wave, F.G * NWAVES);
        PB_END(PH_COMBINE);
        if (PROBE_MASK && blockIdx.x == 0 && F.tid == 0) { const unsigned long long te = rt() + (unsigned long long)PROBE_K * F.pacc; while (rt() < te) __builtin_amdgcn_s_sleep(8); }
    }
#undef IN
#undef SEAM
}

extern "C" void kernel_launch(void* const* d_in, const int* in_sizes, int n_in, void* d_out, int out_size, void* d_ws, size_t ws_size, hipStream_t stream) {
    static int grid = 0;
    if (grid == 0) {
        if (n_in != 24 || in_sizes[0] != M * D || out_size != M * D || ws_size < WS_END) { fprintf(stderr, "kernel_launch: unexpected problem (n_in %d, out %d, ws %zu < %zu)\n", n_in, out_size, ws_size, (size_t)WS_END); grid = -1; return; }
        int dev = 0, cus = 0, per_cu = 0;
        if (hipGetDevice(&dev) != hipSuccess || hipDeviceGetAttribute(&cus, hipDeviceAttributeMultiprocessorCount, dev) != hipSuccess) { grid = -1; return; }
        if (hipFuncSetAttribute((const void*)fwd, hipFuncAttributeMaxDynamicSharedMemorySize, LDS_BYTES) != hipSuccess) { fprintf(stderr, "kernel_launch: hipFuncSetAttribute failed\n"); grid = -1; return; }
        if (hipOccupancyMaxActiveBlocksPerMultiprocessor(&per_cu, (const void*)fwd, NWAVES * 64, LDS_BYTES) != hipSuccess || per_cu < 1) fprintf(stderr, "kernel_launch: occupancy query says %d\n", per_cu);
        (void)hipGetLastError();
        grid = cus;
    }
    if (grid < 0) return;
    (void)hipMemsetAsync((char*)d_ws + WS_CTL, 0, CTL_ZERO_BYTES, stream);
    Args a{};
    for (int i = 0; i < 24; ++i) a.in[i] = (const float*)d_in[i];
    a.out = (float*)d_out; a.ws = (unsigned char*)d_ws;
    int li = 0;
    auto launch = [&](int lo, int hi) { a.ph_lo = lo; a.ph_hi = hi; a.li = li++; hipLaunchKernelGGL(fwd, dim3(grid), dim3(NWAVES * 64), LDS_BYTES, stream, a); };
    auto each = [&](int lo, int hi) { for (int p = lo; p < hi; ++p) launch(p, p + 1); };
#if defined(MK_PER_PHASE)
    each(PH_PRO, NPH);
#else
    launch(PH_PRO, NPH);
#endif
}
```

```cpp
#include <hip/hip_runtime.h>
#include <cstdio>
#include <cstdint>
#include <cmath>
namespace pg8 {
#define PG8_LAS __attribute__((address_space(3)))
typedef unsigned short bf16_t;
typedef short bf16x8 __attribute__((ext_vector_type(8)));
typedef float f32x4 __attribute__((ext_vector_type(4)));
typedef unsigned u32x4 __attribute__((ext_vector_type(4)));
typedef int i32x4 __attribute__((ext_vector_type(4)));
typedef int i32x8 __attribute__((ext_vector_type(8)));
constexpr int BM = 256, BK = 64, HALF = 128, HTB = HALF * BK * 2  , STAGE_BYTES = 8 * HTB, NXCD = 8, WGM = 8;

__host__ __device__ __forceinline__ int lds_byte(int r, int c) { const int st = (r >> 4) * 2 + (c >> 5), rr = r & 15, cc = c & 31, ob = rr * 64 + cc * 2; return st * 1024 + (ob ^ (((ob >> 9) & 1) << 5)); }
__host__ __device__ __forceinline__ void stage_rc(int b, int& R, int& C) { const int st = b / 1024, sb = b % 1024, swz = sb ^ (((sb >> 9) & 1) << 5); R = (st >> 1) * 16 + swz / 64; C = (st & 1) * 32 + (swz % 64) / 2; }
__host__ __device__ __forceinline__ int perm32(int rho) { const int n = rho >> 4, i = rho & 15; return 8 * (i >> 2) + 4 * n + (i & 3); }

struct Unit { int pm, pn; size_t boffb, aoffb; int ks; };
struct Gemm { const bf16_t* A; const bf16_t* Bt; int M, N, K; int ld; };

struct StaticOrder {
    int nM, nN, nwg, G, c;
    __host__ __device__ void init(int M, int N, int G_, int c_) { nM = M / BM; nN = N / BM; nwg = nM * nN; G = G_; c = c_; }
    __host__ __device__ bool next(int i, Unit& u) const {
        const long L = (long)i * G + c; if (L >= nwg) return false;
        int wgid = (int)L; { const int q = nwg / NXCD, r = nwg % NXCD, xcd = wgid % NXCD, off = wgid / NXCD; wgid = (xcd < r ? xcd * (q + 1) : r * (q + 1) + (xcd - r) * q) + off; }
        const int nig = WGM * nN, gid = wgid / nig, fm = gid * WGM, gsz = (nM - fm) < WGM ? (nM - fm) : WGM;
        u.pm = fm + ((wgid % nig) % gsz); u.pn = (wgid % nig) / gsz; u.boffb = 0; u.aoffb = 0; u.ks = 0; return true;
    }
    __device__ __forceinline__ void a_ready(const Unit&) const {}
    __device__ __forceinline__ void done(const Unit&) const {}
};

__device__ __forceinline__ unsigned cvt_pk_bf16(float lo, float hi) { unsigned r; asm volatile("v_cvt_pk_bf16_f32 %0, %1, %2" : "=v"(r) : "v"(lo), "v"(hi)); return r; }
typedef float f32x2 __attribute__((ext_vector_type(2)));
__device__ __forceinline__ f32x2 gelu_pk(f32x2 v) {
    const f32x2 av = __builtin_elementwise_abs(v), d = av * 0.2316418882f + 1.0f;
    f32x2 t; t.x = __builtin_amdgcn_rcpf(d.x); t.y = __builtin_amdgcn_rcpf(d.y);
    f32x2 q = t * 0.5307027145f + (-0.7265760135f); q = q * t + 0.7107068705f; q = q * t + (-0.142248368f); q = q * t + 0.127414796f; q = q * t;
    const f32x2 s = (v * v) * (-0.72134752044f);
    f32x2 e; e.x = __builtin_amdgcn_exp2f(s.x); e.y = __builtin_amdgcn_exp2f(s.y);
    const f32x2 m = v * (q * e), r = v - m;
    f32x2 o; o.x = v.x < 0.f ? m.x : r.x; o.y = v.y < 0.f ? m.y : r.y; return o;
}

template <int ACT  > struct EpiBf16 {
    static constexpr bool PERM = true, AFTER_DRAIN = false; static_assert(ACT == 0 || ACT == 1, "EpiBf16: ACT is 0 (none) or 1 (gelu_pk)");
    bf16_t* O; int ldc; const float* bias; int split_cols; size_t split_stride; float scale0;
    __device__ __forceinline__ void operator()(const f32x4 (&acc)[2][2][4][2], const Unit& u, int wr, int wc, int fr, int fq) const {
        const int row0 = u.pm * BM + wr * 64 + fr; int colt = u.pn * BM; bf16_t* base = O;
        float sc = 1.f; if (split_cols) { const int t = colt / split_cols; base += (size_t)t * split_stride; colt -= t * split_cols; if (t == 0) sc = scale0; }
        const int col0 = colt + wc * 32 + 8 * fq, bcol0 = u.pn * BM + wc * 32 + 8 * fq;
        f32x4 bv[2][2];
#pragma unroll
        for (int bj = 0; bj < 2; ++bj)
#pragma unroll
            for (int n = 0; n < 2; ++n) bv[bj][n] = bias ? *(const f32x4*)(bias + bcol0 + bj * HALF + 4 * n) : (f32x4){0.f, 0.f, 0.f, 0.f};
#pragma unroll
        for (int ai = 0; ai < 2; ++ai)
#pragma unroll
            for (int m = 0; m < 4; ++m) { bf16_t* rowp = base + (size_t)(row0 + ai * HALF + m * 16) * ldc + col0;
#pragma unroll
                for (int bj = 0; bj < 2; ++bj) { f32x4 v0 = acc[ai][bj][m][0] + bv[bj][0], v1 = acc[ai][bj][m][1] + bv[bj][1];
                    if (ACT == 1) { f32x2 a = gelu_pk((f32x2){v0[0], v0[1]}), b = gelu_pk((f32x2){v0[2], v0[3]}), c = gelu_pk((f32x2){v1[0], v1[1]}), d = gelu_pk((f32x2){v1[2], v1[3]});
                        v0 = (f32x4){a.x, a.y, b.x, b.y}; v1 = (f32x4){c.x, c.y, d.x, d.y}; }
                    v0 = v0 * sc; v1 = v1 * sc; u32x4 w; w.x = cvt_pk_bf16(v0[0], v0[1]); w.y = cvt_pk_bf16(v0[2], v0[3]); w.z = cvt_pk_bf16(v1[0], v1[1]); w.w = cvt_pk_bf16(v1[2], v1[3]);
                    *(u32x4*)(rowp + bj * HALF) = w; } }
    }
};

struct EpiSwiGLU {
    static constexpr bool PERM = true, AFTER_DRAIN = false;
    bf16_t* O; int ldc; bf16_t* O2; int split_pm; float wscale;
    __device__ __forceinline__ static float silu_mul(float g, float u) { return g * __builtin_amdgcn_rcpf(1.0f + __builtin_amdgcn_exp2f(g * -1.4426950408889634f)) * u; }
    __device__ __forceinline__ void operator()(const f32x4 (&acc)[2][2][4][2], const Unit& u, int wr, int wc, int fr, int fq) const {
        const int row0 = u.pm * BM + wr * 64 + fr, col0 = u.pn * HALF + wc * 32 + 8 * fq;
#pragma unroll
        for (int ai = 0; ai < 2; ++ai)
#pragma unroll
            for (int m = 0; m < 4; ++m) { bf16_t* rowp = ((split_pm >= 0 && u.pm >= split_pm) ? O2 : O) + (size_t)(row0 + ai * HALF + m * 16) * ldc + col0;
                const f32x4 g0 = acc[ai][0][m][0] * wscale, g1 = acc[ai][0][m][1] * wscale, u0 = acc[ai][1][m][0] * wscale, u1 = acc[ai][1][m][1] * wscale;
                u32x4 w; w.x = cvt_pk_bf16(silu_mul(g0[0], u0[0]), silu_mul(g0[1], u0[1])); w.y = cvt_pk_bf16(silu_mul(g0[2], u0[2]), silu_mul(g0[3], u0[3]));
                w.z = cvt_pk_bf16(silu_mul(g1[0], u1[0]), silu_mul(g1[1], u1[1])); w.w = cvt_pk_bf16(silu_mul(g1[2], u1[2]), silu_mul(g1[3], u1[3]));
                *(u32x4*)rowp = w; }
    }
};
struct EpiResF32 {
    static constexpr bool PERM = false, AFTER_DRAIN = false;
    const float* R; float* out; int ldc; float alpha;
    __device__ __forceinline__ void operator()(const f32x4 (&acc)[2][2][4][2], const Unit& u, int wr, int wc, int fr, int fq) const {
        const int col0 = u.pn * BM + wc * 32 + 4 * fq;
#pragma unroll
        for (int ai = 0; ai < 2; ++ai)
#pragma unroll
            for (int m = 0; m < 4; ++m) { const size_t off = (size_t)(u.pm * BM + ai * HALF + wr * 64 + m * 16 + fr) * ldc + col0;
#pragma unroll
                for (int bj = 0; bj < 2; ++bj)
#pragma unroll
                    for (int n = 0; n < 2; ++n) { const f32x4 rs = *(const f32x4*)(R + off + bj * HALF + n * 16); *(f32x4*)(out + off + bj * HALF + n * 16) = rs * alpha + acc[ai][bj][m][n]; }
                if (m & 1) asm volatile("" ::: "memory"); }
    }
};
__device__ __forceinline__ unsigned pk4_e4m3(float a, float b, float c, float d) {
    a = __builtin_fminf(__builtin_fmaxf(a, -448.f), 448.f); b = __builtin_fminf(__builtin_fmaxf(b, -448.f), 448.f); c = __builtin_fminf(__builtin_fmaxf(c, -448.f), 448.f); d = __builtin_fminf(__builtin_fmaxf(d, -448.f), 448.f);
    unsigned w = 0u; w = __builtin_amdgcn_cvt_pk_fp8_f32(a, b, w, false); w = __builtin_amdgcn_cvt_pk_fp8_f32(c, d, w, true); return w;
}
struct EpiSwiGLU8 {
    static constexpr bool PERM = true, AFTER_DRAIN = false;
    unsigned char* O; int ldc; float wscale, hscale;
    __device__ __forceinline__ void operator()(const f32x4 (&acc)[2][2][4][2], const Unit& u, int wr, int wc, int fr, int fq) const {
        const int row0 = u.pm * BM + wr * 64 + fr, col0 = u.pn * HALF + wc * 32 + 8 * fq;
        typedef unsigned u32x2 __attribute__((ext_vector_type(2)));
#pragma unroll
        for (int ai = 0; ai < 2; ++ai)
#pragma unroll
            for (int m = 0; m < 4; ++m) { unsigned char* rowp = O + (size_t)(row0 + ai * HALF + m * 16) * ldc + col0;
                const f32x4 g0 = acc[ai][0][m][0] * wscale, g1 = acc[ai][0][m][1] * wscale, u0 = acc[ai][1][m][0] * (wscale * hscale), u1 = acc[ai][1][m][1] * (wscale * hscale);
                u32x2 w; w.x = pk4_e4m3(EpiSwiGLU::silu_mul(g0[0], u0[0]), EpiSwiGLU::silu_mul(g0[1], u0[1]), EpiSwiGLU::silu_mul(g0[2], u0[2]), EpiSwiGLU::silu_mul(g0[3], u0[3]));
                w.y = pk4_e4m3(EpiSwiGLU::silu_mul(g1[0], u1[0]), EpiSwiGLU::silu_mul(g1[1], u1[1]), EpiSwiGLU::silu_mul(g1[2], u1[2]), EpiSwiGLU::silu_mul(g1[3], u1[3]));
                *(u32x2*)rowp = w; }
    }
};
struct EpiBf16S {
    static constexpr bool PERM = true, AFTER_DRAIN = false;
    bf16_t* O; int ldc; float s;
    __device__ __forceinline__ void operator()(const f32x4 (&acc)[2][2][4][2], const Unit& u, int wr, int wc, int fr, int fq) const {
        const int row0 = u.pm * BM + wr * 64 + fr, col0 = u.pn * BM + wc * 32 + 8 * fq;
#pragma unroll
        for (int ai = 0; ai < 2; ++ai)
#pragma unroll
            for (int m = 0; m < 4; ++m) { bf16_t* rowp = O + (size_t)(row0 + ai * HALF + m * 16) * ldc + col0;
#pragma unroll
                for (int bj = 0; bj < 2; ++bj) { const f32x4 v0 = acc[ai][bj][m][0] * s, v1 = acc[ai][bj][m][1] * s;
                    u32x4 w; w.x = cvt_pk_bf16(v0[0], v0[1]); w.y = cvt_pk_bf16(v0[2], v0[3]); w.z = cvt_pk_bf16(v1[0], v1[1]); w.w = cvt_pk_bf16(v1[2], v1[3]);
                    *(u32x4*)(rowp + bj * HALF) = w; } }
    }
};
struct EpiResBf16 {
    static constexpr bool PERM = true, AFTER_DRAIN = false;
    const bf16_t* R; bf16_t* out; int ldc; float alpha; float s;
    __device__ __forceinline__ void operator()(const f32x4 (&acc)[2][2][4][2], const Unit& u, int wr, int wc, int fr, int fq) const {
        const int row0 = u.pm * BM + wr * 64 + fr, col0 = u.pn * BM + wc * 32 + 8 * fq;
#pragma unroll
        for (int ai = 0; ai < 2; ++ai)
#pragma unroll
            for (int m = 0; m < 4; ++m) { const size_t off = (size_t)(row0 + ai * HALF + m * 16) * ldc + col0;
#pragma unroll
                for (int bj = 0; bj < 2; ++bj) { const u32x4 rv = *(const u32x4*)(R + off + bj * HALF); const f32x4 v0 = acc[ai][bj][m][0] * s, v1 = acc[ai][bj][m][1] * s;
                    u32x4 w;
                    w.x = cvt_pk_bf16(alpha * __uint_as_float(rv.x << 16) + v0[0], alpha * __uint_as_float(rv.x & 0xffff0000u) + v0[1]);
                    w.y = cvt_pk_bf16(alpha * __uint_as_float(rv.y << 16) + v0[2], alpha * __uint_as_float(rv.y & 0xffff0000u) + v0[3]);
                    w.z = cvt_pk_bf16(alpha * __uint_as_float(rv.z << 16) + v1[0], alpha * __uint_as_float(rv.z & 0xffff0000u) + v1[1]);
                    w.w = cvt_pk_bf16(alpha * __uint_as_float(rv.w << 16) + v1[2], alpha * __uint_as_float(rv.w & 0xffff0000u) + v1[3]);
                    *(u32x4*)(out + off + bj * HALF) = w; }
                if (m & 1) asm volatile("" ::: "memory"); }
    }
};
constexpr int MOE_SUB = 64;
struct MoeOrder {
    int base, nrows, nN, G, c; int segt[9]; size_t estride_b; int split_pm; size_t adiff;
    __device__ __forceinline__ bool next(int i, Unit& u) const {
        const long L = (long)i * G + c; if (L >= (long)nrows * nN) return false;
        if (nrows % MOE_SUB) { u.pm = base + (int)(L % nrows); u.pn = (int)(L / nrows); }
        else { const int per = MOE_SUB * nN, sc = (int)(L / per), Lr = (int)(L % per); u.pm = base + sc * MOE_SUB + Lr % MOE_SUB; u.pn = Lr / MOE_SUB; }
        int e = 0;
#pragma unroll
        for (int k = 1; k < 8; ++k) e += (u.pm >= segt[k]) ? 1 : 0;
        u.boffb = (size_t)e * estride_b; u.aoffb = (split_pm >= 0 && u.pm >= split_pm) ? adiff : 0; u.ks = 0; return true;
    }
    __device__ __forceinline__ void a_ready(const Unit&) const {}
    __device__ __forceinline__ void done(const Unit&) const {}
};
struct MoeSplitK {
    int base, nrows, nN, nS, KS, G, c; int segt[9]; size_t estride_b;
    __device__ __forceinline__ bool next(int i, Unit& u) const {
        const long L = (long)i * G + c; if (L >= (long)nrows * nN * nS) return false;
        u.ks = (int)(L % nS); const int rest = (int)(L / nS); u.pm = base + rest % nrows; u.pn = rest / nrows;
        int e = 0;
#pragma unroll
        for (int k = 1; k < 8; ++k) e += (u.pm >= segt[k]) ? 1 : 0;
        u.boffb = (size_t)e * estride_b + (size_t)u.ks * KS * 2; u.aoffb = (size_t)u.ks * KS * 2; return true;
    }
    __device__ __forceinline__ void a_ready(const Unit&) const {}
    __device__ __forceinline__ void done(const Unit&) const {}
};
struct EpiPart {
    static constexpr bool PERM = true, AFTER_DRAIN = false;
    bf16_t* P; int ldc, base, ptiles; float s;
    __device__ __forceinline__ void operator()(const f32x4 (&acc)[2][2][4][2], const Unit& u, int wr, int wc, int fr, int fq) const {
        const int row0 = (u.ks * ptiles + (u.pm - base)) * BM + wr * 64 + fr, col0 = u.pn * BM + wc * 32 + 8 * fq;
#pragma unroll
        for (int ai = 0; ai < 2; ++ai)
#pragma unroll
            for (int m = 0; m < 4; ++m) { bf16_t* rowp = P + (size_t)(row0 + ai * HALF + m * 16) * ldc + col0;
#pragma unroll
                for (int bj = 0; bj < 2; ++bj) { const f32x4 v0 = acc[ai][bj][m][0] * s, v1 = acc[ai][bj][m][1] * s;
                    u32x4 w; w.x = cvt_pk_bf16(v0[0], v0[1]); w.y = cvt_pk_bf16(v0[2], v0[3]); w.z = cvt_pk_bf16(v1[0], v1[1]); w.w = cvt_pk_bf16(v1[2], v1[3]);
                    *(u32x4*)(rowp + bj * HALF) = w; } }
    }
};

template <class Epi, class Sched, bool ALIGN_EPI = false, bool SP2 = false, bool FP8 = false>
__device__ __forceinline__ void gemm_phase(PG8_LAS unsigned char* lds, const Gemm g, const Sched& S, const Epi& E) {
    const int tid = threadIdx.x, wid = __builtin_amdgcn_readfirstlane(tid >> 6), lane = tid & 63, wr = wid >> 2, wc = wid & 3, fr = lane & 15, fq = lane >> 4;
    const int K = g.K, nt = K / BK, LD = g.ld ? g.ld : g.K;
    unsigned voffA[2], voffB[2];
#pragma unroll
    for (int i = 0; i < 2; ++i) { int R, C; stage_rc(tid * 16 + i * 8192, R, C); const int Rb = Epi::PERM ? ((R & ~31) + perm32(R & 31)) : R;
        voffA[i] = (unsigned)(R * LD + C) * 2u; voffB[i] = (unsigned)(Rb * LD + C) * 2u; }
    const size_t kstep = (size_t)(BK * 2);
    const size_t hstep = (size_t)HALF * LD * 2;
    const size_t tstep = 2 * hstep;
    const unsigned ldsw = (unsigned)wid * 1024u;
    const int aoff = lds_byte(wr * 64 + fr, fq * 8), boff = lds_byte(wc * 32 + fr, fq * 8);
#define PG8_SA(b, h) (((b) * 2 + (h)) * HTB)
#define PG8_SB(b, h) ((4 + (b) * 2 + (h)) * HTB)
#define PG8_STAGE(bufoff, gbase, voff) do { _Pragma("unroll") for (int _i = 0; _i < 2; ++_i) \
        __builtin_amdgcn_global_load_lds((const unsigned*)((const char*)(gbase) + (voff)[_i]), (PG8_LAS unsigned*)(lds + (bufoff) + ldsw + _i * 8192), 16, 0, 0); } while (0)
#define PG8_LDA(dst, b, h) do { if constexpr (FP8) { _Pragma("unroll") for (int m = 0; m < 4; ++m) { const i32x4 lo_ = *(const PG8_LAS i32x4*)(lds + PG8_SA(b, h) + aoff + m * 2048), hi_ = *(const PG8_LAS i32x4*)(lds + PG8_SA(b, h) + aoff + m * 2048 + 1024); \
            dst##8[m] = __builtin_shufflevector(lo_, hi_, 0, 1, 2, 3, 4, 5, 6, 7); } } \
        else { _Pragma("unroll") for (int m = 0; m < 4; ++m) _Pragma("unroll") for (int k = 0; k < 2; ++k) dst[m][k] = *(const PG8_LAS bf16x8*)(lds + PG8_SA(b, h) + aoff + m * 2048 + k * 1024); } } while (0)
#define PG8_LDB(dst, b, h) do { if constexpr (FP8) { _Pragma("unroll") for (int n = 0; n < 2; ++n) { const i32x4 lo_ = *(const PG8_LAS i32x4*)(lds + PG8_SB(b, h) + boff + n * 2048), hi_ = *(const PG8_LAS i32x4*)(lds + PG8_SB(b, h) + boff + n * 2048 + 1024); \
            dst##8[n] = __builtin_shufflevector(lo_, hi_, 0, 1, 2, 3, 4, 5, 6, 7); } } \
        else { _Pragma("unroll") for (int n = 0; n < 2; ++n) _Pragma("unroll") for (int k = 0; k < 2; ++k) dst[n][k] = *(const PG8_LAS bf16x8*)(lds + PG8_SB(b, h) + boff + n * 2048 + k * 1024); } } while (0)
#define PG8_MMA(ai, bj, At, Bt) do { __builtin_amdgcn_s_setprio(1); \
        if constexpr (FP8) { _Pragma("unroll") for (int m = 0; m < 4; ++m) _Pragma("unroll") for (int n = 0; n < 2; ++n) \
            asm volatile("v_mfma_scale_f32_16x16x128_f8f6f4 %0, %1, %2, %0, %3, %3 op_sel_hi:[0,0,0]" : "+v"(acc[ai][bj][m][n]) : "v"(Bt##8[n]), "v"(At##8[m]), "v"(fp8_one)); } \
        else { _Pragma("unroll") for (int m = 0; m < 4; ++m) _Pragma("unroll") for (int n = 0; n < 2; ++n) _Pragma("unroll") for (int k = 0; k < 2; ++k) \
            acc[ai][bj][m][n] = __builtin_amdgcn_mfma_f32_16x16x32_bf16(Bt[n][k], At[m][k], acc[ai][bj][m][n], 0, 0, 0); } \
        __builtin_amdgcn_s_setprio(0); } while (0)
#define PG8_WAIT_V(n) asm volatile("s_waitcnt vmcnt(" #n ")" ::: "memory")
#define PG8_WAIT_L(n) asm volatile("s_waitcnt lgkmcnt(" #n ")" ::: "memory")
#define PG8_BAR __builtin_amdgcn_s_barrier()
#define PG8_SCHED __builtin_amdgcn_sched_barrier(0)
    Unit cur, nxt; int ui = 0;
    if (!S.next(0, cur)) return;
    f32x4 acc[2][2][4][2];
#pragma unroll
    for (int a = 0; a < 2; ++a)
#pragma unroll
        for (int b = 0; b < 2; ++b)
#pragma unroll
            for (int m = 0; m < 4; ++m)
#pragma unroll
                for (int n = 0; n < 2; ++n) acc[a][b][m][n] = (f32x4){0.f, 0.f, 0.f, 0.f};
    bf16x8 At[4][2], B0[2][2], B1[2][2];
    i32x8 At8[4], B08[2], B18[2];
    int fp8_one = 0x7F7F7F7F; if constexpr (FP8) asm volatile("" : "+v"(fp8_one));
    const char* cA = (const char*)g.A + (size_t)cur.pm * tstep + cur.aoffb; const char* cB = (const char*)g.Bt + (size_t)cur.pn * tstep + cur.boffb;
    S.a_ready(cur);
    if constexpr (SP2) {
        PG8_STAGE(PG8_SB(0, 0), cB, voffB); PG8_STAGE(PG8_SB(0, 1), cB + hstep, voffB); PG8_STAGE(PG8_SA(0, 0), cA, voffA); PG8_STAGE(PG8_SA(0, 1), cA + hstep, voffA);
        if (wr == 1) PG8_BAR;
        PG8_WAIT_V(2); PG8_BAR;
        PG8_STAGE(PG8_SB(1, 0), cB + kstep, voffB); PG8_STAGE(PG8_SA(1, 0), cA + kstep, voffA); PG8_STAGE(PG8_SB(1, 1), cB + hstep + kstep, voffB);
        PG8_WAIT_V(6); PG8_BAR;
    } else {
        PG8_STAGE(PG8_SB(0, 0), cB, voffB); PG8_STAGE(PG8_SA(0, 0), cA, voffA); PG8_STAGE(PG8_SB(0, 1), cB + hstep, voffB); PG8_STAGE(PG8_SA(0, 1), cA + hstep, voffA);
        if (wr == 1) PG8_BAR;
        PG8_WAIT_V(4); PG8_BAR;
        PG8_STAGE(PG8_SB(1, 0), cB + kstep, voffB); PG8_STAGE(PG8_SA(1, 0), cA + kstep, voffA); PG8_STAGE(PG8_SB(1, 1), cB + hstep + kstep, voffB);
        PG8_WAIT_V(6); PG8_BAR;
    }
    for (;;) {
        const bool has_next = S.next(ui + 1, nxt);
        const char* nA = has_next ? (const char*)g.A + (size_t)nxt.pm * tstep + nxt.aoffb : cA; const char* nB = has_next ? (const char*)g.Bt + (size_t)nxt.pn * tstep + nxt.boffb : cB;
#pragma unroll 1
        for (int t = 0; t < nt; t += 2) {
            const bool last = (t == nt - 2);
            const char* a1 = cA + (size_t)(t + 1) * kstep;
            const char* a2 = last ? nA : cA + (size_t)(t + 2) * kstep; const char* b2 = last ? nB : cB + (size_t)(t + 2) * kstep;
            const char* a3 = a2 + kstep; const char* b3 = b2 + kstep;
            if (last && has_next) S.a_ready(nxt);
            if constexpr (SP2) {
            PG8_LDB(B0, 0, 0); PG8_LDB(B1, 0, 1); PG8_SCHED; PG8_LDA(At, 0, 0); PG8_STAGE(PG8_SA(1, 1), a1 + hstep, voffA);
            PG8_WAIT_V(8); PG8_WAIT_L(0); PG8_BAR; PG8_MMA(0, 0, At, B0); PG8_MMA(0, 1, At, B1); PG8_BAR; PG8_SCHED;
            PG8_LDA(At, 0, 1); PG8_STAGE(PG8_SB(0, 0), b2, voffB); PG8_STAGE(PG8_SB(0, 1), b2 + hstep, voffB); PG8_STAGE(PG8_SA(0, 0), a2, voffA);
            PG8_WAIT_V(8); PG8_WAIT_L(0); PG8_BAR; PG8_MMA(1, 0, At, B0); PG8_MMA(1, 1, At, B1); PG8_BAR; PG8_SCHED;
            PG8_LDB(B0, 1, 0); PG8_LDB(B1, 1, 1); PG8_SCHED; PG8_LDA(At, 1, 0); PG8_STAGE(PG8_SA(0, 1), a2 + hstep, voffA);
            PG8_WAIT_V(8); PG8_WAIT_L(0); PG8_BAR; PG8_MMA(0, 0, At, B0); PG8_MMA(0, 1, At, B1); PG8_BAR; PG8_SCHED;
            PG8_LDA(At, 1, 1); PG8_STAGE(PG8_SB(1, 0), b3, voffB); PG8_STAGE(PG8_SB(1, 1), b3 + hstep, voffB); PG8_STAGE(PG8_SA(1, 0), a3, voffA);
            PG8_WAIT_V(8); PG8_WAIT_L(0); PG8_BAR; PG8_MMA(1, 0, At, B0); PG8_MMA(1, 1, At, B1); PG8_BAR; PG8_SCHED;
            } else {
            PG8_LDB(B0, 0, 0); PG8_SCHED; PG8_LDA(At, 0, 0); PG8_STAGE(PG8_SA(1, 1), a1 + hstep, voffA);
            PG8_WAIT_L(8); PG8_BAR; PG8_WAIT_L(0); PG8_MMA(0, 0, At, B0); PG8_BAR; PG8_SCHED;
            PG8_LDB(B1, 0, 1); PG8_STAGE(PG8_SB(0, 0), b2, voffB);
            PG8_BAR; PG8_WAIT_L(0); PG8_MMA(0, 1, At, B1); PG8_BAR;
            PG8_LDA(At, 0, 1); PG8_STAGE(PG8_SA(0, 0), a2, voffA);
            PG8_BAR; PG8_WAIT_L(0); PG8_MMA(1, 0, At, B0); PG8_BAR; PG8_SCHED;
            PG8_STAGE(PG8_SB(0, 1), b2 + hstep, voffB);
            PG8_WAIT_V(6); PG8_BAR; PG8_MMA(1, 1, At, B1); PG8_BAR;
            PG8_LDB(B0, 1, 0); PG8_SCHED; PG8_LDA(At, 1, 0); PG8_STAGE(PG8_SA(0, 1), a2 + hstep, voffA);
            PG8_WAIT_L(8); PG8_BAR; PG8_WAIT_L(0); PG8_MMA(0, 0, At, B0); PG8_BAR; PG8_SCHED;
            PG8_LDB(B1, 1, 1); PG8_STAGE(PG8_SB(1, 0), b3, voffB);
            PG8_BAR; PG8_WAIT_L(0); PG8_MMA(0, 1, At, B1); PG8_BAR;
            PG8_LDA(At, 1, 1); PG8_STAGE(PG8_SA(1, 0), a3, voffA);
            PG8_BAR; PG8_WAIT_L(0); PG8_MMA(1, 0, At, B0); PG8_BAR; PG8_SCHED;
            PG8_STAGE(PG8_SB(1, 1), b3 + hstep, voffB);
            PG8_WAIT_V(6); PG8_BAR; PG8_MMA(1, 1, At, B1); PG8_BAR;
            }
        }
        if constexpr (FP8) asm volatile("s_nop 15\n\ts_nop 15" ::: "memory");
        if constexpr (ALIGN_EPI) { if (wr == 0) PG8_BAR; }
        if constexpr (!Epi::AFTER_DRAIN) { E(acc, cur, wr, wc, fr, fq); S.done(cur); }
        if (!has_next) break;
#pragma unroll
        for (int a = 0; a < 2; ++a)
#pragma unroll
            for (int b = 0; b < 2; ++b)
#pragma unroll
                for (int m = 0; m < 4; ++m)
#pragma unroll
                    for (int n = 0; n < 2; ++n) acc[a][b][m][n] = (f32x4){0.f, 0.f, 0.f, 0.f};
        cur = nxt; cA = nA; cB = nB; ++ui;
        if constexpr (ALIGN_EPI) { if (wr == 1) PG8_BAR; }
    }
    PG8_WAIT_V(0);
    if constexpr (!ALIGN_EPI) { if (wr == 0) PG8_BAR; }
    PG8_BAR;
    if constexpr (Epi::AFTER_DRAIN) { E.fused(acc, cur, wr, wc, fr, fq, lds, wid, lane); S.done(cur); }
#undef PG8_SA
#undef PG8_SB
#undef PG8_STAGE
#undef PG8_LDA
#undef PG8_LDB
#undef PG8_MMA
#undef PG8_WAIT_V
#undef PG8_WAIT_L
#undef PG8_BAR
#undef PG8_SCHED
}
}
#define GAS __attribute__((address_space(1)))
#define LAS __attribute__((address_space(3)))
typedef unsigned short bf16;
typedef unsigned v4u __attribute__((ext_vector_type(4)));
typedef float f32x4 __attribute__((ext_vector_type(4)));
typedef short bf16x8 __attribute__((ext_vector_type(8)));
typedef GAS unsigned gu32;
typedef GAS unsigned long long gu64;
#define RLX_AGENT __ATOMIC_RELAXED, __HIP_MEMORY_SCOPE_AGENT
#define LDS_WAIT() asm volatile("s_waitcnt lgkmcnt(0)" ::: "memory")
#define VM_WAIT() asm volatile("s_waitcnt vmcnt(0)" ::: "memory")
__device__ __forceinline__ unsigned long long rt() { return __builtin_amdgcn_s_memrealtime(); }
__device__ __forceinline__ unsigned f2bf(float f) { unsigned u = __builtin_bit_cast(unsigned, f); return (u + 0x7fffu + ((u >> 16) & 1u)) >> 16; }
typedef float pk_f32x2_t __attribute__((ext_vector_type(2))); typedef __bf16 pk_bf16x2_t __attribute__((ext_vector_type(2)));
__device__ __forceinline__ unsigned pk2(float lo, float hi) { const pk_f32x2_t v = {lo, hi}; return __builtin_bit_cast(unsigned, __builtin_convertvector(v, pk_bf16x2_t)); }

#define XB_TMO      128
#define XB_XCNT(j)  (256  + 64 * (j))
#define XB_XSUB(j)  (1280 + 64 * (j))
#define XB_XGEN(j)  (2304 + 64 * (j))
#define XB_TOP      3328
#define XB_TOPGEN   3392
#define XCD_BAR_WORDS 3456
#define XB_SPIN_CAP (1u << 18)

__device__ __forceinline__ unsigned xb_ld(unsigned* p)              { return __hip_atomic_load(p, __ATOMIC_RELAXED, __HIP_MEMORY_SCOPE_AGENT); }
__device__ __forceinline__ unsigned xb_add(unsigned* p, unsigned v) { return __hip_atomic_fetch_add(p, v, __ATOMIC_RELAXED, __HIP_MEMORY_SCOPE_AGENT); }
__device__ __forceinline__ unsigned xb_xcc_id() { return (unsigned)__builtin_amdgcn_s_getreg((3 << 11) | 20) & 0xFu; }
#define XB_SPIN(cond, bar) do { unsigned _sp = 0; while (cond) { __builtin_amdgcn_s_sleep(1); \
    if ((++_sp & 255u) == 0u) { if (xb_ld(&(bar)[XB_TMO])) break; if (_sp > XB_SPIN_CAP) { atomicAdd(&(bar)[XB_TMO], 1u); break; } } } } while (0)

struct XcdBarrier {
    unsigned* bar; unsigned x;
    volatile LAS unsigned* st;
};

__device__ __forceinline__ XcdBarrier xcd_barrier_post(unsigned* bar, volatile LAS unsigned* st) {
    XcdBarrier b; b.bar = bar; b.x = xb_xcc_id(); b.st = st;
    if (threadIdx.x == 0) (void)xb_add(&bar[XB_XCNT(b.x)], 1u);
    return b;
}
__device__ __forceinline__ void xcd_barrier_complete(unsigned* bar, unsigned x, unsigned& nloc, unsigned& nx) {
    const unsigned G = gridDim.x * gridDim.y * gridDim.z;
    unsigned sum, cnt, mine, sp = 0u;
    for (;;) {
        sum = 0u; cnt = 0u; mine = 0u;
#pragma unroll
        for (unsigned j = 0; j < 16; ++j) { const unsigned c = xb_ld(&bar[XB_XCNT(j)]); sum += c; cnt += (c > 0u) ? 1u : 0u; mine = (j == x) ? c : mine; }
        if (sum == G) break;
        __builtin_amdgcn_s_sleep(1);
        if ((++sp & 255u) == 0u) { if (xb_ld(&bar[XB_TMO])) break; if (sp > XB_SPIN_CAP) { atomicAdd(&bar[XB_TMO], 1u); break; } }
    }
    nloc = mine > 0u ? mine : 1u; nx = cnt > 0u ? cnt : 1u;
}

__device__ __forceinline__ void xcd_barrier(const XcdBarrier& b) {
    asm volatile("s_waitcnt vmcnt(0)" ::: "memory");
    __syncthreads();
    if (threadIdx.x == 0) {
        unsigned* bar = b.bar;
        __builtin_amdgcn_s_waitcnt(0);
        unsigned nloc = b.st[0], nx = b.st[1];
        if (nloc == 0u) { xcd_barrier_complete(bar, b.x, nloc, nx); b.st[0] = nloc; b.st[1] = nx; }
        const unsigned old = xb_add(&bar[XB_XSUB(b.x)], 1u);
        const unsigned gen = old / nloc;
        if (old + 1u == (gen + 1u) * nloc) {
            __builtin_amdgcn_fence(__ATOMIC_RELEASE, "agent");
            asm volatile("s_waitcnt vmcnt(0)" ::: "memory");
            const unsigned og = xb_add(&bar[XB_TOP], 1u);
            const unsigned tg = og / nx;
            if (og + 1u == (tg + 1u) * nx) xb_add(&bar[XB_TOPGEN], 1u);
            else XB_SPIN(xb_ld(&bar[XB_TOPGEN]) == tg, bar);
            __builtin_amdgcn_fence(__ATOMIC_ACQUIRE, "agent");
            xb_add(&bar[XB_XGEN(b.x)], 1u);
            asm volatile("s_waitcnt vmcnt(0)" ::: "memory");
        } else {
            XB_SPIN(xb_ld(&bar[XB_XGEN(b.x)]) == gen, bar);
            __builtin_amdgcn_fence(__ATOMIC_ACQUIRE, "agent");
            asm volatile("s_waitcnt vmcnt(0)" ::: "memory");
        }
    }
    __syncthreads();
}


constexpr int NWAVES = 8;
constexpr int NBATCH = 8, SEQ = 4096, M = NBATCH * SEQ, D = 1024, DIN = 2560, DA = 512, DL = 512, NH = 8, HD = 64;
constexpr int DFF = 2816, NE = 8, DFE = 3584;
constexpr int SORT_ROWS = 2 * M + NE * 256, NT_MAX = SORT_ROWS / 256;
constexpr int CHUNK_TILES = 128, NCHUNK = (NT_MAX + CHUNK_TILES - 1) / CHUNK_TILES;
constexpr float ALPHA = 1.4142135623730951f, LN_EPS = 1e-5f, RMS_EPS = 1e-6f;
constexpr float LOG2E = 1.4426950408889634f, QSCALE = 0.125f * LOG2E;
constexpr int PH_PRO = 0, PH_L0 = 1, PH_L1 = 9;
constexpr int PH_DISPATCH = 14, PH_MOE0 = 15, PH_COMBINE = PH_MOE0 + 2 * NCHUNK, NPH = PH_COMBINE + 1;
constexpr size_t MiB = 1u << 20;
constexpr size_t WS_CTL = 0, CTL_ZERO_BYTES = 1 * MiB;
constexpr size_t WS_TOKE = 1 * MiB, WS_TOKP = WS_TOKE + 256 * 1024, WS_TOKPOS = WS_TOKP + 256 * 1024, WS_SEG = WS_TOKPOS + 256 * 1024;
constexpr size_t WS_LRUW = 2 * MiB;
constexpr size_t WS_LSE = 3 * MiB, WS_AGG = 6 * MiB;
constexpr size_t WS_WIN = 8 * MiB, WS_WOUT = 18 * MiB, WS_WGU = 22 * MiB, WS_WD = 33 * MiB, WS_MGU = 39 * MiB, WS_MD = 95 * MiB;
constexpr size_t WS_XB = 207 * MiB;
constexpr size_t WS_Q = 271 * MiB, WS_K = 303 * MiB, WS_V = 335 * MiB, WS_U = 367 * MiB, WS_G = 399 * MiB;
constexpr size_t WS_O0 = 39 * MiB, WS_O1 = 71 * MiB, WS_O2 = 103 * MiB;
constexpr size_t WS_LA = 135 * MiB, WS_BE = 167 * MiB;
constexpr size_t WS_Y = WS_Q;
constexpr size_t WS_HB = 271 * MiB, WS_X8 = 359 * MiB;
constexpr int TAIL_KS = 512, TAIL_NS = DFE / TAIL_KS, TAIL_TILES = NT_MAX - (NCHUNK - 1) * CHUNK_TILES;
constexpr size_t WS_PART = 8 * MiB;
static_assert(WS_PART + (size_t)TAIL_NS * TAIL_TILES * 256 * D * 2 <= 39 * MiB, "tail partials");
constexpr size_t WS_HCA = 151 * MiB, WS_XS8 = 271 * MiB, WS_YS = 337 * MiB, WS_END = 469 * MiB;
constexpr float MOE_HSCALE = 8.0f, MOE_DSCALE = 128.0f;
constexpr float MOE_WSCALE = 32.0f;
static_assert(WS_MGU + (size_t)NE * 2 * DFE * D <= WS_MD && WS_MD + (size_t)NE * D * DFE <= WS_HCA && WS_HCA + (size_t)TAIL_TILES * 256 * DFE <= WS_XB && (size_t)CHUNK_TILES * 256 * DFE <= (size_t)M * D * 4 && WS_XS8 + (size_t)SORT_ROWS * D <= WS_YS && WS_YS + (size_t)SORT_ROWS * D * 2 <= WS_END, "d_ws map");
constexpr int CW_TMO = 0, CW_CODE = 1, CW_BAR = 4096;
constexpr unsigned long long PROBE_MASK = 0ull; constexpr unsigned PROBE_K = 8; constexpr int PROBE_SEAM = -1;
constexpr int RING_OFF = 0, RING_BYTES = 131072;
constexpr int LDSCTL_OFF = RING_BYTES, MISC_OFF = LDSCTL_OFF + 320;
constexpr int LDS_BYTES = 147456;

typedef int v4i __attribute__((ext_vector_type(4)));
typedef unsigned v2u __attribute__((ext_vector_type(2)));
typedef float f32x2 __attribute__((ext_vector_type(2)));
struct Frame {
    LAS unsigned char* lds;
    volatile LAS unsigned* MISC;
    gu32* ctl;
    int tid, lane, wave;
    int vcu, G;
    unsigned long long pt0, pacc;
};
__device__ __forceinline__ int fresh_lane() { int l; asm volatile("v_mbcnt_lo_u32_b32 %0, -1, 0\n\tv_mbcnt_hi_u32_b32 %0, -1, %0" : "=v"(l)); return l; }
struct Args { const float* in[24]; float* out; unsigned char* ws; int ph_lo, ph_hi, li, pad; };

__device__ __forceinline__ float wave_sum(float v) {
#pragma unroll
    for (int o = 1; o < 64; o <<= 1) v += __shfl_xor(v, o);
    return v;
}
__device__ __forceinline__ float bf2f(bf16 h) { return __uint_as_float((unsigned)h << 16); }
__device__ __forceinline__ float bflo(unsigned w) { return __uint_as_float(w << 16); }
__device__ __forceinline__ float bfhi(unsigned w) { return __uint_as_float(w & 0xffff0000u); }

__device__ __forceinline__ void transpose_item(const float* W, int N, bf16* WT, int ldt, int dst_row0, LAS float* scr, int kb, int nb, int lane) {
    const int k0 = 64 * kb, n0 = 32 * nb;
    f32x4 v[8];
#pragma unroll
    for (int i = 0; i < 8; ++i) v[i] = *(const GAS f32x4*)(W + (size_t)(k0 + 8 * i + (lane >> 3)) * N + n0 + 4 * (lane & 7));
#pragma unroll
    for (int i = 0; i < 8; ++i) { LAS float* d = scr + (8 * i + (lane >> 3)) * 33 + 4 * (lane & 7); d[0] = v[i].x; d[1] = v[i].y; d[2] = v[i].z; d[3] = v[i].w; }
    LDS_WAIT(); asm volatile("" ::: "memory");
    const int c = lane & 7;
#pragma unroll
    for (int j = 0; j < 4; ++j) { const int n = (lane >> 3) + 8 * j; const LAS float* s = scr + (8 * c) * 33 + n;
        v4u o; o.x = pk2(s[0 * 33], s[1 * 33]); o.y = pk2(s[2 * 33], s[3 * 33]); o.z = pk2(s[4 * 33], s[5 * 33]); o.w = pk2(s[6 * 33], s[7 * 33]);
        *(GAS v4u*)(WT + (size_t)(dst_row0 + n) * ldt + k0 + 8 * c) = o; }
    LDS_WAIT(); asm volatile("" ::: "memory");
}
__device__ __forceinline__ unsigned pk4_fp8(float a, float b, float c, float d) {
    a = __builtin_fminf(__builtin_fmaxf(a, -448.f), 448.f); b = __builtin_fminf(__builtin_fmaxf(b, -448.f), 448.f); c = __builtin_fminf(__builtin_fmaxf(c, -448.f), 448.f); d = __builtin_fminf(__builtin_fmaxf(d, -448.f), 448.f);
    unsigned w = 0u; w = __builtin_amdgcn_cvt_pk_fp8_f32(a, b, w, false); w = __builtin_amdgcn_cvt_pk_fp8_f32(c, d, w, true); return w;
}
__device__ __forceinline__ void transpose_item_fp8(const float* W, int N, unsigned char* WT8, int ldt, int dst_row0, LAS float* scr, int kb, int nb, int lane, float scale) {
    const int k0 = 64 * kb, n0 = 32 * nb;
    f32x4 v[8];
#pragma unroll
    for (int i = 0; i < 8; ++i) v[i] = *(const GAS f32x4*)(W + (size_t)(k0 + 8 * i + (lane >> 3)) * N + n0 + 4 * (lane & 7));
#pragma unroll
    for (int i = 0; i < 8; ++i) { LAS float* d = scr + (8 * i + (lane >> 3)) * 33 + 4 * (lane & 7); d[0] = v[i].x * scale; d[1] = v[i].y * scale; d[2] = v[i].z * scale; d[3] = v[i].w * scale; }
    LDS_WAIT(); asm volatile("" ::: "memory");
    const int c = lane & 3;
#pragma unroll
    for (int j = 0; j < 2; ++j) { const int n = (lane >> 2) + 16 * j; const LAS float* s = scr + (16 * c) * 33 + n;
        v4u o; o.x = pk4_fp8(s[0 * 33], s[1 * 33], s[2 * 33], s[3 * 33]); o.y = pk4_fp8(s[4 * 33], s[5 * 33], s[6 * 33], s[7 * 33]);
        o.z = pk4_fp8(s[8 * 33], s[9 * 33], s[10 * 33], s[11 * 33]); o.w = pk4_fp8(s[12 * 33], s[13 * 33], s[14 * 33], s[15 * 33]);
        *(GAS v4u*)(WT8 + (size_t)(dst_row0 + n) * ldt + k0 + 16 * c) = o; }
    LDS_WAIT(); asm volatile("" ::: "memory");
}
__device__ __forceinline__ void tr_gu8(const float* W, int K, int N, unsigned char* WT8, int half, LAS float* scr, int item, int lane, float scale) {
    const int nblk = N / 32, kb = item / nblk, nb = item % nblk, n0 = 32 * nb; transpose_item_fp8(W, N, WT8, K, (n0 >> 7) * 256 + half * 128 + (n0 & 127), scr, kb, nb, lane, scale);
}
__device__ __forceinline__ void tr_plain8(const float* W, int K, int N, unsigned char* WT8, LAS float* scr, int item, int lane, float scale) {
    const int nblk = N / 32, kb = item / nblk, nb = item % nblk; transpose_item_fp8(W, N, WT8, K, 32 * nb, scr, kb, nb, lane, scale);
}
__device__ __forceinline__ void tr_plain(const float* W, int K, int N, bf16* WT, LAS float* scr, int item, int lane) {
    const int nblk = N / 32, kb = item / nblk, nb = item % nblk; transpose_item(W, N, WT, K, 32 * nb, scr, kb, nb, lane);
}
__device__ __forceinline__ void tr_gu(const float* W, int K, int N, bf16* WT, int half, LAS float* scr, int item, int lane) {
    const int nblk = N / 32, kb = item / nblk, nb = item % nblk, n0 = 32 * nb; transpose_item(W, N, WT, K, (n0 >> 7) * 256 + half * 128 + (n0 & 127), scr, kb, nb, lane);
}

__device__ __forceinline__ void phase_prologue(Frame& F, const Args& a) {
    LAS float* scr = (LAS float*)(F.lds + RING_OFF + F.wave * 16384);
    const int gw = F.vcu * NWAVES + F.wave, NGW = F.G * NWAVES;
    unsigned char* ws = a.ws;
    constexpr int I_WIN = (D / 64) * (DIN / 32), I_WOUT = (D / 64) * (D / 32), I_GU = (D / 64) * (DFF / 32), I_DN = (DFF / 64) * (D / 32), I_LRU = 64;
    constexpr int NITEMS = 2 * I_WIN + 2 * I_WOUT + 2 * I_GU + I_DN + I_LRU;
    for (int it = gw; it < NITEMS; it += NGW) {
        int r = it;
        if (r < 2 * I_WIN) { const int l = r / I_WIN; r -= l * I_WIN; tr_plain(a.in[1] + (size_t)l * D * DIN, D, DIN, (bf16*)(ws + WS_WIN) + (size_t)l * DIN * D, scr, r, F.lane); continue; } r -= 2 * I_WIN;
        if (r < 2 * I_WOUT) { const int l = r / I_WOUT; r -= l * I_WOUT; tr_plain(a.in[12] + (size_t)l * D * D, D, D, (bf16*)(ws + WS_WOUT) + (size_t)l * D * D, scr, r, F.lane); continue; } r -= 2 * I_WOUT;
        if (r < I_GU) { tr_gu(a.in[17], D, DFF, (bf16*)(ws + WS_WGU), 0, scr, r, F.lane); continue; } r -= I_GU;
        if (r < I_GU) { tr_gu(a.in[18], D, DFF, (bf16*)(ws + WS_WGU), 1, scr, r, F.lane); continue; } r -= I_GU;
        if (r < I_DN) { tr_plain8(a.in[19], DFF, D, ws + WS_WD, scr, r, F.lane, MOE_DSCALE); continue; } r -= I_DN;
        { const int mi = r >> 1, it2 = r & 1, l = mi >> 4, gate = (mi >> 3) & 1, g = mi & 7;
          const float* src = (gate ? a.in[6] : a.in[4]) + (size_t)(l * 8 + g) * 4096; tr_plain(src, 64, 64, (bf16*)(ws + WS_LRUW) + (size_t)mi * 4096, scr, it2, F.lane); }
    }
    const float* x = a.in[0]; bf16* XBp = (bf16*)(ws + WS_XB);
    for (int m = gw; m < M; m += NGW) {
        const GAS f32x4* xr = (const GAS f32x4*)(x + (size_t)m * D) + F.lane; GAS unsigned long long* o8 = (GAS unsigned long long*)(XBp + (size_t)m * D) + F.lane;
#pragma unroll
        for (int j = 0; j < 4; ++j) { const f32x4 v = xr[64 * j]; o8[64 * j] = (unsigned long long)pk2(v.x, v.y) | ((unsigned long long)pk2(v.z, v.w) << 32); }
    }
}
struct CvtItem { const float* src; unsigned char* dst; int N, ldt; float scale; };
__device__ __forceinline__ CvtItem moe_cvt_item(const Args& a, int it) {
    constexpr int I_MG = (D / 64) * (DFE / 32), I_MD = (DFE / 64) * (D / 32), I_E = 2 * I_MG + I_MD;
    const int e = it / I_E; int r = it - e * I_E;
    CvtItem c;
    if (r < 2 * I_MG) { const int half = r >= I_MG ? 1 : 0; r -= half * I_MG; constexpr int nblk = DFE / 32; const int q = r >> 1, kp = q / nblk, nb = q - kp * nblk, kb = 2 * kp + (r & 1), n0 = 32 * nb;
        c.src = (half ? a.in[22] : a.in[21]) + (size_t)e * D * DFE + (size_t)(64 * kb) * DFE + n0; c.N = DFE;
        c.dst = a.ws + WS_MGU + (size_t)e * (2 * DFE) * D + (size_t)((n0 >> 7) * 256 + half * 128 + (n0 & 127)) * D + 64 * kb; c.ldt = D; c.scale = MOE_WSCALE; }
    else { r -= 2 * I_MG; constexpr int nblk = D / 32; const int q = r >> 1, kp = q / nblk, nb = q - kp * nblk, kb = 2 * kp + (r & 1);
        c.src = a.in[23] + (size_t)e * DFE * D + (size_t)(64 * kb) * D + 32 * nb; c.N = D;
        c.dst = a.ws + WS_MD + (size_t)e * D * DFE + (size_t)(32 * nb) * DFE + 64 * kb; c.ldt = DFE; c.scale = MOE_DSCALE; }
    return c;
}
#define CVT_LOAD(v_, c_) do { _Pragma("unroll") for (int i_ = 0; i_ < 8; ++i_) v_[i_] = *(const GAS f32x4*)((c_).src + (size_t)(8 * i_ + (F.lane >> 3)) * (c_).N + 4 * (F.lane & 7)); } while (0)
__device__ __forceinline__ void phase_moe_cvt(Frame& F, const Args& a) {
    LAS float* scr = (LAS float*)(F.lds + RING_OFF + 32768 + F.wave * 8704);
    const int gw = F.vcu * NWAVES + F.wave, NGW = F.G * NWAVES;
    constexpr int I_MG = (D / 64) * (DFE / 32), I_MD = (DFE / 64) * (D / 32), TOT = NE * (2 * I_MG + I_MD);
    CvtItem c1 = moe_cvt_item(a, gw < TOT ? gw : 0), c2 = moe_cvt_item(a, gw + NGW < TOT ? gw + NGW : 0);
    f32x4 v1[8], v2[8];
    CVT_LOAD(v1, c1); CVT_LOAD(v2, c2);
    for (int it = gw; it < TOT; it += NGW) {
        const CvtItem c = c1; f32x4 v[8];
#pragma unroll
        for (int i = 0; i < 8; ++i) { v[i] = v1[i]; v1[i] = v2[i]; }
        c1 = c2; c2 = moe_cvt_item(a, it + 2 * NGW < TOT ? it + 2 * NGW : it);
        CVT_LOAD(v2, c2);
        const int l = F.lane;
#pragma unroll
        for (int i = 0; i < 8; ++i) { LAS float* d = scr + (8 * i + (l >> 3)) * 33 + 4 * (l & 7); d[0] = v[i].x * c.scale; d[1] = v[i].y * c.scale; d[2] = v[i].z * c.scale; d[3] = v[i].w * c.scale; }
        LDS_WAIT(); asm volatile("" ::: "memory");
        const int cc = l & 3;
#pragma unroll
        for (int j = 0; j < 2; ++j) { const int n = (l >> 2) + 16 * j; const LAS float* s = scr + (16 * cc) * 33 + n;
            v4u o; o.x = pk4_fp8(s[0 * 33], s[1 * 33], s[2 * 33], s[3 * 33]); o.y = pk4_fp8(s[4 * 33], s[5 * 33], s[6 * 33], s[7 * 33]);
            o.z = pk4_fp8(s[8 * 33], s[9 * 33], s[10 * 33], s[11 * 33]); o.w = pk4_fp8(s[12 * 33], s[13 * 33], s[14 * 33], s[15 * 33]);
            *(GAS v4u*)(c.dst + (size_t)n * c.ldt + 16 * cc) = o; }
        LDS_WAIT(); asm volatile("" ::: "memory");
    }
}
#undef CVT_LOAD
template <bool ROUTE>
__device__ __forceinline__ void phase_ln(Frame& F, bf16* XBp, const float* g, const float* b, const float* rw, int* tok_e, float* tok_p, unsigned char* X8 = nullptr) {
    const int gw = F.vcu * NWAVES + F.wave, NGW = F.G * NWAVES;
    LAS f32x4* rws = (LAS f32x4*)(F.lds + RING_OFF);
    if (ROUTE) { for (int i = F.tid; i < 2048; i += NWAVES * 64) rws[i] = ((const GAS f32x4*)rw)[i]; LDS_WAIT(); __syncthreads(); }
    f32x4 gv[4], bv[4];
#pragma unroll
    for (int j = 0; j < 2; ++j) { gv[2 * j] = ((const GAS f32x4*)g)[2 * F.lane + 128 * j]; gv[2 * j + 1] = ((const GAS f32x4*)g)[2 * F.lane + 128 * j + 1]; bv[2 * j] = ((const GAS f32x4*)b)[2 * F.lane + 128 * j]; bv[2 * j + 1] = ((const GAS f32x4*)b)[2 * F.lane + 128 * j + 1]; }
    v4u nx[2], ny[2];
    { const GAS v4u* xr = (const GAS v4u*)(XBp + (size_t)(gw < M ? gw : 0) * D) + F.lane; nx[0] = xr[0]; nx[1] = xr[64]; }
    { const int m1 = (gw + NGW < M) ? gw + NGW : 0; const GAS v4u* xr = (const GAS v4u*)(XBp + (size_t)m1 * D) + F.lane; ny[0] = xr[0]; ny[1] = xr[64]; }
    for (int m = gw; m < M; m += NGW) {
        const v4u r0 = nx[0], r1 = nx[1];
        nx[0] = ny[0]; nx[1] = ny[1];
        { const int mn = (m + 2 * NGW < M) ? m + 2 * NGW : m; const GAS v4u* xr = (const GAS v4u*)(XBp + (size_t)mn * D) + F.lane; ny[0] = xr[0]; ny[1] = xr[64]; }
        f32x4 v[4];
        v[0] = (f32x4){bflo(r0.x), bfhi(r0.x), bflo(r0.y), bfhi(r0.y)}; v[1] = (f32x4){bflo(r0.z), bfhi(r0.z), bflo(r0.w), bfhi(r0.w)};
        v[2] = (f32x4){bflo(r1.x), bfhi(r1.x), bflo(r1.y), bfhi(r1.y)}; v[3] = (f32x4){bflo(r1.z), bfhi(r1.z), bflo(r1.w), bfhi(r1.w)};
        float s = 0.f;
#pragma unroll
        for (int j = 0; j < 4; ++j) s += (v[j].x + v[j].y) + (v[j].z + v[j].w);
        const float mean = wave_sum(s) * (1.f / D); float s2 = 0.f;
#pragma unroll
        for (int j = 0; j < 4; ++j) { v[j] = v[j] - mean; s2 += (v[j].x * v[j].x + v[j].y * v[j].y) + (v[j].z * v[j].z + v[j].w * v[j].w); }
        const float rstd = 1.f / sqrtf(wave_sum(s2) * (1.f / D) + LN_EPS);
#pragma unroll
        for (int j = 0; j < 4; ++j) v[j] = v[j] * rstd * gv[j] + bv[j];
        GAS v4u* xw = (GAS v4u*)(XBp + (size_t)m * D) + F.lane;
        xw[0] = (v4u){pk2(v[0].x, v[0].y), pk2(v[0].z, v[0].w), pk2(v[1].x, v[1].y), pk2(v[1].z, v[1].w)};
        xw[64] = (v4u){pk2(v[2].x, v[2].y), pk2(v[2].z, v[2].w), pk2(v[3].x, v[3].y), pk2(v[3].z, v[3].w)};
        if (X8) { GAS v2u* x8 = (GAS v2u*)(X8 + (size_t)m * D) + F.lane;
            x8[0] = (v2u){pk4_fp8(v[0].x, v[0].y, v[0].z, v[0].w), pk4_fp8(v[1].x, v[1].y, v[1].z, v[1].w)}; x8[64] = (v2u){pk4_fp8(v[2].x, v[2].y, v[2].z, v[2].w), pk4_fp8(v[3].x, v[3].y, v[3].z, v[3].w)}; }
        if (ROUTE) {
            f32x4 la = {0.f, 0.f, 0.f, 0.f}, lb = {0.f, 0.f, 0.f, 0.f};
#pragma unroll
            for (int j = 0; j < 4; ++j)
#pragma unroll
                for (int i = 0; i < 4; ++i) { const int c = 8 * F.lane + 512 * (j >> 1) + 4 * (j & 1) + i; const f32x4 w0 = rws[2 * c], w1 = rws[2 * c + 1]; la += w0 * v[j][i]; lb += w1 * v[j][i]; }
            float lg[8];
            lg[0] = wave_sum(la.x); lg[1] = wave_sum(la.y); lg[2] = wave_sum(la.z); lg[3] = wave_sum(la.w); lg[4] = wave_sum(lb.x); lg[5] = wave_sum(lb.y); lg[6] = wave_sum(lb.z); lg[7] = wave_sum(lb.w);
            int e0 = 0; float v0 = lg[0];
#pragma unroll
            for (int e = 1; e < 8; ++e) if (lg[e] > v0) { v0 = lg[e]; e0 = e; }
            int e1 = -1; float v1 = -INFINITY;
#pragma unroll
            for (int e = 0; e < 8; ++e) if (e != e0 && lg[e] > v1) { v1 = lg[e]; e1 = e; }
            if (F.lane == 0) { const float p1 = expf(v1 - v0), den = 1.f + p1; tok_e[2 * m] = e0; tok_e[2 * m + 1] = e1; tok_p[2 * m] = 1.f / den; tok_p[2 * m + 1] = p1 / den; }
        }
    }
}
__device__ __forceinline__ void phase_dispatch(Frame& F, const int* tok_e, int* tok_pos, int* segtab, const bf16* XBp, unsigned char* XS8) {
    LAS int* s_tot = (LAS int*)(F.lds + RING_OFF); LAS int* s_bef = s_tot + 8; LAS int* s_w = s_tot + 16; LAS int* s_pos = s_tot + 32;
    for (int tile = blockIdx.x; tile < M / 128; tile += F.G) {
        __syncthreads();
        if (F.tid < 32) s_tot[F.tid] = 0;
        __syncthreads();
        int tot[8], bef[8];
#pragma unroll
        for (int e = 0; e < 8; ++e) { tot[e] = 0; bef[e] = 0; }
        const GAS v4i* te4 = (const GAS v4i*)tok_e;
        for (int i4 = F.tid; i4 < 2 * M / 4; i4 += NWAVES * 64) { const v4i ev = te4[i4]; const int before = (2 * i4 < tile * 128) ? 1 : 0;
#pragma unroll
            for (int e = 0; e < 8; ++e) { const int hit = (ev.x == e) + (ev.y == e) + (ev.z == e) + (ev.w == e); tot[e] += hit; bef[e] += before ? hit : 0; } }
#pragma unroll
        for (int e = 0; e < 8; ++e) { int a = tot[e], b = bef[e];
#pragma unroll
            for (int o = 1; o < 64; o <<= 1) { a += __shfl_xor(a, o); b += __shfl_xor(b, o); }
            if (F.lane == 0) { __hip_atomic_fetch_add(&s_tot[e], a, __ATOMIC_RELAXED, __HIP_MEMORY_SCOPE_WORKGROUP); __hip_atomic_fetch_add(&s_bef[e], b, __ATOMIC_RELAXED, __HIP_MEMORY_SCOPE_WORKGROUP); } }
        int e0 = -1, e1 = -1, rk0 = 0, rk1 = 0; const int tok = tile * 128 + F.tid;
        if (F.wave < 2) { e0 = tok_e[2 * tok]; e1 = tok_e[2 * tok + 1];
#pragma unroll
            for (int e = 0; e < 8; ++e) { const bool has = (e0 == e) || (e1 == e); const unsigned long long mask = __ballot(has); const int rk = __popcll(mask & ((1ull << F.lane) - 1ull));
                if (e0 == e) rk0 = rk; if (e1 == e) rk1 = rk; if (F.lane == 0) s_w[F.wave * 8 + e] = __popcll(mask); } }
        LDS_WAIT(); __syncthreads();
        int seg[9]; seg[0] = 0;
#pragma unroll
        for (int e = 0; e < 8; ++e) seg[e + 1] = seg[e] + ((s_tot[e] + 255) & ~255);
        if (F.wave < 2) { int p0 = 0, p1 = 0;
#pragma unroll
            for (int e = 0; e < 8; ++e) { const int wp = (F.wave == 1) ? s_w[e] : 0; if (e0 == e) p0 = seg[e] + s_bef[e] + wp + rk0; if (e1 == e) p1 = seg[e] + s_bef[e] + wp + rk1; }
            tok_pos[2 * tok] = p0; tok_pos[2 * tok + 1] = p1; s_pos[2 * F.tid] = p0; s_pos[2 * F.tid + 1] = p1; }
        if (tile == 0) {
#pragma unroll
            for (int k = 0; k < 9; ++k) if (F.tid == k) segtab[k] = seg[k] >> 8;
        }
        LDS_WAIT(); __syncthreads();
        for (int i0 = F.wave * 16; i0 < F.wave * 16 + 16; i0 += 4) { v4u ra[4], rb[4];
#pragma unroll
            for (int j = 0; j < 4; ++j) { const GAS v4u* src = (const GAS v4u*)(XBp + (size_t)(tile * 128 + i0 + j) * D) + F.lane; ra[j] = src[0]; rb[j] = src[64]; }
#pragma unroll
            for (int j = 0; j < 4; ++j) { const int p0 = s_pos[2 * (i0 + j)], p1 = s_pos[2 * (i0 + j) + 1];
                v2u qa, qb;
                qa.x = pk4_fp8(bflo(ra[j].x), bfhi(ra[j].x), bflo(ra[j].y), bfhi(ra[j].y)); qa.y = pk4_fp8(bflo(ra[j].z), bfhi(ra[j].z), bflo(ra[j].w), bfhi(ra[j].w));
                qb.x = pk4_fp8(bflo(rb[j].x), bfhi(rb[j].x), bflo(rb[j].y), bfhi(rb[j].y)); qb.y = pk4_fp8(bflo(rb[j].z), bfhi(rb[j].z), bflo(rb[j].w), bfhi(rb[j].w));
                GAS v2u* d0 = (GAS v2u*)(XS8 + (size_t)p0 * D) + F.lane; d0[0] = qa; d0[64] = qb;
                GAS v2u* d1 = (GAS v2u*)(XS8 + (size_t)p1 * D) + F.lane; d1[0] = qa; d1[64] = qb; } }
    }
}
__device__ __forceinline__ void phase_combine(Frame& F, const bf16* XBp, float* outp, const bf16* YS, const int* tok_pos, const float* tok_p, const float* g, const float* b, const bf16* PART, const int mode, const int tail_row0, const int gw, const int NGW) {
    f32x4 gv[4], bv[4];
#pragma unroll
    for (int j = 0; j < 4; ++j) { gv[j] = ((const GAS f32x4*)g)[F.lane + 64 * j]; bv[j] = ((const GAS f32x4*)b)[F.lane + 64 * j]; }
    for (int m = gw; m < M; m += NGW) {
        const int p0 = __builtin_amdgcn_readfirstlane(tok_pos[2 * m]), p1 = __builtin_amdgcn_readfirstlane(tok_pos[2 * m + 1]);
        const bool in_tail = (p0 >= tail_row0) || (p1 >= tail_row0);
        if ((mode == 1 && in_tail) || (mode == 2 && !in_tail)) continue;
        const float w0 = tok_p[2 * m], w1 = tok_p[2 * m + 1];
        const GAS v2u* xr = (const GAS v2u*)(XBp + (size_t)m * D) + F.lane;
        const GAS v2u* y0 = (const GAS v2u*)(YS + (size_t)p0 * D) + F.lane; const GAS v2u* y1 = (const GAS v2u*)(YS + (size_t)p1 * D) + F.lane;
        f32x4 v[4]; float s = 0.f;
#pragma unroll
        for (int j = 0; j < 4; ++j) { const v2u x = xr[64 * j]; f32x4 ya, yc;
            if (p0 >= tail_row0) { ya = (f32x4){0.f, 0.f, 0.f, 0.f};
#pragma unroll
                for (int ks = 0; ks < TAIL_NS; ++ks) { const v2u q = ((const GAS v2u*)(PART + ((size_t)ks * TAIL_TILES * 256 + (p0 - tail_row0)) * D) + F.lane)[64 * j]; ya += (f32x4){bflo(q.x), bfhi(q.x), bflo(q.y), bfhi(q.y)}; } }
            else { const v2u q = y0[64 * j]; ya = (f32x4){bflo(q.x), bfhi(q.x), bflo(q.y), bfhi(q.y)}; }
            if (p1 >= tail_row0) { yc = (f32x4){0.f, 0.f, 0.f, 0.f};
#pragma unroll
                for (int ks = 0; ks < TAIL_NS; ++ks) { const v2u q = ((const GAS v2u*)(PART + ((size_t)ks * TAIL_TILES * 256 + (p1 - tail_row0)) * D) + F.lane)[64 * j]; yc += (f32x4){bflo(q.x), bfhi(q.x), bflo(q.y), bfhi(q.y)}; } }
            else { const v2u q = y1[64 * j]; yc = (f32x4){bflo(q.x), bfhi(q.x), bflo(q.y), bfhi(q.y)}; }
            v[j].x = ALPHA * bflo(x.x) + (w0 * ya.x + w1 * yc.x); v[j].y = ALPHA * bfhi(x.x) + (w0 * ya.y + w1 * yc.y);
            v[j].z = ALPHA * bflo(x.y) + (w0 * ya.z + w1 * yc.z); v[j].w = ALPHA * bfhi(x.y) + (w0 * ya.w + w1 * yc.w);
            s += (v[j].x + v[j].y) + (v[j].z + v[j].w); }
        const float mean = wave_sum(s) * (1.f / D); float s2 = 0.f;
#pragma unroll
        for (int j = 0; j < 4; ++j) { v[j] = v[j] - mean; s2 += (v[j].x * v[j].x + v[j].y * v[j].y) + (v[j].z * v[j].z + v[j].w * v[j].w); }
        const float rstd = 1.f / sqrtf(wave_sum(s2) * (1.f / D) + LN_EPS);
        GAS f32x4* ow = (GAS f32x4*)(outp + (size_t)m * D) + F.lane;
#pragma unroll
        for (int j = 0; j < 4; ++j) ow[64 * j] = v[j] * rstd * gv[j] + bv[j];
    }
}

namespace att {
typedef float f32x16 __attribute__((ext_vector_type(16)));
typedef short s16x4 __attribute__((ext_vector_type(4)));
constexpr int NTASK = NBATCH * NH * 48;
constexpr int K_PITCH = 144, V_OFF = 384 * K_PITCH, V_DBS = 384 * 64 + 64, BIAS_OFF = V_OFF + 2 * V_DBS, TAB_OFF = BIAS_OFF + 528, NEG_OFF = TAB_OFF + 5 * 4 * 64 * 16, ATT_LDS = NEG_OFF + 4 * 64 * 16;
static_assert(ATT_LDS <= RING_BYTES && (TAB_OFF % 16) == 0, "attention LDS");
__device__ __forceinline__ int t5_bucket(int dist) {
    if (dist < 16) return dist;
    int b = 16;
    b += dist >= 22; b += dist >= 30; b += dist >= 40; b += dist >= 54; b += dist >= 73; b += dist >= 99; b += dist >= 134; b += dist >= 182;
    b += dist >= 246; b += dist >= 332; b += dist >= 450; b += dist >= 609; b += dist >= 825; b += dist >= 1117; b += dist >= 1513;
    return b;
}
__device__ __forceinline__ s16x4 vtr(LAS const unsigned char* p) { typedef short v4i16_t __attribute__((ext_vector_type(4))); return __builtin_bit_cast(s16x4, __builtin_amdgcn_ds_read_tr16_b64_v4i16((LAS v4i16_t*)p)); }
struct Task { int head, p, b, r, k, dil; };
__device__ __forceinline__ Task decode(int n, int head) { Task t; t.head = head; t.p = n >> 7; t.b = (n >> 4) & 7; const int q16 = n & 15, npair = 16 >> (2 * t.p); t.r = q16 / npair; t.k = q16 - t.r * npair; t.dil = 1 << (2 * t.p); return t; }

#define PBR(k) do { if (PROBE_MASK >> 32) { const unsigned long long t_ = rt(); if ((PROBE_MASK >> (k)) & 1ull) F.pacc += t_ - F.pt0; F.pt0 = t_; } } while (0)
__device__ __forceinline__ void attn_phase(Frame& F, const bf16* Qg, const bf16* Kg, const bf16* Vg, const float* rel_bias, bf16* O0, bf16* O1, bf16* O2, float* LSE) {
    LAS unsigned char* lds = F.lds + RING_OFF;
    LAS float* bias_l = (LAS float*)(lds + BIAS_OFF);
    LAS f32x4* tab = (LAS f32x4*)(lds + TAB_OFF);
    const int w = F.wave, l = F.lane, q_rel = l & 31, hh = l >> 5;
    const int head = (int)blockIdx.x & 7, jwg = (int)blockIdx.x >> 3, nwg = (F.G + 7 - head) >> 3;
    const int T0 = jwg, T1 = NTASK / 8;
    v4u kreg[6], vreg[6]; bf16x8 qn[4];
    int cur_hp = -1;
#define ATT_LOAD(T_) do { const Task t_ = decode(T_, head); const size_t rb_ = (size_t)t_.b * SEQ * DA + t_.head * HD; \
        _Pragma("unroll") for (int n = 0; n < 6; ++n) { const int ci = F.tid + 512 * n, kk = ci >> 3, c = ci & 7, li = 256 * t_.k - 128 + kk; \
            const bool ok_ = li >= 0; const size_t off = rb_ + (size_t)((ok_ ? li : 0) * t_.dil + t_.r) * DA + c * 8;     \
            const v4u kx_ = *(const GAS v4u*)(Kg + off), vx_ = *(const GAS v4u*)(Vg + off); kreg[n] = ok_ ? kx_ : (v4u){0u, 0u, 0u, 0u}; vreg[n] = ok_ ? vx_ : (v4u){0u, 0u, 0u, 0u}; } \
        const bf16* qp_ = Qg + rb_ + (size_t)((256 * t_.k + 32 * w + q_rel) * t_.dil + t_.r) * DA + 8 * hh; \
        _Pragma("unroll") for (int s = 0; s < 4; ++s) qn[s] = *(const GAS bf16x8*)(qp_ + 16 * s); } while (0)
    if (T0 < T1) ATT_LOAD(T0);
    for (int T = T0; T < T1; T += nwg) {
        const Task t = decode(T, head);
        const int hp = t.p;
        if (PROBE_MASK >> 32) F.pt0 = rt();
        __syncthreads();
#pragma unroll
        for (int n = 0; n < 6; ++n) { const int ci = F.tid + 512 * n, kk = ci >> 3, c = ci & 7;
            *(LAS v4u*)(lds + kk * K_PITCH + c * 16) = kreg[n];
            *(LAS v4u*)(lds + V_OFF + (c >> 2) * V_DBS + kk * 64 + (c & 3) * 16) = vreg[n]; }
        bf16x8 qf[4];
#pragma unroll
        for (int s = 0; s < 4; ++s) qf[s] = qn[s];
        if (hp != cur_hp) {
            if (F.tid < 129) bias_l[F.tid] = rel_bias[t5_bucket(F.tid * t.dil) * NH + t.head] * LOG2E;
            LDS_WAIT(); __syncthreads();
            for (int idx = F.tid; idx < 5 * 4 * 64; idx += NWAVES * 64) { const int ln = idx & 63, e4 = (idx >> 6) & 3, i = idx >> 8, qr = ln & 31, h2 = ln >> 5;
                f32x4 tv;
#pragma unroll
                for (int j = 0; j < 4; ++j) { const int k_rel = j + 8 * e4 + 4 * h2; int delta = 128 - 32 * i + qr - k_rel; const bool ok = (i != 0 || k_rel >= qr) && (i != 4 || k_rel <= qr);
                    delta = delta < 0 ? 0 : (delta > 128 ? 128 : delta); tv[j] = ok ? bias_l[delta] : -1e30f; }
                tab[idx] = tv; }
            for (int idx = F.tid; idx < 4 * 64; idx += NWAVES * 64) ((LAS f32x4*)(lds + NEG_OFF))[idx] = (f32x4){-1e30f, -1e30f, -1e30f, -1e30f};
            cur_hp = hp;
        }
        LDS_WAIT(); __syncthreads();
        PBR(32);
        if (T + nwg < T1) ATT_LOAD(T + nwg);
        f32x16 st[5];
        const LAS unsigned char* kbase = lds + (32 * w + q_rel) * K_PITCH + 16 * hh;
        const LAS f32x4* negt = (const LAS f32x4*)(lds + NEG_OFF) + l;
        float mx = -1e30f;
#pragma unroll
        for (int i = 0; i < 5; ++i) {
            const LAS f32x4* tp = (t.k == 0 && w + i < 4) ? negt : tab + (i * 4) * 64 + l;
#pragma unroll
            for (int e4 = 0; e4 < 4; ++e4) { const f32x4 tv = tp[e4 * 64];
#pragma unroll
                for (int j = 0; j < 4; ++j) st[i][4 * e4 + j] = tv[j]; }
#pragma unroll
            for (int s = 0; s < 4; ++s) { const bf16x8 kf = *(const LAS bf16x8*)(kbase + i * (32 * K_PITCH) + s * 32); st[i] = __builtin_amdgcn_mfma_f32_32x32x16_bf16(kf, qf[s], st[i], 0, 0, 0); }
        }
#pragma unroll
        for (int i = 0; i < 5; ++i)
#pragma unroll
            for (int e = 0; e < 16; ++e) mx = fmaxf(mx, st[i][e]);
        mx = fmaxf(mx, __shfl_xor(mx, 32));
        PBR(33);
        float ls[5];
#pragma unroll
        for (int i = 0; i < 5; ++i) { float a0 = 0.f, a1 = 0.f;
#pragma unroll
            for (int e = 0; e < 16; e += 2) { const float p0 = __builtin_amdgcn_exp2f(st[i][e] - mx), p1 = __builtin_amdgcn_exp2f(st[i][e + 1] - mx); st[i][e] = p0; st[i][e + 1] = p1; a0 += p0; a1 += p1; }
            ls[i] = a0 + a1; }
        float lsum = (ls[0] + ls[1]) + (ls[2] + ls[3]) + ls[4];
        lsum += __shfl_xor(lsum, 32);
        PBR(34);
        f32x16 o[2];
#pragma unroll
        for (int e = 0; e < 16; ++e) { o[0][e] = 0.f; o[1][e] = 0.f; }
        const LAS unsigned char* vb = lds + V_OFF + (32 * w + 4 * hh + ((l & 15) >> 2)) * 64 + (16 * ((l >> 4) & 1) + 4 * (l & 3)) * 2;
#pragma unroll
        for (int i = 0; i < 5; ++i)
#pragma unroll
            for (int s2 = 0; s2 < 2; ++s2) {
                v4u pw; pw.x = pk2(st[i][8 * s2 + 0], st[i][8 * s2 + 1]); pw.y = pk2(st[i][8 * s2 + 2], st[i][8 * s2 + 3]);
                pw.z = pk2(st[i][8 * s2 + 4], st[i][8 * s2 + 5]); pw.w = pk2(st[i][8 * s2 + 6], st[i][8 * s2 + 7]);
                const bf16x8 pf = __builtin_bit_cast(bf16x8, pw);
#pragma unroll
                for (int db = 0; db < 2; ++db) { const s16x4 lo = vtr(vb + db * V_DBS + i * 2048 + s2 * 1024), hi = vtr(vb + db * V_DBS + i * 2048 + s2 * 1024 + 512);
                    const bf16x8 vf = (bf16x8){lo[0], lo[1], lo[2], lo[3], hi[0], hi[1], hi[2], hi[3]};
                    o[db] = __builtin_amdgcn_mfma_f32_32x32x16_bf16(vf, pf, o[db], 0, 0, 0); }
            }
        PBR(35);
        const float inv = 1.0f / lsum;
        const size_t rowbase = (size_t)t.b * SEQ * DA + t.head * HD; const int qtok = (256 * t.k + 32 * w + q_rel) * t.dil + t.r;
        bf16* Op = (t.p == 0) ? O0 : (t.p == 1) ? O1 : O2;
        bf16* orow = Op + rowbase + (size_t)qtok * DA + 8 * hh;
#pragma unroll
        for (int db = 0; db < 2; ++db)
#pragma unroll
            for (int g = 0; g < 4; g += 2) {
                unsigned ax = pk2(o[db][4 * g] * inv, o[db][4 * g + 1] * inv), ay = pk2(o[db][4 * g + 2] * inv, o[db][4 * g + 3] * inv);
                unsigned bx = pk2(o[db][4 * g + 4] * inv, o[db][4 * g + 5] * inv), by = pk2(o[db][4 * g + 6] * inv, o[db][4 * g + 7] * inv);
                { const auto r = __builtin_amdgcn_permlane32_swap(ax, bx, false, false); ax = r[0]; bx = r[1]; }
                { const auto r = __builtin_amdgcn_permlane32_swap(ay, by, false, false); ay = r[0]; by = r[1]; }
                *(GAS v4u*)(orow + 32 * db + 8 * g) = (v4u){ax, ay, bx, by}; }
        if (hh == 0) LSE[((size_t)t.p * M + (size_t)t.b * SEQ + qtok) * NH + t.head] = mx + __builtin_amdgcn_logf(lsum);
        PBR(36);
    }
#undef ATT_LOAD
}
__device__ __forceinline__ void merge_attn_phase(Frame& F, const bf16* O0, const bf16* O1, const bf16* O2, const float* LSE, const float* g_attn, bf16* Y) {
    const int gw = F.vcu * NWAVES + F.wave, NGW = F.G * NWAVES, head = F.lane >> 3;
    const f32x4 g0 = ((const GAS f32x4*)g_attn)[2 * F.lane], g1 = ((const GAS f32x4*)g_attn)[2 * F.lane + 1];
    v4u na, nb, nc; float nl0, nl1, nl2;
#define MRG_LOAD(m_) do { const int mm_ = (m_) < M ? (m_) : 0; na = ((const GAS v4u*)(O0 + (size_t)mm_ * DA))[F.lane]; nb = ((const GAS v4u*)(O1 + (size_t)mm_ * DA))[F.lane]; nc = ((const GAS v4u*)(O2 + (size_t)mm_ * DA))[F.lane]; \
        nl0 = LSE[((size_t)0 * M + mm_) * NH + head]; nl1 = LSE[((size_t)1 * M + mm_) * NH + head]; nl2 = LSE[((size_t)2 * M + mm_) * NH + head]; } while (0)
    MRG_LOAD(gw);
    for (int m = gw; m < M; m += NGW) {
        const v4u a = na, b = nb, c = nc; const float l0 = nl0, l1 = nl1, l2 = nl2;
        MRG_LOAD(m + NGW);
        const float mx = fmaxf(l0, fmaxf(l1, l2));
        float w0 = __builtin_amdgcn_exp2f(l0 - mx), w1 = __builtin_amdgcn_exp2f(l1 - mx), w2 = __builtin_amdgcn_exp2f(l2 - mx);
        const float inv = 1.0f / (w0 + w1 + w2); w0 *= inv; w1 *= inv; w2 *= inv;
        float v[8]; float ss = 0.f;
#pragma unroll
        for (int j = 0; j < 4; ++j) { v[2 * j] = w0 * bflo(a[j]) + w1 * bflo(b[j]) + w2 * bflo(c[j]); v[2 * j + 1] = w0 * bfhi(a[j]) + w1 * bfhi(b[j]) + w2 * bfhi(c[j]); ss += v[2 * j] * v[2 * j] + v[2 * j + 1] * v[2 * j + 1]; }
        const float rs = 1.0f / sqrtf(wave_sum(ss) * (1.0f / DA) + RMS_EPS);
        v4u ov; ov.x = pk2(v[0] * rs * g0.x, v[1] * rs * g0.y); ov.y = pk2(v[2] * rs * g0.z, v[3] * rs * g0.w); ov.z = pk2(v[4] * rs * g1.x, v[5] * rs * g1.y); ov.w = pk2(v[6] * rs * g1.z, v[7] * rs * g1.w);
        ((GAS v4u*)(Y + (size_t)m * D))[F.lane] = ov;
    }
#undef MRG_LOAD
}
}

namespace lru {
constexpr int TAB_OFF = 0, STG_OFF = 10240, STG_WAVE = 16 * 68 * 4, GST_OFF = STG_OFF + NWAVES * STG_WAVE, GST_WAVE = 16 * 64 * 2, VST_OFF = GST_OFF + NWAVES * GST_WAVE, VST_WAVE = 64 * 64 * 2,
              SS_OFF = VST_OFF + NWAVES * VST_WAVE, LRU_LDS = SS_OFF + 2048;
static_assert(LRU_LDS <= RING_BYTES && (SS_OFF % 16) == 0 && (STG_OFF % 16) == 0, "LRU LDS");
constexpr int NUNIT = NBATCH * (SEQ / 64);
constexpr int FT_PITCH = 144, FT_WAVE = 64 * FT_PITCH;
static_assert(NWAVES * FT_WAVE + 2048 <= RING_BYTES, "LRU final LDS");
__device__ __forceinline__ float sigmoidf_fast(float x) { return __builtin_amdgcn_rcpf(1.0f + __builtin_amdgcn_exp2f(-LOG2E * x)); }

template <bool FINAL>
__device__ __forceinline__ void lru_phase(Frame& F, const int layer, const Args& a, const bf16* Ug, const bf16* Gg, float* AGG, bf16* Y, bf16* LAo, bf16* BEo) {
    LAS unsigned char* lds = F.lds + RING_OFF;
    LAS float* convw = (LAS float*)(lds + TAB_OFF);
    LAS float* convb = convw + 2048;
    __syncthreads();
    for (int i = F.tid; i < 2048; i += NWAVES * 64) convw[i] = a.in[2][layer * 2048 + i];
    if (F.tid < 512) convb[F.tid] = a.in[3][layer * 512 + F.tid];
    LDS_WAIT(); __syncthreads();
    const int g = F.wave, l = F.lane, c16 = l & 15, lg = l >> 4;
    float nba[4], nbx[4], c2[4];
#pragma unroll
    for (int t = 0; t < 4; ++t) { const int ch = 64 * g + 16 * t + c16; nba[t] = -LOG2E * a.in[5][layer * 512 + ch]; nbx[t] = -LOG2E * a.in[7][layer * 512 + ch]; c2[t] = -8.0f * LOG2E * log1pf(expf(-a.in[8][layer * 512 + ch])); }
    bf16x8 wf[2][4][2];
    { const bf16* Wbase = (const bf16*)(a.ws + WS_LRUW) + (size_t)(layer * 16 + g) * 4096 + c16 * 64 + 8 * lg;
#pragma unroll
      for (int gate = 0; gate < 2; ++gate)
#pragma unroll
        for (int t = 0; t < 4; ++t)
#pragma unroll
            for (int s = 0; s < 2; ++s) wf[gate][t][s] = *(const GAS bf16x8*)(Wbase + (size_t)gate * 8 * 4096 + t * 16 * 64 + s * 32); }
    LAS float* stg = (LAS float*)(lds + STG_OFF + g * STG_WAVE);
    LAS bf16* gst = (LAS bf16*)(lds + GST_OFF + g * GST_WAVE);
    LAS bf16* vst = (LAS bf16*)(lds + VST_OFF + g * VST_WAVE);
    LAS float* ssl = (LAS float*)(lds + SS_OFF);
    LAS float* stg_c = stg + (4 * lg) * 68 + c16;
    LAS bf16* gst_c = gst + (4 * lg) * 64 + c16;
    LAS bf16* vst_c = vst + (4 * lg) * 64 + c16;
    LAS float* ssl_w = ssl + (4 * lg) * 8 + g;
    for (int unit = blockIdx.x; unit < NUNIT; unit += F.G) {
        const int b = unit >> 6, c = unit & 63; const size_t tok0 = (size_t)b * SEQ + 64 * c;
        v4u un[2][4]; v4u gn[2];
#define LRU_LOAD(ss_) do { const int ts_ = 64 * c + 16 * (ss_) + c16; const size_t row_ = tok0 + 16 * (ss_) + c16; \
            _Pragma("unroll") for (int s = 0; s < 2; ++s) _Pragma("unroll") for (int w = 0; w < 4; ++w) { \
                const bool ok_ = ts_ - 3 + w >= 0; const v4u x_ = *(const GAS v4u*)(Ug + (ok_ ? row_ - 3 + w : row_) * DL + 64 * g + 32 * s + 8 * lg);     \
                un[s][w] = ok_ ? x_ : (v4u){0u, 0u, 0u, 0u}; } \
            if (FINAL) { const bf16* gp_ = Gg + (tok0 + 16 * (ss_) + (l >> 2)) * DL + 64 * g + (l & 3) * 16; gn[0] = *(const GAS v4u*)gp_; gn[1] = *(const GAS v4u*)(gp_ + 8); } } while (0)
        LRU_LOAD(0);
        float hc[4], At[4];
#pragma unroll
        for (int t = 0; t < 4; ++t) { hc[t] = 0.f; At[t] = 1.f; }
        if (FINAL) {
#pragma unroll 4
            for (int cc = 0; cc < c; ++cc) {
#pragma unroll
                for (int t = 0; t < 4; ++t) { const f32x2 ab = *(const GAS f32x2*)(AGG + ((size_t)(b * 64 + cc) * 512 + 64 * g + 16 * t + c16) * 2); hc[t] = ab.x * hc[t] + ab.y; } }
        }
#pragma unroll
        for (int ss = 0; ss < 4; ++ss) {
            if (FINAL) { *(LAS v4u*)(gst + (l >> 2) * 64 + (l & 3) * 16) = gn[0]; *(LAS v4u*)(gst + (l >> 2) * 64 + (l & 3) * 16 + 8) = gn[1]; }
            bf16x8 af[2];
#pragma unroll
            for (int s = 0; s < 2; ++s) { const int cb = 64 * g + 32 * s + 8 * lg;
                f32x4 u0 = *(const LAS f32x4*)(convb + cb), u1 = *(const LAS f32x4*)(convb + cb + 4);
#pragma unroll
                for (int w = 0; w < 4; ++w) { const v4u x = un[s][w];
                    const f32x4 w0 = *(const LAS f32x4*)(convw + w * 512 + cb), w1 = *(const LAS f32x4*)(convw + w * 512 + cb + 4);
                    u0.x += w0.x * bflo(x.x); u0.y += w0.y * bfhi(x.x); u0.z += w0.z * bflo(x.y); u0.w += w0.w * bfhi(x.y);
                    u1.x += w1.x * bflo(x.z); u1.y += w1.y * bfhi(x.z); u1.z += w1.z * bflo(x.w); u1.w += w1.w * bfhi(x.w); }
                *(LAS f32x4*)(stg + c16 * 68 + 32 * s + 8 * lg) = u0; *(LAS f32x4*)(stg + c16 * 68 + 32 * s + 8 * lg + 4) = u1;
                v4u pw; pw.x = pk2(u0.x, u0.y); pw.y = pk2(u0.z, u0.w); pw.z = pk2(u1.x, u1.y); pw.w = pk2(u1.z, u1.w); af[s] = __builtin_bit_cast(bf16x8, pw); }
            if (ss < 3) LRU_LOAD(ss + 1);
            f32x4 acc[2][4];
#pragma unroll
            for (int gate = 0; gate < 2; ++gate)
#pragma unroll
                for (int t = 0; t < 4; ++t) { acc[gate][t] = (f32x4){0.f, 0.f, 0.f, 0.f};
#pragma unroll
                    for (int s = 0; s < 2; ++s) acc[gate][t] = __builtin_amdgcn_mfma_f32_16x16x32_bf16(af[s], wf[gate][t][s], acc[gate][t], 0, 0, 0); }
            float ssq[4] = {0.f, 0.f, 0.f, 0.f};
#pragma unroll
            for (int t = 0; t < 4; ++t) {
                float aj[4], bj[4], l2[4];
#pragma unroll
                for (int r = 0; r < 4; ++r) { const float uu = stg_c[r * 68 + 16 * t];
                    const float rr = __builtin_amdgcn_rcpf(1.0f + __builtin_amdgcn_exp2f(__builtin_fmaf(acc[0][t][r], -LOG2E, nba[t])));
                    const float ig = __builtin_amdgcn_rcpf(1.0f + __builtin_amdgcn_exp2f(__builtin_fmaf(acc[1][t][r], -LOG2E, nbx[t])));
                    l2[r] = rr * c2[t]; aj[r] = __builtin_amdgcn_exp2f(l2[r]);
                    bj[r] = __builtin_amdgcn_sqrtf(__builtin_fmaf(-aj[r], aj[r], 1.0f)) * (ig * uu); }
                if (!FINAL) {
                    const size_t lo = (((((size_t)unit * 8 + g) * 4 + ss) * 4 + t) * 64 + l) * 4;
                    *(GAS v2u*)(LAo + lo) = (v2u){pk2(l2[0], l2[1]), pk2(l2[2], l2[3])}; *(GAS v2u*)(BEo + lo) = (v2u){pk2(bj[0], bj[1]), pk2(bj[2], bj[3])}; }
                float hl[4], cum[4]; hl[0] = bj[0]; cum[0] = aj[0];
#pragma unroll
                for (int r = 1; r < 4; ++r) { hl[r] = aj[r] * hl[r - 1] + bj[r]; cum[r] = cum[r - 1] * aj[r]; }
                float A = cum[3], B = hl[3];
                float pA = __shfl(A, (l + 48) & 63), pB = __shfl(B, (l + 48) & 63);
                if (lg >= 1) { B = A * pB + B; A = A * pA; }
                pA = __shfl(A, (l + 32) & 63); pB = __shfl(B, (l + 32) & 63);
                if (lg >= 2) { B = A * pB + B; A = A * pA; }
                float eA = __shfl(A, (l + 48) & 63), eB = __shfl(B, (l + 48) & 63); if (lg == 0) { eA = 1.0f; eB = 0.0f; }
                const float hin = eA * hc[t] + eB;
                const float tA = __shfl(A, 48 + c16), tB = __shfl(B, 48 + c16);
                hc[t] = tA * hc[t] + tB; At[t] *= tA;
                if (FINAL) {
#pragma unroll
                    for (int r = 0; r < 4; ++r) { const float h = hl[r] + cum[r] * hin; const float gx = bf2f(gst_c[r * 64 + 16 * t]);
                        const float z2 = 1.5957691216057308f * (gx + 0.044715f * gx * gx * gx); const float vv = gx * sigmoidf_fast(z2) * h;
                        vst_c[(16 * ss + r) * 64 + 16 * t] = (bf16)f2bf(vv); ssq[r] += vv * vv; }
                }
            }
            if (FINAL) {
#pragma unroll
                for (int r = 0; r < 4; ++r) { float q = ssq[r]; q += __shfl_xor(q, 1); q += __shfl_xor(q, 2); q += __shfl_xor(q, 4); q += __shfl_xor(q, 8); if (c16 == 0) ssl_w[(16 * ss + r) * 8] = q; }
            }
        }
#undef LRU_LOAD
        if (!FINAL) {
            if (lg == 0) {
#pragma unroll
                for (int t = 0; t < 4; ++t) *(GAS f32x2*)(AGG + ((size_t)(b * 64 + c) * 512 + 64 * g + 16 * t + c16) * 2) = (f32x2){At[t], hc[t]}; }
        } else {
            LDS_WAIT(); __syncthreads();
            f32x4 gq[4];
#pragma unroll
            for (int j = 0; j < 4; ++j) gq[j] = ((const GAS f32x4*)(a.in[11] + layer * 512 + 64 * g + (l & 3) * 16))[j];
#pragma unroll
            for (int ss = 0; ss < 4; ++ss) { const int tl = 16 * ss + (l >> 2);
                const f32x4 s0 = *(const LAS f32x4*)(ssl + tl * 8), s1 = *(const LAS f32x4*)(ssl + tl * 8 + 4);
                const float rs = 1.0f / sqrtf(((s0.x + s0.y) + (s0.z + s0.w) + (s1.x + s1.y) + (s1.z + s1.w)) * (1.0f / DL) + RMS_EPS);
                const v4u y0 = *(const LAS v4u*)(vst + tl * 64 + (l & 3) * 16), y1 = *(const LAS v4u*)(vst + tl * 64 + (l & 3) * 16 + 8);
                v4u o0, o1;
                o0.x = pk2(bflo(y0.x) * rs * gq[0].x, bfhi(y0.x) * rs * gq[0].y); o0.y = pk2(bflo(y0.y) * rs * gq[0].z, bfhi(y0.y) * rs * gq[0].w);
                o0.z = pk2(bflo(y0.z) * rs * gq[1].x, bfhi(y0.z) * rs * gq[1].y); o0.w = pk2(bflo(y0.w) * rs * gq[1].z, bfhi(y0.w) * rs * gq[1].w);
                o1.x = pk2(bflo(y1.x) * rs * gq[2].x, bfhi(y1.x) * rs * gq[2].y); o1.y = pk2(bflo(y1.y) * rs * gq[2].z, bfhi(y1.y) * rs * gq[2].w);
                o1.z = pk2(bflo(y1.z) * rs * gq[3].x, bfhi(y1.z) * rs * gq[3].y); o1.w = pk2(bflo(y1.w) * rs * gq[3].z, bfhi(y1.w) * rs * gq[3].w);
                GAS v4u* dst = (GAS v4u*)(Y + (tok0 + tl) * D + DL + 64 * g + (l & 3) * 16); dst[0] = o0; dst[1] = o1; }
            __syncthreads();
        }
    }
}

__device__ __forceinline__ void lru_final_phase(Frame& F, const int layer, const Args& a, const bf16* Gg, const float* AGG, const bf16* LAi, const bf16* BEi, bf16* Y) {
    LAS unsigned char* lds = F.lds + RING_OFF;
    const int g = F.wave, l = F.lane;
    LAS unsigned char* tile = lds + g * FT_WAVE;
    LAS float* ssl = (LAS float*)(lds + NWAVES * FT_WAVE);
    f32x4 gq[2];
#pragma unroll
    for (int j = 0; j < 2; ++j) gq[j] = ((const GAS f32x4*)(a.in[11] + layer * 512 + 64 * g + (l & 7) * 8))[j];
    __syncthreads();
    for (int u0 = blockIdx.x, it = 0; u0 < NUNIT; u0 += F.G, ++it) {
        const int unit = (it & 1) ? (u0 ^ 63) : u0;
        const int b = unit >> 6, c = unit & 63; const size_t tok0 = (size_t)b * SEQ + 64 * c;
        v4u gr[8];
#pragma unroll
        for (int j = 0; j < 8; ++j) gr[j] = *(const GAS v4u*)(Gg + (tok0 + 8 * j + (l >> 3)) * DL + 64 * g + (l & 7) * 8);
        const GAS v2u* lap = (const GAS v2u*)(LAi + ((((size_t)unit * 8 + g) * 4) * 4 + (l >> 4)) * 256 + (l & 15) * 4); const GAS v2u* bep = (const GAS v2u*)(BEi + ((((size_t)unit * 8 + g) * 4) * 4 + (l >> 4)) * 256 + (l & 15) * 4);
        v2u la8[8], be8[8];
#pragma unroll
        for (int j = 0; j < 8; ++j) { la8[j] = lap[(j >> 2) * 4 * 64 + (j & 3) * 16]; be8[j] = bep[(j >> 2) * 4 * 64 + (j & 3) * 16]; }
        float h = 0.f;
        { const GAS f32x2* ap = (const GAS f32x2*)(AGG + ((size_t)(b * 64) * 512 + 64 * g + l) * 2);
          int cc = 0;
          for (; cc + 16 <= c; cc += 16) { f32x2 ab[16];
#pragma unroll
              for (int j = 0; j < 16; ++j) ab[j] = ap[(size_t)(cc + j) * 512];
#pragma unroll
              for (int j = 0; j < 16; ++j) h = ab[j].x * h + ab[j].y; }
          { f32x2 ab[16];
#pragma unroll
              for (int j = 0; j < 16; ++j) ab[j] = ap[(size_t)((cc + j < c) ? cc + j : 0) * 512];
#pragma unroll
              for (int j = 0; j < 16; ++j) if (cc + j < c) h = ab[j].x * h + ab[j].y; } }
#pragma unroll
        for (int j = 0; j < 8; ++j) *(LAS v4u*)(tile + (8 * j + (l >> 3)) * FT_PITCH + (l & 7) * 16) = gr[j];
        LAS bf16* col = (LAS bf16*)(tile + 2 * l);
#pragma unroll
        for (int half = 0; half < 2; ++half) {
            if (half == 1) {
#pragma unroll
                for (int j = 0; j < 8; ++j) { la8[j] = lap[(2 + (j >> 2)) * 4 * 64 + (j & 3) * 16]; be8[j] = bep[(2 + (j >> 2)) * 4 * 64 + (j & 3) * 16]; } }
#pragma unroll
            for (int j = 0; j < 8; ++j)
#pragma unroll
                for (int e = 0; e < 4; ++e) { const int tt = 32 * half + 4 * j + e; const unsigned lw = la8[j][e >> 1], bw = be8[j][e >> 1];
                    const float l2 = (e & 1) ? bfhi(lw) : bflo(lw), be = (e & 1) ? bfhi(bw) : bflo(bw);
                    h = __builtin_amdgcn_exp2f(l2) * h + be;
                    const float gx = bf2f(col[tt * (FT_PITCH / 2)]);
                    const float z2 = 1.5957691216057308f * (gx + 0.044715f * gx * gx * gx);
                    col[tt * (FT_PITCH / 2)] = (bf16)pk2(gx * sigmoidf_fast(z2) * h, 0.f); }
        }
        { float q = 0.f;
#pragma unroll
          for (int j = 0; j < 8; ++j) { const v4u y = *(const LAS v4u*)(tile + l * FT_PITCH + 16 * j);
#pragma unroll
              for (int e = 0; e < 4; ++e) { const float x0 = bflo(y[e]), x1 = bfhi(y[e]); q += x0 * x0 + x1 * x1; } }
          ssl[l * 8 + g] = q; }
        LDS_WAIT(); __syncthreads();
#pragma unroll
        for (int j = 0; j < 8; ++j) { const int tl = 8 * j + (l >> 3);
            const f32x4 s0 = *(const LAS f32x4*)(ssl + tl * 8), s1 = *(const LAS f32x4*)(ssl + tl * 8 + 4);
            const float rs = 1.0f / sqrtf(((s0.x + s0.y) + (s0.z + s0.w) + (s1.x + s1.y) + (s1.z + s1.w)) * (1.0f / DL) + RMS_EPS);
            const v4u y = *(const LAS v4u*)(tile + tl * FT_PITCH + (l & 7) * 16);
            v4u o; o.x = pk2(bflo(y.x) * rs * gq[0].x, bfhi(y.x) * rs * gq[0].y); o.y = pk2(bflo(y.y) * rs * gq[0].z, bfhi(y.y) * rs * gq[0].w);
            o.z = pk2(bflo(y.z) * rs * gq[1].x, bfhi(y.z) * rs * gq[1].y); o.w = pk2(bflo(y.w) * rs * gq[1].z, bfhi(y.w) * rs * gq[1].w);
            *(GAS v4u*)(Y + (tok0 + tl) * D + DL + 64 * g + (l & 7) * 8) = o; }
        __syncthreads();
    }
}
}

#define PB_BEGIN(k) do { F.lane = fresh_lane(); if (PROBE_MASK && ((PROBE_MASK >> (k)) & 1ull)) F.pt0 = rt(); } while (0)
#define PB_END(k) do { if (PROBE_MASK && ((PROBE_MASK >> (k)) & 1ull)) F.pacc += rt() - F.pt0; } while (0)
#define IN(k) (lo <= (k) && (k) < hi)
#define SEAM(k) do { if (IN(k) && IN((k) + 1)) { if ((PROBE_MASK & (1ull << 37)) && (PROBE_SEAM < 0 || PROBE_SEAM == (k))) { const unsigned long long t_ = rt(); xcd_barrier(bar); F.pacc += rt() - t_; } else xcd_barrier(bar); } } while (0)
template <int layer>
__device__ __forceinline__ void run_layer(Frame& F, const Args& args, const XcdBarrier& bar, const int lo, const int hi) {
    unsigned char* ws = args.ws; bf16* XBp = (bf16*)(ws + WS_XB);
        const int pb = layer ? PH_L1 : PH_L0;
        PB_BEGIN(pb + 0);
        if (IN(pb + 0)) {
            pg8::Gemm g{XBp, (const bf16*)(ws + WS_WIN) + (size_t)layer * DIN * D, M, DIN, D}; pg8::StaticOrder S; S.init(M, DIN, F.G, (int)blockIdx.x);
            pg8::EpiBf16<0> E{(bf16*)(ws + WS_Q), DA, nullptr, DA, (size_t)M * DA, QSCALE};
            pg8::gemm_phase<pg8::EpiBf16<0>, pg8::StaticOrder, true, true>(F.lds + RING_OFF, g, S, E);
        }
        SEAM(pb + 0);
        PB_END(pb + 0);
        PB_BEGIN(pb + 1);
        if (IN(pb + 1)) { PB_BEGIN(27); att::attn_phase(F, (const bf16*)(ws + WS_Q), (const bf16*)(ws + WS_K), (const bf16*)(ws + WS_V), args.in[9], (bf16*)(ws + WS_O0), (bf16*)(ws + WS_O1), (bf16*)(ws + WS_O2), (float*)(ws + WS_LSE)); PB_END(27);
            PB_BEGIN(28); lru::lru_phase<false>(F, layer, args, (const bf16*)(ws + WS_U), (const bf16*)(ws + WS_G), (float*)(ws + WS_AGG), nullptr, (bf16*)(ws + WS_LA), (bf16*)(ws + WS_BE)); PB_END(28); }
        SEAM(pb + 1);
        PB_END(pb + 1);
        PB_BEGIN(pb + 2);
        if (IN(pb + 2)) { PB_BEGIN(29); att::merge_attn_phase(F, (const bf16*)(ws + WS_O0), (const bf16*)(ws + WS_O1), (const bf16*)(ws + WS_O2), (const float*)(ws + WS_LSE), args.in[10] + layer * DA, (bf16*)(ws + WS_Y)); PB_END(29);
            PB_BEGIN(30); lru::lru_final_phase(F, layer, args, (const bf16*)(ws + WS_G), (const float*)(ws + WS_AGG), (const bf16*)(ws + WS_LA), (const bf16*)(ws + WS_BE), (bf16*)(ws + WS_Y)); PB_END(30); }
        SEAM(pb + 2);
        PB_END(pb + 2);
        PB_BEGIN(pb + 3);
        if (IN(pb + 3)) {
            pg8::Gemm g{(const bf16*)(ws + WS_Y), (const bf16*)(ws + WS_WOUT) + (size_t)layer * D * D, M, D, D}; pg8::StaticOrder S; S.init(M, D, F.G, (int)blockIdx.x);
            pg8::EpiResBf16 E{XBp, XBp, D, ALPHA, 1.0f};
            pg8::gemm_phase<pg8::EpiResBf16, pg8::StaticOrder, true, true>(F.lds + RING_OFF, g, S, E);
        }
        SEAM(pb + 3);
        PB_END(pb + 3);
        PB_BEGIN(pb + 4);
        if (IN(pb + 4)) {
            if (layer == 0) phase_ln<false>(F, XBp, args.in[13], args.in[14], nullptr, nullptr, nullptr);
            else { phase_ln<true>(F, XBp, args.in[13] + D, args.in[14] + D, args.in[20], (int*)(ws + WS_TOKE), (float*)(ws + WS_TOKP)); PB_BEGIN(26); phase_moe_cvt(F, args); PB_END(26); }
        }
        SEAM(pb + 4);
        PB_END(pb + 4);
        if (layer == 0) {
            PB_BEGIN(pb + 5);
            if (IN(pb + 5)) {
                pg8::Gemm g{XBp, (const bf16*)(ws + WS_WGU), M, 2 * DFF, D}; pg8::StaticOrder S; S.init(M, 2 * DFF, F.G, (int)blockIdx.x);
                pg8::EpiSwiGLU8 E{ws + WS_HB, DFF, 1.0f, MOE_HSCALE};
                pg8::gemm_phase<pg8::EpiSwiGLU8, pg8::StaticOrder, true, true>(F.lds + RING_OFF, g, S, E);
            }
            SEAM(pb + 5);
            PB_END(pb + 5);
            PB_BEGIN(pb + 6);
            if (IN(pb + 6)) {
                pg8::Gemm g{(const bf16*)(ws + WS_HB), (const bf16*)(ws + WS_WD), M, D, DFF / 2}; pg8::StaticOrder S; S.init(M, D, F.G, (int)blockIdx.x);
                pg8::EpiResBf16 E{XBp, XBp, D, ALPHA, 1.0f / (MOE_HSCALE * MOE_DSCALE)};
                pg8::gemm_phase<pg8::EpiResBf16, pg8::StaticOrder, true, true, true>(F.lds + RING_OFF, g, S, E);
            }
            SEAM(pb + 6);
            PB_END(pb + 6);
            PB_BEGIN(pb + 7);
            if (IN(pb + 7)) phase_ln<false>(F, XBp, args.in[15], args.in[16], nullptr, nullptr, nullptr);
            SEAM(pb + 7);
            PB_END(pb + 7);
        }
}

__global__ void __launch_bounds__(NWAVES * 64, 2) fwd(Args args) {
    extern __shared__ __attribute__((aligned(16))) unsigned char lds[];
    Frame F;
    F.lds = (LAS unsigned char*)lds;
    F.MISC = (volatile LAS unsigned*)(F.lds + MISC_OFF);
    F.tid = threadIdx.x; F.lane = F.tid & 63; F.wave = __builtin_amdgcn_readfirstlane(F.tid >> 6);
    F.pt0 = 0ull; F.pacc = 0ull;
    F.G = gridDim.x; { const int bx = blockIdx.x; F.vcu = (F.G % 8 == 0) ? (bx % 8) * (F.G / 8) + bx / 8 : bx; }
    unsigned char* ws = args.ws;
    F.ctl = (gu32*)(ws + WS_CTL);
    for (int u = F.tid; u < (LDS_BYTES - LDSCTL_OFF) / 4; u += NWAVES * 64) ((LAS unsigned*)(F.lds + LDSCTL_OFF))[u] = 0u;
    __syncthreads();
    const int lo = args.ph_lo, hi = args.ph_hi;
    const bool use_bar = (hi - lo) > 1;
    XcdBarrier bar; bar.bar = (unsigned*)(F.ctl + CW_BAR) + args.li * XCD_BAR_WORDS; bar.x = 0; bar.st = nullptr;
    if (use_bar) bar = xcd_barrier_post((unsigned*)(F.ctl + CW_BAR) + args.li * XCD_BAR_WORDS, F.MISC + 8);
    float* out = args.out;
    bf16* XBp = (bf16*)(ws + WS_XB);

    PB_BEGIN(PH_PRO);
    if (IN(PH_PRO)) phase_prologue(F, args);
    SEAM(PH_PRO);
    PB_END(PH_PRO);

    run_layer<0>(F, args, bar, lo, hi);
    run_layer<1>(F, args, bar, lo, hi);
    PB_BEGIN(PH_DISPATCH);
    if (IN(PH_DISPATCH)) phase_dispatch(F, (const int*)(ws + WS_TOKE), (int*)(ws + WS_TOKPOS), (int*)(ws + WS_SEG), XBp, ws + WS_XS8);
    SEAM(PH_DISPATCH);
    PB_END(PH_DISPATCH);
    for (int c = 0; c < NCHUNK - 1; ++c) {
        const int pg = PH_MOE0 + 2 * c;
        if (IN(pg) || IN(pg + 1)) {
            pg8::MoeOrder S; S.G = F.G; S.c = (int)blockIdx.x; S.base = c * CHUNK_TILES;
            const GAS int* st = (const GAS int*)(ws + WS_SEG);
#pragma unroll
            for (int k = 0; k < 9; ++k) S.segt[k] = __builtin_amdgcn_readfirstlane(st[k]);
            const int nT = S.segt[8]; S.nrows = nT - S.base; if (S.nrows > CHUNK_TILES) S.nrows = CHUNK_TILES; if (S.nrows < 0) S.nrows = 0;
            unsigned char* HCv = (unsigned char*)out - (size_t)S.base * 256 * DFE;
            S.split_pm = -1; S.adiff = 0;
            PB_BEGIN(pg);
            if (IN(pg)) {
                S.nN = 2 * DFE / 256; S.estride_b = (size_t)2 * DFE * D;
                pg8::Gemm g{(const bf16*)(ws + WS_XS8), (const bf16*)(ws + WS_MGU), SORT_ROWS, 2 * DFE, D / 2};
                pg8::EpiSwiGLU8 E{HCv, DFE, 1.0f / MOE_WSCALE, MOE_HSCALE};
                pg8::gemm_phase<pg8::EpiSwiGLU8, pg8::MoeOrder, true, true, true>(F.lds + RING_OFF, g, S, E);
            }
            SEAM(pg);
            PB_END(pg);
            PB_BEGIN(pg + 1);
            if (IN(pg + 1)) {
                S.nN = D / 256; S.estride_b = (size_t)D * DFE;
                pg8::Gemm g{(const bf16*)HCv, (const bf16*)(ws + WS_MD), SORT_ROWS, D, DFE / 2};
                pg8::EpiBf16S E{(bf16*)(ws + WS_YS), D, 1.0f / (MOE_HSCALE * MOE_DSCALE)};
                pg8::gemm_phase<pg8::EpiBf16S, pg8::MoeOrder, true, true, true>(F.lds + RING_OFF, g, S, E);
            }
            SEAM(pg + 1);
            PB_END(pg + 1);
        }
    }
    {
        constexpr int pg = PH_MOE0 + 2 * (NCHUNK - 1), TAIL_ROW0 = (NCHUNK - 1) * CHUNK_TILES * 256;
        pg8::MoeOrder S; S.G = F.G; S.c = (int)blockIdx.x; S.base = (NCHUNK - 1) * CHUNK_TILES; S.nrows = 0; S.split_pm = -1; S.adiff = 0;
        unsigned char* HCv = ws + WS_HCA - (size_t)S.base * 256 * DFE;
        if (IN(pg) || IN(pg + 1)) {
            const GAS int* st = (const GAS int*)(ws + WS_SEG);
#pragma unroll
            for (int k = 0; k < 9; ++k) S.segt[k] = __builtin_amdgcn_readfirstlane(st[k]);
            S.nrows = S.segt[8] - S.base; if (S.nrows > CHUNK_TILES) S.nrows = CHUNK_TILES; if (S.nrows < 0) S.nrows = 0;
        }
        PB_BEGIN(pg);
        if (IN(pg)) {
            S.nN = 2 * DFE / 256; S.estride_b = (size_t)2 * DFE * D;
            pg8::Gemm g{(const bf16*)(ws + WS_XS8), (const bf16*)(ws + WS_MGU), SORT_ROWS, 2 * DFE, D / 2};
            pg8::EpiSwiGLU8 E{HCv, DFE, 1.0f / MOE_WSCALE, MOE_HSCALE};
            pg8::gemm_phase<pg8::EpiSwiGLU8, pg8::MoeOrder, true, true, true>(F.lds + RING_OFF, g, S, E);
        }
        SEAM(pg);
        PB_END(pg);
        PB_BEGIN(pg + 1);
        if (IN(pg + 1)) {
            {
                pg8::MoeSplitK S2; S2.base = S.base; S2.nrows = S.nrows; S2.nN = D / 256; S2.nS = TAIL_NS; S2.KS = TAIL_KS / 2; S2.G = F.G; S2.c = (int)blockIdx.x; S2.estride_b = (size_t)D * DFE;
#pragma unroll
                for (int k2 = 0; k2 < 9; ++k2) S2.segt[k2] = S.segt[k2];
                pg8::Gemm g{(const bf16*)HCv, (const bf16*)(ws + WS_MD), SORT_ROWS, D, TAIL_KS / 2, DFE / 2};
                pg8::EpiPart E{(bf16*)(ws + WS_PART), D, S.base, TAIL_TILES, 1.0f / (MOE_HSCALE * MOE_DSCALE)};
                pg8::gemm_phase<pg8::EpiPart, pg8::MoeSplitK, true, true, true>(F.lds + RING_OFF, g, S2, E);
            }
            phase_combine(F, XBp, out, (const bf16*)(ws + WS_YS), (const int*)(ws + WS_TOKPOS), (const float*)(ws + WS_TOKP), args.in[15] + D, args.in[16] + D, (const bf16*)(ws + WS_PART), 1, TAIL_ROW0, F.vcu * NWAVES + F.wave, F.G * NWAVES);
        }
        SEAM(pg + 1);
        PB_END(pg + 1);
        PB_BEGIN(PH_COMBINE);
        if (IN(PH_COMBINE)) phase_combine(F, XBp, out, (const bf16*)(ws + WS_YS), (const int*)(ws + WS_TOKPOS), (const float*)(ws + WS_TOKP), args.in[15] + D, args.in[16] + D, (const bf16*)(ws + WS_PART), 2, TAIL_ROW0, F.vcu * NWAVES + F.wave, F.G * NWAVES);
        PB_END(PH_COMBINE);
        if (PROBE_MASK && blockIdx.x == 0 && F.tid == 0) { const unsigned long long te = rt() + (unsigned long long)PROBE_K * F.pacc; while (rt() < te) __builtin_amdgcn_s_sleep(8); }
    }
#undef IN
#undef SEAM
}

extern "C" void kernel_launch(void* const* d_in, const int* in_sizes, int n_in, void* d_out, int out_size, void* d_ws, size_t ws_size, hipStream_t stream) {
    static int grid = 0;
    if (grid == 0) {
        if (n_in != 24 || in_sizes[0] != M * D || out_size != M * D || ws_size < WS_END) { fprintf(stderr, "kernel_launch: unexpected problem (n_in %d, out %d, ws %zu < %zu)\n", n_in, out_size, ws_size, (size_t)WS_END); grid = -1; return; }
        int dev = 0, cus = 0, per_cu = 0;
        if (hipGetDevice(&dev) != hipSuccess || hipDeviceGetAttribute(&cus, hipDeviceAttributeMultiprocessorCount, dev) != hipSuccess) { grid = -1; return; }
        if (hipFuncSetAttribute((const void*)fwd, hipFuncAttributeMaxDynamicSharedMemorySize, LDS_BYTES) != hipSuccess) { fprintf(stderr, "kernel_launch: hipFuncSetAttribute failed\n"); grid = -1; return; }
        if (hipOccupancyMaxActiveBlocksPerMultiprocessor(&per_cu, (const void*)fwd, NWAVES * 64, LDS_BYTES) != hipSuccess || per_cu < 1) fprintf(stderr, "kernel_launch: occupancy query says %d\n", per_cu);
        (void)hipGetLastError();
        grid = cus;
    }
    if (grid < 0) return;
    (void)hipMemsetAsync((char*)d_ws + WS_CTL, 0, CTL_ZERO_BYTES, stream);
    Args a{};
    for (int i = 0; i < 24; ++i) a.in[i] = (const float*)d_in[i];
    a.out = (float*)d_out; a.ws = (unsigned char*)d_ws;
    int li = 0;
    auto launch = [&](int lo, int hi) { a.ph_lo = lo; a.ph_hi = hi; a.li = li++; hipLaunchKernelGGL(fwd, dim3(grid), dim3(NWAVES * 64), LDS_BYTES, stream, a); };
    auto each = [&](int lo, int hi) { for (int p = lo; p < hi; ++p) launch(p, p + 1); };
#if defined(MK_PER_PHASE)
    each(PH_PRO, NPH);
#else
    launch(PH_PRO, NPH);
#endif
}
```

```cpp
#include <hip/hip_runtime.h>
#include <cstdio>
#include <cstdint>
#include <cmath>
namespace pg8 {
#define PG8_LAS __attribute__((address_space(3)))
typedef unsigned short bf16_t;
typedef short bf16x8 __attribute__((ext_vector_type(8)));
typedef float f32x4 __attribute__((ext_vector_type(4)));
typedef unsigned u32x4 __attribute__((ext_vector_type(4)));
typedef int i32x4 __attribute__((ext_vector_type(4)));
typedef int i32x8 __attribute__((ext_vector_type(8)));
constexpr int BM = 256, BK = 64, HALF = 128, HTB = HALF * BK * 2  , STAGE_BYTES = 8 * HTB, NXCD = 8, WGM = 8;

__host__ __device__ __forceinline__ int lds_byte(int r, int c) { const int st = (r >> 4) * 2 + (c >> 5), rr = r & 15, cc = c & 31, ob = rr * 64 + cc * 2; return st * 1024 + (ob ^ (((ob >> 9) & 1) << 5)); }
__host__ __device__ __forceinline__ void stage_rc(int b, int& R, int& C) { const int st = b / 1024, sb = b % 1024, swz = sb ^ (((sb >> 9) & 1) << 5); R = (st >> 1) * 16 + swz / 64; C = (st & 1) * 32 + (swz % 64) / 2; }
__host__ __device__ __forceinline__ int perm32(int rho) { const int n = rho >> 4, i = rho & 15; return 8 * (i >> 2) + 4 * n + (i & 3); }

struct Unit { int pm, pn; size_t boffb, aoffb; int ks; };
struct Gemm { const bf16_t* A; const bf16_t* Bt; int M, N, K; int ld; };

struct StaticOrder {
    int nM, nN, nwg, G, c;
    __host__ __device__ void init(int M, int N, int G_, int c_) { nM = M / BM; nN = N / BM; nwg = nM * nN; G = G_; c = c_; }
    __host__ __device__ void map(int wgid, Unit& u) const {
        { const int q = nwg / NXCD, r = nwg % NXCD, xcd = wgid % NXCD, off = wgid / NXCD; wgid = (xcd < r ? xcd * (q + 1) : r * (q + 1) + (xcd - r) * q) + off; }
        const int nig = WGM * nN, gid = wgid / nig, fm = gid * WGM, gsz = (nM - fm) < WGM ? (nM - fm) : WGM;
        u.pm = fm + ((wgid % nig) % gsz); u.pn = (wgid % nig) / gsz; u.boffb = 0; u.aoffb = 0; u.ks = 0;
    }
    __host__ __device__ bool next(int i, Unit& u) const {
        const long L = (long)i * G + c; if (L >= nwg) return false;
        map((int)L, u); return true;
    }
    __device__ __forceinline__ void a_ready(const Unit&) const {}
    __device__ __forceinline__ void done(const Unit&) const {}
};
struct SplitOrder {
    StaticOrder so; int ncv, rskip; bool late;
    __device__ __forceinline__ bool next(int i, Unit& u) const {
        const int ge = so.G - ncv; long L;
        if (late) L = (long)rskip * ge + (long)i * so.G + so.c;
        else L = (i < rskip) ? (long)i * ge + so.c : (long)rskip * ge + (long)(i - rskip) * so.G + so.c;
        if (L >= so.nwg) return false;
        so.map((int)L, u); return true;
    }
    __device__ __forceinline__ void a_ready(const Unit&) const {}
    __device__ __forceinline__ void done(const Unit&) const {}
};

__device__ __forceinline__ unsigned cvt_pk_bf16(float lo, float hi) { unsigned r; asm volatile("v_cvt_pk_bf16_f32 %0, %1, %2" : "=v"(r) : "v"(lo), "v"(hi)); return r; }
typedef float f32x2 __attribute__((ext_vector_type(2)));
__device__ __forceinline__ f32x2 gelu_pk(f32x2 v) {
    const f32x2 av = __builtin_elementwise_abs(v), d = av * 0.2316418882f + 1.0f;
    f32x2 t; t.x = __builtin_amdgcn_rcpf(d.x); t.y = __builtin_amdgcn_rcpf(d.y);
    f32x2 q = t * 0.5307027145f + (-0.7265760135f); q = q * t + 0.7107068705f; q = q * t + (-0.142248368f); q = q * t + 0.127414796f; q = q * t;
    const f32x2 s = (v * v) * (-0.72134752044f);
    f32x2 e; e.x = __builtin_amdgcn_exp2f(s.x); e.y = __builtin_amdgcn_exp2f(s.y);
    const f32x2 m = v * (q * e), r = v - m;
    f32x2 o; o.x = v.x < 0.f ? m.x : r.x; o.y = v.y < 0.f ? m.y : r.y; return o;
}

template <int ACT  > struct EpiBf16 {
    static constexpr bool PERM = true, AFTER_DRAIN = false; static_assert(ACT == 0 || ACT == 1, "EpiBf16: ACT is 0 (none) or 1 (gelu_pk)");
    bf16_t* O; int ldc; const float* bias; int split_cols; size_t split_stride; float scale0;
    __device__ __forceinline__ void operator()(const f32x4 (&acc)[2][2][4][2], const Unit& u, int wr, int wc, int fr, int fq) const {
        const int row0 = u.pm * BM + wr * 64 + fr; int colt = u.pn * BM; bf16_t* base = O;
        float sc = 1.f; if (split_cols) { const int t = colt / split_cols; base += (size_t)t * split_stride; colt -= t * split_cols; if (t == 0) sc = scale0; }
        const int col0 = colt + wc * 32 + 8 * fq, bcol0 = u.pn * BM + wc * 32 + 8 * fq;
        f32x4 bv[2][2];
#pragma unroll
        for (int bj = 0; bj < 2; ++bj)
#pragma unroll
            for (int n = 0; n < 2; ++n) bv[bj][n] = bias ? *(const f32x4*)(bias + bcol0 + bj * HALF + 4 * n) : (f32x4){0.f, 0.f, 0.f, 0.f};
#pragma unroll
        for (int ai = 0; ai < 2; ++ai)
#pragma unroll
            for (int m = 0; m < 4; ++m) { bf16_t* rowp = base + (size_t)(row0 + ai * HALF + m * 16) * ldc + col0;
#pragma unroll
                for (int bj = 0; bj < 2; ++bj) { f32x4 v0 = acc[ai][bj][m][0] + bv[bj][0], v1 = acc[ai][bj][m][1] + bv[bj][1];
                    if (ACT == 1) { f32x2 a = gelu_pk((f32x2){v0[0], v0[1]}), b = gelu_pk((f32x2){v0[2], v0[3]}), c = gelu_pk((f32x2){v1[0], v1[1]}), d = gelu_pk((f32x2){v1[2], v1[3]});
                        v0 = (f32x4){a.x, a.y, b.x, b.y}; v1 = (f32x4){c.x, c.y, d.x, d.y}; }
                    v0 = v0 * sc; v1 = v1 * sc; u32x4 w; w.x = cvt_pk_bf16(v0[0], v0[1]); w.y = cvt_pk_bf16(v0[2], v0[3]); w.z = cvt_pk_bf16(v1[0], v1[1]); w.w = cvt_pk_bf16(v1[2], v1[3]);
                    *(u32x4*)(rowp + bj * HALF) = w; } }
    }
};

struct EpiSwiGLU {
    static constexpr bool PERM = true, AFTER_DRAIN = false;
    bf16_t* O; int ldc; bf16_t* O2; int split_pm; float wscale;
    __device__ __forceinline__ static float silu_mul(float g, float u) { return g * __builtin_amdgcn_rcpf(1.0f + __builtin_amdgcn_exp2f(g * -1.4426950408889634f)) * u; }
    __device__ __forceinline__ void operator()(const f32x4 (&acc)[2][2][4][2], const Unit& u, int wr, int wc, int fr, int fq) const {
        const int row0 = u.pm * BM + wr * 64 + fr, col0 = u.pn * HALF + wc * 32 + 8 * fq;
#pragma unroll
        for (int ai = 0; ai < 2; ++ai)
#pragma unroll
            for (int m = 0; m < 4; ++m) { bf16_t* rowp = ((split_pm >= 0 && u.pm >= split_pm) ? O2 : O) + (size_t)(row0 + ai * HALF + m * 16) * ldc + col0;
                const f32x4 g0 = acc[ai][0][m][0] * wscale, g1 = acc[ai][0][m][1] * wscale, u0 = acc[ai][1][m][0] * wscale, u1 = acc[ai][1][m][1] * wscale;
                u32x4 w; w.x = cvt_pk_bf16(silu_mul(g0[0], u0[0]), silu_mul(g0[1], u0[1])); w.y = cvt_pk_bf16(silu_mul(g0[2], u0[2]), silu_mul(g0[3], u0[3]));
                w.z = cvt_pk_bf16(silu_mul(g1[0], u1[0]), silu_mul(g1[1], u1[1])); w.w = cvt_pk_bf16(silu_mul(g1[2], u1[2]), silu_mul(g1[3], u1[3]));
                *(u32x4*)rowp = w; }
    }
};
struct EpiResF32 {
    static constexpr bool PERM = false, AFTER_DRAIN = false;
    const float* R; float* out; int ldc; float alpha;
    __device__ __forceinline__ void operator()(const f32x4 (&acc)[2][2][4][2], const Unit& u, int wr, int wc, int fr, int fq) const {
        const int col0 = u.pn * BM + wc * 32 + 4 * fq;
#pragma unroll
        for (int ai = 0; ai < 2; ++ai)
#pragma unroll
            for (int m = 0; m < 4; ++m) { const size_t off = (size_t)(u.pm * BM + ai * HALF + wr * 64 + m * 16 + fr) * ldc + col0;
#pragma unroll
                for (int bj = 0; bj < 2; ++bj)
#pragma unroll
                    for (int n = 0; n < 2; ++n) { const f32x4 rs = *(const f32x4*)(R + off + bj * HALF + n * 16); *(f32x4*)(out + off + bj * HALF + n * 16) = rs * alpha + acc[ai][bj][m][n]; }
                if (m & 1) asm volatile("" ::: "memory"); }
    }
};
__device__ __forceinline__ unsigned pk4_e4m3(float a, float b, float c, float d) {
    a = __builtin_amdgcn_fmed3f(a, -448.f, 448.f); b = __builtin_amdgcn_fmed3f(b, -448.f, 448.f); c = __builtin_amdgcn_fmed3f(c, -448.f, 448.f); d = __builtin_amdgcn_fmed3f(d, -448.f, 448.f);
    unsigned w = 0u; w = __builtin_amdgcn_cvt_pk_fp8_f32(a, b, w, false); w = __builtin_amdgcn_cvt_pk_fp8_f32(c, d, w, true); return w;
}
struct EpiSwiGLU8 {
    static constexpr bool PERM = true, AFTER_DRAIN = false;
    unsigned char* O; int ldc; float wscale, hscale;
    __device__ __forceinline__ void operator()(const f32x4 (&acc)[2][2][4][2], const Unit& u, int wr, int wc, int fr, int fq) const {
        const int row0 = u.pm * BM + wr * 64 + fr, col0 = u.pn * HALF + wc * 32 + 8 * fq;
        typedef unsigned u32x2 __attribute__((ext_vector_type(2)));
#pragma unroll
        for (int ai = 0; ai < 2; ++ai)
#pragma unroll
            for (int m = 0; m < 4; ++m) { unsigned char* rowp = O + (size_t)(row0 + ai * HALF + m * 16) * ldc + col0;
                const float c1 = -1.4426950408889634f * wscale, ik = 1.0f / (wscale * wscale * hscale);
                f32x4 hv[2];
#pragma unroll
                for (int n = 0; n < 2; ++n) { const f32x4 ag = acc[ai][0][m][n], au = acc[ai][1][m][n], t = ag * c1;
                    f32x4 e; e[0] = __builtin_amdgcn_exp2f(t[0]); e[1] = __builtin_amdgcn_exp2f(t[1]); e[2] = __builtin_amdgcn_exp2f(t[2]); e[3] = __builtin_amdgcn_exp2f(t[3]);
                    const f32x4 d = e * ik + ik;
                    f32x4 r; r[0] = __builtin_amdgcn_rcpf(d[0]); r[1] = __builtin_amdgcn_rcpf(d[1]); r[2] = __builtin_amdgcn_rcpf(d[2]); r[3] = __builtin_amdgcn_rcpf(d[3]);
                    hv[n] = (ag * au) * r; }
                u32x2 w; w.x = pk4_e4m3(hv[0][0], hv[0][1], hv[0][2], hv[0][3]); w.y = pk4_e4m3(hv[1][0], hv[1][1], hv[1][2], hv[1][3]);
                *(u32x2*)rowp = w; }
    }
};
struct EpiBf16S {
    static constexpr bool PERM = true, AFTER_DRAIN = false;
    bf16_t* O; int ldc; float s;
    __device__ __forceinline__ void operator()(const f32x4 (&acc)[2][2][4][2], const Unit& u, int wr, int wc, int fr, int fq) const {
        const int row0 = u.pm * BM + wr * 64 + fr, col0 = u.pn * BM + wc * 32 + 8 * fq;
#pragma unroll
        for (int ai = 0; ai < 2; ++ai)
#pragma unroll
            for (int m = 0; m < 4; ++m) { bf16_t* rowp = O + (size_t)(row0 + ai * HALF + m * 16) * ldc + col0;
#pragma unroll
                for (int bj = 0; bj < 2; ++bj) { const f32x4 v0 = acc[ai][bj][m][0] * s, v1 = acc[ai][bj][m][1] * s;
                    u32x4 w; w.x = cvt_pk_bf16(v0[0], v0[1]); w.y = cvt_pk_bf16(v0[2], v0[3]); w.z = cvt_pk_bf16(v1[0], v1[1]); w.w = cvt_pk_bf16(v1[2], v1[3]);
                    *(u32x4*)(rowp + bj * HALF) = w; } }
    }
};
struct EpiResBf16 {
    static constexpr bool PERM = true, AFTER_DRAIN = false;
    const bf16_t* R; bf16_t* out; int ldc; float alpha; float s;
    __device__ __forceinline__ void operator()(const f32x4 (&acc)[2][2][4][2], const Unit& u, int wr, int wc, int fr, int fq) const {
        const int row0 = u.pm * BM + wr * 64 + fr, col0 = u.pn * BM + wc * 32 + 8 * fq;
        u32x4 rv[2][4][2];
#pragma unroll
        for (int ai = 0; ai < 2; ++ai)
#pragma unroll
            for (int m = 0; m < 4; ++m)
#pragma unroll
                for (int bj = 0; bj < 2; ++bj) rv[ai][m][bj] = *(const u32x4*)(R + (size_t)(row0 + ai * HALF + m * 16) * ldc + col0 + bj * HALF);
#pragma unroll
        for (int ai = 0; ai < 2; ++ai)
#pragma unroll
            for (int m = 0; m < 4; ++m) { const size_t off = (size_t)(row0 + ai * HALF + m * 16) * ldc + col0;
#pragma unroll
                for (int bj = 0; bj < 2; ++bj) { const u32x4 r = rv[ai][m][bj]; const f32x4 v0 = acc[ai][bj][m][0] * s, v1 = acc[ai][bj][m][1] * s;
                    u32x4 w;
                    w.x = cvt_pk_bf16(alpha * __uint_as_float(r.x << 16) + v0[0], alpha * __uint_as_float(r.x & 0xffff0000u) + v0[1]);
                    w.y = cvt_pk_bf16(alpha * __uint_as_float(r.y << 16) + v0[2], alpha * __uint_as_float(r.y & 0xffff0000u) + v0[3]);
                    w.z = cvt_pk_bf16(alpha * __uint_as_float(r.z << 16) + v1[0], alpha * __uint_as_float(r.z & 0xffff0000u) + v1[1]);
                    w.w = cvt_pk_bf16(alpha * __uint_as_float(r.w << 16) + v1[2], alpha * __uint_as_float(r.w & 0xffff0000u) + v1[3]);
                    *(u32x4*)(out + off + bj * HALF) = w; } }
    }
};
constexpr int MOE_SUB = 64;
struct MoeOrder {
    int base, nrows, nN, G, c; int segt[9]; size_t estride_b; int split_pm; size_t adiff;
    __device__ __forceinline__ bool next(int i, Unit& u) const {
        const long L = (long)i * G + c; if (L >= (long)nrows * nN) return false;
        if (nrows % MOE_SUB) { u.pm = base + (int)(L % nrows); u.pn = (int)(L / nrows); }
        else { const int per = MOE_SUB * nN, sc = (int)(L / per), Lr = (int)(L % per); u.pm = base + sc * MOE_SUB + Lr % MOE_SUB; u.pn = Lr / MOE_SUB; }
        int e = 0;
#pragma unroll
        for (int k = 1; k < 8; ++k) e += (u.pm >= segt[k]) ? 1 : 0;
        u.boffb = (size_t)e * estride_b; u.aoffb = (split_pm >= 0 && u.pm >= split_pm) ? adiff : 0; u.ks = 0; return true;
    }
    __device__ __forceinline__ void a_ready(const Unit&) const {}
    __device__ __forceinline__ void done(const Unit&) const {}
};
struct MoeSplitK {
    int base, nrows, nN, nS, KS, G, c; int segt[9]; size_t estride_b;
    __device__ __forceinline__ bool next(int i, Unit& u) const {
        const long L = (long)i * G + c; if (L >= (long)nrows * nN * nS) return false;
        u.ks = (int)(L % nS); const int rest = (int)(L / nS); u.pm = base + rest % nrows; u.pn = rest / nrows;
        int e = 0;
#pragma unroll
        for (int k = 1; k < 8; ++k) e += (u.pm >= segt[k]) ? 1 : 0;
        u.boffb = (size_t)e * estride_b + (size_t)u.ks * KS * 2; u.aoffb = (size_t)u.ks * KS * 2; return true;
    }
    __device__ __forceinline__ void a_ready(const Unit&) const {}
    __device__ __forceinline__ void done(const Unit&) const {}
};
struct EpiPart {
    static constexpr bool PERM = true, AFTER_DRAIN = false;
    bf16_t* P; int ldc, base, ptiles; float s;
    __device__ __forceinline__ void operator()(const f32x4 (&acc)[2][2][4][2], const Unit& u, int wr, int wc, int fr, int fq) const {
        const int row0 = (u.ks * ptiles + (u.pm - base)) * BM + wr * 64 + fr, col0 = u.pn * BM + wc * 32 + 8 * fq;
#pragma unroll
        for (int ai = 0; ai < 2; ++ai)
#pragma unroll
            for (int m = 0; m < 4; ++m) { bf16_t* rowp = P + (size_t)(row0 + ai * HALF + m * 16) * ldc + col0;
#pragma unroll
                for (int bj = 0; bj < 2; ++bj) { const f32x4 v0 = acc[ai][bj][m][0] * s, v1 = acc[ai][bj][m][1] * s;
                    u32x4 w; w.x = cvt_pk_bf16(v0[0], v0[1]); w.y = cvt_pk_bf16(v0[2], v0[3]); w.z = cvt_pk_bf16(v1[0], v1[1]); w.w = cvt_pk_bf16(v1[2], v1[3]);
                    *(u32x4*)(rowp + bj * HALF) = w; } }
    }
};

template <class Epi, class Sched, bool ALIGN_EPI = false, bool SP2 = false, bool FP8 = false>
__device__ __forceinline__ void gemm_phase(PG8_LAS unsigned char* lds, const Gemm g, const Sched& S, const Epi& E) {
    const int tid = threadIdx.x, wid = __builtin_amdgcn_readfirstlane(tid >> 6), lane = tid & 63, wr = wid >> 2, wc = wid & 3, fr = lane & 15, fq = lane >> 4;
    const int K = g.K, nt = K / BK, LD = g.ld ? g.ld : g.K;
    unsigned voffA[2], voffB[2];
#pragma unroll
    for (int i = 0; i < 2; ++i) { int R, C; stage_rc(tid * 16 + i * 8192, R, C); const int Rb = Epi::PERM ? ((R & ~31) + perm32(R & 31)) : R;
        voffA[i] = (unsigned)(R * LD + C) * 2u; voffB[i] = (unsigned)(Rb * LD + C) * 2u; }
    const size_t kstep = (size_t)(BK * 2);
    const size_t hstep = (size_t)HALF * LD * 2;
    const size_t tstep = 2 * hstep;
    const unsigned ldsw = (unsigned)wid * 1024u;
    const int aoff = lds_byte(wr * 64 + fr, fq * 8), boff = lds_byte(wc * 32 + fr, fq * 8);
#define PG8_SA(b, h) (((b) * 2 + (h)) * HTB)
#define PG8_SB(b, h) ((4 + (b) * 2 + (h)) * HTB)
#define PG8_STAGE(bufoff, gbase, voff) do { _Pragma("unroll") for (int _i = 0; _i < 2; ++_i) \
        __builtin_amdgcn_global_load_lds((const unsigned*)((const char*)(gbase) + (voff)[_i]), (PG8_LAS unsigned*)(lds + (bufoff) + ldsw + _i * 8192), 16, 0, 0); } while (0)
#define PG8_LDA(dst, b, h) do { if constexpr (FP8) { _Pragma("unroll") for (int m = 0; m < 4; ++m) { const i32x4 lo_ = *(const PG8_LAS i32x4*)(lds + PG8_SA(b, h) + aoff + m * 2048), hi_ = *(const PG8_LAS i32x4*)(lds + PG8_SA(b, h) + aoff + m * 2048 + 1024); \
            dst##8[m] = __builtin_shufflevector(lo_, hi_, 0, 1, 2, 3, 4, 5, 6, 7); } } \
        else { _Pragma("unroll") for (int m = 0; m < 4; ++m) _Pragma("unroll") for (int k = 0; k < 2; ++k) dst[m][k] = *(const PG8_LAS bf16x8*)(lds + PG8_SA(b, h) + aoff + m * 2048 + k * 1024); } } while (0)
#define PG8_LDB(dst, b, h) do { if constexpr (FP8) { _Pragma("unroll") for (int n = 0; n < 2; ++n) { const i32x4 lo_ = *(const PG8_LAS i32x4*)(lds + PG8_SB(b, h) + boff + n * 2048), hi_ = *(const PG8_LAS i32x4*)(lds + PG8_SB(b, h) + boff + n * 2048 + 1024); \
            dst##8[n] = __builtin_shufflevector(lo_, hi_, 0, 1, 2, 3, 4, 5, 6, 7); } } \
        else { _Pragma("unroll") for (int n = 0; n < 2; ++n) _Pragma("unroll") for (int k = 0; k < 2; ++k) dst[n][k] = *(const PG8_LAS bf16x8*)(lds + PG8_SB(b, h) + boff + n * 2048 + k * 1024); } } while (0)
#define PG8_MMA(ai, bj, At, Bt) do { __builtin_amdgcn_s_setprio(1); \
        if constexpr (FP8) { _Pragma("unroll") for (int m = 0; m < 4; ++m) _Pragma("unroll") for (int n = 0; n < 2; ++n) \
            asm volatile("v_mfma_scale_f32_16x16x128_f8f6f4 %0, %1, %2, %0, %3, %3 op_sel_hi:[0,0,0]" : "+v"(acc[ai][bj][m][n]) : "v"(Bt##8[n]), "v"(At##8[m]), "v"(fp8_one)); } \
        else { _Pragma("unroll") for (int m = 0; m < 4; ++m) _Pragma("unroll") for (int n = 0; n < 2; ++n) _Pragma("unroll") for (int k = 0; k < 2; ++k) \
            acc[ai][bj][m][n] = __builtin_amdgcn_mfma_f32_16x16x32_bf16(Bt[n][k], At[m][k], acc[ai][bj][m][n], 0, 0, 0); } \
        __builtin_amdgcn_s_setprio(0); } while (0)
#define PG8_WAIT_V(n) asm volatile("s_waitcnt vmcnt(" #n ")" ::: "memory")
#define PG8_WAIT_L(n) asm volatile("s_waitcnt lgkmcnt(" #n ")" ::: "memory")
#define PG8_BAR __builtin_amdgcn_s_barrier()
#define PG8_SCHED __builtin_amdgcn_sched_barrier(0)
    Unit cur, nxt; int ui = 0;
    if (!S.next(0, cur)) return;
    f32x4 acc[2][2][4][2];
#pragma unroll
    for (int a = 0; a < 2; ++a)
#pragma unroll
        for (int b = 0; b < 2; ++b)
#pragma unroll
            for (int m = 0; m < 4; ++m)
#pragma unroll
                for (int n = 0; n < 2; ++n) acc[a][b][m][n] = (f32x4){0.f, 0.f, 0.f, 0.f};
    bf16x8 At[4][2], B0[2][2], B1[2][2];
    i32x8 At8[4], B08[2], B18[2];
    int fp8_one = 0x7F7F7F7F; if constexpr (FP8) asm volatile("" : "+v"(fp8_one));
    const char* cA = (const char*)g.A + (size_t)cur.pm * tstep + cur.aoffb; const char* cB = (const char*)g.Bt + (size_t)cur.pn * tstep + cur.boffb;
    S.a_ready(cur);
    if constexpr (SP2) {
        PG8_STAGE(PG8_SB(0, 0), cB, voffB); PG8_STAGE(PG8_SB(0, 1), cB + hstep, voffB); PG8_STAGE(PG8_SA(0, 0), cA, voffA); PG8_STAGE(PG8_SA(0, 1), cA + hstep, voffA);
        if (wr == 1) PG8_BAR;
        PG8_WAIT_V(2); PG8_BAR;
        PG8_STAGE(PG8_SB(1, 0), cB + kstep, voffB); PG8_STAGE(PG8_SA(1, 0), cA + kstep, voffA); PG8_STAGE(PG8_SB(1, 1), cB + hstep + kstep, voffB);
        PG8_WAIT_V(6); PG8_BAR;
    } else {
        PG8_STAGE(PG8_SB(0, 0), cB, voffB); PG8_STAGE(PG8_SA(0, 0), cA, voffA); PG8_STAGE(PG8_SB(0, 1), cB + hstep, voffB); PG8_STAGE(PG8_SA(0, 1), cA + hstep, voffA);
        if (wr == 1) PG8_BAR;
        PG8_WAIT_V(4); PG8_BAR;
        PG8_STAGE(PG8_SB(1, 0), cB + kstep, voffB); PG8_STAGE(PG8_SA(1, 0), cA + kstep, voffA); PG8_STAGE(PG8_SB(1, 1), cB + hstep + kstep, voffB);
        PG8_WAIT_V(6); PG8_BAR;
    }
    for (;;) {
        const bool has_next = S.next(ui + 1, nxt);
        const char* nA = has_next ? (const char*)g.A + (size_t)nxt.pm * tstep + nxt.aoffb : cA; const char* nB = has_next ? (const char*)g.Bt + (size_t)nxt.pn * tstep + nxt.boffb : cB;
#pragma unroll 1
        for (int t = 0; t < nt; t += 2) {
            const bool last = (t == nt - 2);
            const char* a1 = cA + (size_t)(t + 1) * kstep;
            const char* a2 = last ? nA : cA + (size_t)(t + 2) * kstep; const char* b2 = last ? nB : cB + (size_t)(t + 2) * kstep;
            const char* a3 = a2 + kstep; const char* b3 = b2 + kstep;
            if (last && has_next) S.a_ready(nxt);
            if constexpr (SP2) {
            PG8_LDB(B0, 0, 0); PG8_LDB(B1, 0, 1); PG8_SCHED; PG8_LDA(At, 0, 0); PG8_STAGE(PG8_SA(1, 1), a1 + hstep, voffA);
            PG8_WAIT_V(8); PG8_WAIT_L(0); PG8_BAR; PG8_MMA(0, 0, At, B0); PG8_MMA(0, 1, At, B1); PG8_BAR; PG8_SCHED;
            PG8_LDA(At, 0, 1); PG8_STAGE(PG8_SB(0, 0), b2, voffB); PG8_STAGE(PG8_SB(0, 1), b2 + hstep, voffB); PG8_STAGE(PG8_SA(0, 0), a2, voffA);
            PG8_WAIT_V(8); PG8_WAIT_L(0); PG8_BAR; PG8_MMA(1, 0, At, B0); PG8_MMA(1, 1, At, B1); PG8_BAR; PG8_SCHED;
            PG8_LDB(B0, 1, 0); PG8_LDB(B1, 1, 1); PG8_SCHED; PG8_LDA(At, 1, 0); PG8_STAGE(PG8_SA(0, 1), a2 + hstep, voffA);
            PG8_WAIT_V(8); PG8_WAIT_L(0); PG8_BAR; PG8_MMA(0, 0, At, B0); PG8_MMA(0, 1, At, B1); PG8_BAR; PG8_SCHED;
            PG8_LDA(At, 1, 1); PG8_STAGE(PG8_SB(1, 0), b3, voffB); PG8_STAGE(PG8_SB(1, 1), b3 + hstep, voffB); PG8_STAGE(PG8_SA(1, 0), a3, voffA);
            PG8_WAIT_V(8); PG8_WAIT_L(0); PG8_BAR; PG8_MMA(1, 0, At, B0); PG8_MMA(1, 1, At, B1); PG8_BAR; PG8_SCHED;
            } else {
            PG8_LDB(B0, 0, 0); PG8_SCHED; PG8_LDA(At, 0, 0); PG8_STAGE(PG8_SA(1, 1), a1 + hstep, voffA);
            PG8_WAIT_L(8); PG8_BAR; PG8_WAIT_L(0); PG8_MMA(0, 0, At, B0); PG8_BAR; PG8_SCHED;
            PG8_LDB(B1, 0, 1); PG8_STAGE(PG8_SB(0, 0), b2, voffB);
            PG8_BAR; PG8_WAIT_L(0); PG8_MMA(0, 1, At, B1); PG8_BAR;
            PG8_LDA(At, 0, 1); PG8_STAGE(PG8_SA(0, 0), a2, voffA);
            PG8_BAR; PG8_WAIT_L(0); PG8_MMA(1, 0, At, B0); PG8_BAR; PG8_SCHED;
            PG8_STAGE(PG8_SB(0, 1), b2 + hstep, voffB);
            PG8_WAIT_V(6); PG8_BAR; PG8_MMA(1, 1, At, B1); PG8_BAR;
            PG8_LDB(B0, 1, 0); PG8_SCHED; PG8_LDA(At, 1, 0); PG8_STAGE(PG8_SA(0, 1), a2 + hstep, voffA);
            PG8_WAIT_L(8); PG8_BAR; PG8_WAIT_L(0); PG8_MMA(0, 0, At, B0); PG8_BAR; PG8_SCHED;
            PG8_LDB(B1, 1, 1); PG8_STAGE(PG8_SB(1, 0), b3, voffB);
            PG8_BAR; PG8_WAIT_L(0); PG8_MMA(0, 1, At, B1); PG8_BAR;
            PG8_LDA(At, 1, 1); PG8_STAGE(PG8_SA(1, 0), a3, voffA);
            PG8_BAR; PG8_WAIT_L(0); PG8_MMA(1, 0, At, B0); PG8_BAR; PG8_SCHED;
            PG8_STAGE(PG8_SB(1, 1), b3 + hstep, voffB);
            PG8_WAIT_V(6); PG8_BAR; PG8_MMA(1, 1, At, B1); PG8_BAR;
            }
        }
        if constexpr (FP8) asm volatile("s_nop 15\n\ts_nop 15" ::: "memory");
        if constexpr (ALIGN_EPI) { if (wr == 0) PG8_BAR; }
        if constexpr (!Epi::AFTER_DRAIN) { E(acc, cur, wr, wc, fr, fq); S.done(cur); }
        if (!has_next) break;
#pragma unroll
        for (int a = 0; a < 2; ++a)
#pragma unroll
            for (int b = 0; b < 2; ++b)
#pragma unroll
                for (int m = 0; m < 4; ++m)
#pragma unroll
                    for (int n = 0; n < 2; ++n) acc[a][b][m][n] = (f32x4){0.f, 0.f, 0.f, 0.f};
        cur = nxt; cA = nA; cB = nB; ++ui;
        if constexpr (ALIGN_EPI) { if (wr == 1) PG8_BAR; }
    }
    PG8_WAIT_V(0);
    if constexpr (!ALIGN_EPI) { if (wr == 0) PG8_BAR; }
    PG8_BAR;
    if constexpr (Epi::AFTER_DRAIN) { E.fused(acc, cur, wr, wc, fr, fq, lds, wid, lane); S.done(cur); }
#undef PG8_SA
#undef PG8_SB
#undef PG8_STAGE
#undef PG8_LDA
#undef PG8_LDB
#undef PG8_MMA
#undef PG8_WAIT_V
#undef PG8_WAIT_L
#undef PG8_BAR
#undef PG8_SCHED
}
}
#define GAS __attribute__((address_space(1)))
#define LAS __attribute__((address_space(3)))
typedef unsigned short bf16;
typedef unsigned v4u __attribute__((ext_vector_type(4)));
typedef float f32x4 __attribute__((ext_vector_type(4)));
typedef short bf16x8 __attribute__((ext_vector_type(8)));
typedef GAS unsigned gu32;
typedef GAS unsigned long long gu64;
#define RLX_AGENT __ATOMIC_RELAXED, __HIP_MEMORY_SCOPE_AGENT
#define LDS_WAIT() asm volatile("s_waitcnt lgkmcnt(0)" ::: "memory")
#define VM_WAIT() asm volatile("s_waitcnt vmcnt(0)" ::: "memory")
#define LDS_BARRIER() asm volatile("s_waitcnt lgkmcnt(0)\n\ts_barrier" ::: "memory")
__device__ __forceinline__ unsigned long long rt() { return __builtin_amdgcn_s_memrealtime(); }
__device__ __forceinline__ unsigned f2bf(float f) { unsigned u = __builtin_bit_cast(unsigned, f); return (u + 0x7fffu + ((u >> 16) & 1u)) >> 16; }
typedef float pk_f32x2_t __attribute__((ext_vector_type(2))); typedef __bf16 pk_bf16x2_t __attribute__((ext_vector_type(2)));
__device__ __forceinline__ unsigned pk2(float lo, float hi) { const pk_f32x2_t v = {lo, hi}; return __builtin_bit_cast(unsigned, __builtin_convertvector(v, pk_bf16x2_t)); }

#define XB_TMO      128
#define XB_XCNT(j)  (256  + 64 * (j))
#define XB_XSUB(j)  (1280 + 64 * (j))
#define XB_XGEN(j)  (2304 + 64 * (j))
#define XB_TOP      3328
#define XB_TOPGEN   3392
#define XCD_BAR_WORDS 3456
#define XB_SPIN_CAP (1u << 18)

__device__ __forceinline__ unsigned xb_ld(unsigned* p)              { return __hip_atomic_load(p, __ATOMIC_RELAXED, __HIP_MEMORY_SCOPE_AGENT); }
__device__ __forceinline__ unsigned xb_add(unsigned* p, unsigned v) { return __hip_atomic_fetch_add(p, v, __ATOMIC_RELAXED, __HIP_MEMORY_SCOPE_AGENT); }
__device__ __forceinline__ unsigned xb_xcc_id() { return (unsigned)__builtin_amdgcn_s_getreg((3 << 11) | 20) & 0xFu; }
#define XB_SPIN(cond, bar) do { unsigned _sp = 0; while (cond) { __builtin_amdgcn_s_sleep(1); \
    if ((++_sp & 255u) == 0u) { if (xb_ld(&(bar)[XB_TMO])) break; if (_sp > XB_SPIN_CAP) { atomicAdd(&(bar)[XB_TMO], 1u); break; } } } } while (0)

struct XcdBarrier {
    unsigned* bar; unsigned x;
    volatile LAS unsigned* st;
};

__device__ __forceinline__ XcdBarrier xcd_barrier_post(unsigned* bar, volatile LAS unsigned* st) {
    XcdBarrier b; b.bar = bar; b.x = xb_xcc_id(); b.st = st;
    if (threadIdx.x == 0) (void)xb_add(&bar[XB_XCNT(b.x)], 1u);
    return b;
}
__device__ __forceinline__ void xcd_barrier_complete(unsigned* bar, unsigned x, unsigned& nloc, unsigned& nx) {
    const unsigned G = gridDim.x * gridDim.y * gridDim.z;
    unsigned sum, cnt, mine, sp = 0u;
    for (;;) {
        sum = 0u; cnt = 0u; mine = 0u;
#pragma unroll
        for (unsigned j = 0; j < 16; ++j) { const unsigned c = xb_ld(&bar[XB_XCNT(j)]); sum += c; cnt += (c > 0u) ? 1u : 0u; mine = (j == x) ? c : mine; }
        if (sum == G) break;
        __builtin_amdgcn_s_sleep(1);
        if ((++sp & 255u) == 0u) { if (xb_ld(&bar[XB_TMO])) break; if (sp > XB_SPIN_CAP) { atomicAdd(&bar[XB_TMO], 1u); break; } }
    }
    nloc = mine > 0u ? mine : 1u; nx = cnt > 0u ? cnt : 1u;
}

__device__ __forceinline__ void xcd_barrier(const XcdBarrier& b) {
    asm volatile("s_waitcnt vmcnt(0)" ::: "memory");
    __syncthreads();
    if (threadIdx.x == 0) {
        unsigned* bar = b.bar;
        __builtin_amdgcn_s_waitcnt(0);
        unsigned nloc = b.st[0], nx = b.st[1];
        if (nloc == 0u) { xcd_barrier_complete(bar, b.x, nloc, nx); b.st[0] = nloc; b.st[1] = nx; }
        const unsigned old = xb_add(&bar[XB_XSUB(b.x)], 1u);
        const unsigned gen = old / nloc;
        if (old + 1u == (gen + 1u) * nloc) {
            __builtin_amdgcn_fence(__ATOMIC_RELEASE, "agent");
            asm volatile("s_waitcnt vmcnt(0)" ::: "memory");
            const unsigned og = xb_add(&bar[XB_TOP], 1u);
            const unsigned tg = og / nx;
            if (og + 1u == (tg + 1u) * nx) xb_add(&bar[XB_TOPGEN], 1u);
            else XB_SPIN(xb_ld(&bar[XB_TOPGEN]) == tg, bar);
            __builtin_amdgcn_fence(__ATOMIC_ACQUIRE, "agent");
            xb_add(&bar[XB_XGEN(b.x)], 1u);
            asm volatile("s_waitcnt vmcnt(0)" ::: "memory");
        } else {
            XB_SPIN(xb_ld(&bar[XB_XGEN(b.x)]) == gen, bar);
            __builtin_amdgcn_fence(__ATOMIC_ACQUIRE, "agent");
            asm volatile("s_waitcnt vmcnt(0)" ::: "memory");
        }
    }
    __syncthreads();
}


constexpr int NWAVES = 8;
constexpr int NBATCH = 8, SEQ = 4096, M = NBATCH * SEQ, D = 1024, DIN = 2560, DA = 512, DL = 512, NH = 8, HD = 64;
constexpr int DFF = 2816, NE = 8, DFE = 3584;
constexpr int SORT_ROWS = 2 * M + NE * 256, NT_MAX = SORT_ROWS / 256;
constexpr int CHUNK_TILES = 128, NCHUNK = (NT_MAX + CHUNK_TILES - 1) / CHUNK_TILES;
constexpr float ALPHA = 1.4142135623730951f, LN_EPS = 1e-5f, RMS_EPS = 1e-6f;
constexpr float LOG2E = 1.4426950408889634f, QSCALE = 0.125f * LOG2E;
constexpr int PH_PRO = 0, PH_L0 = 1, PH_L1 = 9;
constexpr int PH_DISPATCH = 14, PH_MOE0 = 15, PH_COMBINE = PH_MOE0 + 2 * NCHUNK, NPH = PH_COMBINE + 1;
constexpr size_t MiB = 1u << 20;
#if defined(MK_PER_PHASE)
constexpr size_t WS_CTL = 0, CTL_ZERO_BYTES = 1 * MiB;
#else
constexpr size_t WS_CTL = 0, CTL_ZERO_BYTES = 32 * 1024;
#endif
constexpr size_t WS_TOKE = 1 * MiB, WS_TOKP = WS_TOKE + 256 * 1024, WS_TOKPOS = WS_TOKP + 256 * 1024, WS_SEG = WS_TOKPOS + 256 * 1024;
constexpr size_t WS_LRUW = 2 * MiB;
constexpr size_t WS_LSE = 3 * MiB, WS_AGG = 6 * MiB;
constexpr size_t WS_WIN = 8 * MiB, WS_WOUT = 18 * MiB, WS_WGU = 22 * MiB, WS_WD = 33 * MiB, WS_MGU = 431 * MiB, WS_MD = 487 * MiB;
constexpr size_t WS_XB = 207 * MiB;
constexpr size_t WS_Q = 271 * MiB, WS_K = 303 * MiB, WS_V = 335 * MiB, WS_U = 367 * MiB, WS_G = 399 * MiB;
constexpr size_t WS_O0 = 39 * MiB, WS_O1 = 71 * MiB, WS_O2 = 103 * MiB;
constexpr size_t WS_LA = 135 * MiB, WS_BE = 167 * MiB;
constexpr size_t WS_Y = WS_Q;
constexpr size_t WS_HB = 271 * MiB, WS_X8 = 359 * MiB;
constexpr int TAIL_KS = 512, TAIL_NS = DFE / TAIL_KS, TAIL_TILES = NT_MAX - (NCHUNK - 1) * CHUNK_TILES;
constexpr size_t WS_PART = 8 * MiB;
static_assert(WS_PART + (size_t)TAIL_NS * TAIL_TILES * 256 * D * 2 <= 39 * MiB, "tail partials");
constexpr size_t WS_HCA = 171 * MiB, WS_XS8 = 271 * MiB, WS_YS = 39 * MiB, WS_END = 515 * MiB;
constexpr float MOE_HSCALE = 8.0f, MOE_DSCALE = 128.0f;
constexpr float MOE_WSCALE = 32.0f;
static_assert(WS_MGU >= WS_G + (size_t)M * DL * 2 && WS_MGU + (size_t)NE * 2 * DFE * D <= WS_MD && WS_MD + (size_t)NE * D * DFE <= WS_END && WS_YS + (size_t)SORT_ROWS * D * 2 <= WS_HCA && WS_HCA + (size_t)TAIL_TILES * 256 * DFE <= WS_XB && (size_t)CHUNK_TILES * 256 * DFE <= (size_t)M * D * 4 && WS_XS8 + (size_t)SORT_ROWS * D <= WS_MGU, "d_ws map");
constexpr int CW_TMO = 0, CW_CODE = 1, CW_TAILCNT = 64, CW_TAILGU = 128, CW_BAR = 4096; constexpr int TAIL_HEAD_PCT = 36;
constexpr unsigned long long PROBE_MASK = 0ull; constexpr unsigned PROBE_K = 8; constexpr int PROBE_SEAM = -1;
constexpr int RING_OFF = 0, RING_BYTES = 131072;
constexpr int LDSCTL_OFF = RING_BYTES, MISC_OFF = LDSCTL_OFF + 320;
constexpr int LDS_BYTES = 147456;

typedef int v4i __attribute__((ext_vector_type(4)));
typedef unsigned v2u __attribute__((ext_vector_type(2)));
typedef float f32x2 __attribute__((ext_vector_type(2)));
struct Frame {
    LAS unsigned char* lds;
    volatile LAS unsigned* MISC;
    gu32* ctl;
    int tid, lane, wave;
    int vcu, G;
    unsigned long long pt0, pacc;
};
__device__ __forceinline__ int fresh_lane() { int l; asm volatile("v_mbcnt_lo_u32_b32 %0, -1, 0\n\tv_mbcnt_hi_u32_b32 %0, -1, %0" : "=v"(l)); return l; }
struct Args { const float* in[24]; float* out; unsigned char* ws; int ph_lo, ph_hi, li, pad; };

template <int CTRL> __device__ __forceinline__ float dpp_mov(float v) { return __builtin_bit_cast(float, __builtin_amdgcn_update_dpp(0, __builtin_bit_cast(int, v), CTRL, 0xf, 0xf, true)); }
__device__ __forceinline__ float wave_sum(float v) {
    v += dpp_mov<0xB1>(v);
    v += dpp_mov<0x4E>(v);
    v += dpp_mov<0x141>(v);
    v += dpp_mov<0x140>(v);
    const int vi = __builtin_bit_cast(int, v);
    const float r0 = __builtin_bit_cast(float, __builtin_amdgcn_readlane(vi, 0)), r1 = __builtin_bit_cast(float, __builtin_amdgcn_readlane(vi, 16));
    const float r2 = __builtin_bit_cast(float, __builtin_amdgcn_readlane(vi, 32)), r3 = __builtin_bit_cast(float, __builtin_amdgcn_readlane(vi, 48));
    return (r0 + r1) + (r2 + r3);
}
__device__ __forceinline__ int wave_sum_i(int v) {
    v += __builtin_amdgcn_update_dpp(0, v, 0xB1, 0xf, 0xf, true); v += __builtin_amdgcn_update_dpp(0, v, 0x4E, 0xf, 0xf, true);
    v += __builtin_amdgcn_update_dpp(0, v, 0x141, 0xf, 0xf, true); v += __builtin_amdgcn_update_dpp(0, v, 0x140, 0xf, 0xf, true);
    return (__builtin_amdgcn_readlane(v, 0) + __builtin_amdgcn_readlane(v, 16)) + (__builtin_amdgcn_readlane(v, 32) + __builtin_amdgcn_readlane(v, 48));
}
__device__ __forceinline__ float bf2f(bf16 h) { return __uint_as_float((unsigned)h << 16); }
__device__ __forceinline__ float bflo(unsigned w) { return __uint_as_float(w << 16); }
__device__ __forceinline__ float bfhi(unsigned w) { return __uint_as_float(w & 0xffff0000u); }

__device__ __forceinline__ void transpose_item(const float* W, int N, bf16* WT, int ldt, int dst_row0, LAS float* scr, int kb, int nb, int lane) {
    const int k0 = 64 * kb, n0 = 32 * nb;
    f32x4 v[8];
#pragma unroll
    for (int i = 0; i < 8; ++i) v[i] = *(const GAS f32x4*)(W + (size_t)(k0 + 8 * i + (lane >> 3)) * N + n0 + 4 * (lane & 7));
#pragma unroll
    for (int i = 0; i < 8; ++i) { LAS float* d = scr + (8 * i + (lane >> 3)) * 33 + 4 * (lane & 7); d[0] = v[i].x; d[1] = v[i].y; d[2] = v[i].z; d[3] = v[i].w; }
    LDS_WAIT(); asm volatile("" ::: "memory");
    const int c = lane & 7;
#pragma unroll
    for (int j = 0; j < 4; ++j) { const int n = (lane >> 3) + 8 * j; const LAS float* s = scr + (8 * c) * 33 + n;
        v4u o; o.x = pk2(s[0 * 33], s[1 * 33]); o.y = pk2(s[2 * 33], s[3 * 33]); o.z = pk2(s[4 * 33], s[5 * 33]); o.w = pk2(s[6 * 33], s[7 * 33]);
        *(GAS v4u*)(WT + (size_t)(dst_row0 + n) * ldt + k0 + 8 * c) = o; }
    LDS_WAIT(); asm volatile("" ::: "memory");
}
__device__ __forceinline__ unsigned pk4_fp8(float a, float b, float c, float d) {
    a = __builtin_fminf(__builtin_fmaxf(a, -448.f), 448.f); b = __builtin_fminf(__builtin_fmaxf(b, -448.f), 448.f); c = __builtin_fminf(__builtin_fmaxf(c, -448.f), 448.f); d = __builtin_fminf(__builtin_fmaxf(d, -448.f), 448.f);
    unsigned w = 0u; w = __builtin_amdgcn_cvt_pk_fp8_f32(a, b, w, false); w = __builtin_amdgcn_cvt_pk_fp8_f32(c, d, w, true); return w;
}
__device__ __forceinline__ void transpose_item_fp8(const float* W, int N, unsigned char* WT8, int ldt, int dst_row0, LAS float* scr, int kb, int nb, int lane, float scale) {
    const int k0 = 64 * kb, n0 = 32 * nb;
    f32x4 v[8];
#pragma unroll
    for (int i = 0; i < 8; ++i) v[i] = *(const GAS f32x4*)(W + (size_t)(k0 + 8 * i + (lane >> 3)) * N + n0 + 4 * (lane & 7));
#pragma unroll
    for (int i = 0; i < 8; ++i) { LAS float* d = scr + (8 * i + (lane >> 3)) * 33 + 4 * (lane & 7); d[0] = v[i].x * scale; d[1] = v[i].y * scale; d[2] = v[i].z * scale; d[3] = v[i].w * scale; }
    LDS_WAIT(); asm volatile("" ::: "memory");
    const int c = lane & 3;
#pragma unroll
    for (int j = 0; j < 2; ++j) { const int n = (lane >> 2) + 16 * j; const LAS float* s = scr + (16 * c) * 33 + n;
        v4u o; o.x = pk4_fp8(s[0 * 33], s[1 * 33], s[2 * 33], s[3 * 33]); o.y = pk4_fp8(s[4 * 33], s[5 * 33], s[6 * 33], s[7 * 33]);
        o.z = pk4_fp8(s[8 * 33], s[9 * 33], s[10 * 33], s[11 * 33]); o.w = pk4_fp8(s[12 * 33], s[13 * 33], s[14 * 33], s[15 * 33]);
        *(GAS v4u*)(WT8 + (size_t)(dst_row0 + n) * ldt + k0 + 16 * c) = o; }
    LDS_WAIT(); asm volatile("" ::: "memory");
}
__device__ __forceinline__ void tr_gu8(const float* W, int K, int N, unsigned char* WT8, int half, LAS float* scr, int item, int lane, float scale) {
    const int nblk = N / 32, kb = item / nblk, nb = item % nblk, n0 = 32 * nb; transpose_item_fp8(W, N, WT8, K, (n0 >> 7) * 256 + half * 128 + (n0 & 127), scr, kb, nb, lane, scale);
}
__device__ __forceinline__ void tr_plain8(const float* W, int K, int N, unsigned char* WT8, LAS float* scr, int item, int lane, float scale) {
    const int nblk = N / 32, kb = item / nblk, nb = item % nblk; transpose_item_fp8(W, N, WT8, K, 32 * nb, scr, kb, nb, lane, scale);
}
__device__ __forceinline__ void tr_plain(const float* W, int K, int N, bf16* WT, LAS float* scr, int item, int lane) {
    const int nblk = N / 32, kb = item / nblk, nb = item % nblk; transpose_item(W, N, WT, K, 32 * nb, scr, kb, nb, lane);
}
__device__ __forceinline__ void tr_gu(const float* W, int K, int N, bf16* WT, int half, LAS float* scr, int item, int lane) {
    const int nblk = N / 32, kb = item / nblk, nb = item % nblk, n0 = 32 * nb; transpose_item(W, N, WT, K, (n0 >> 7) * 256 + half * 128 + (n0 & 127), scr, kb, nb, lane);
}

__device__ __forceinline__ void phase_prologue(Frame& F, const Args& a) {
    LAS float* scr = (LAS float*)(F.lds + RING_OFF + F.wave * 16384);
    const int gw = F.vcu * NWAVES + F.wave, NGW = F.G * NWAVES;
    unsigned char* ws = a.ws;
    constexpr int I_WIN = (D / 64) * (DIN / 32), I_WOUT = (D / 64) * (D / 32), I_GU = (D / 64) * (DFF / 32), I_DN = (DFF / 64) * (D / 32), I_LRU = 64;
    constexpr int NITEMS = 2 * I_WIN + 2 * I_WOUT + 2 * I_GU + I_DN + I_LRU;
    for (int it = gw; it < NITEMS; it += NGW) {
        int r = it;
        if (r < 2 * I_WIN) { const int l = r / I_WIN; r -= l * I_WIN; tr_plain(a.in[1] + (size_t)l * D * DIN, D, DIN, (bf16*)(ws + WS_WIN) + (size_t)l * DIN * D, scr, r, F.lane); continue; } r -= 2 * I_WIN;
        if (r < 2 * I_WOUT) { const int l = r / I_WOUT; r -= l * I_WOUT; tr_plain(a.in[12] + (size_t)l * D * D, D, D, (bf16*)(ws + WS_WOUT) + (size_t)l * D * D, scr, r, F.lane); continue; } r -= 2 * I_WOUT;
        if (r < I_GU) { tr_gu8(a.in[17], D, DFF, ws + WS_WGU, 0, scr, r, F.lane, MOE_WSCALE); continue; } r -= I_GU;
        if (r < I_GU) { tr_gu8(a.in[18], D, DFF, ws + WS_WGU, 1, scr, r, F.lane, MOE_WSCALE); continue; } r -= I_GU;
        if (r < I_DN) { tr_plain8(a.in[19], DFF, D, ws + WS_WD, scr, r, F.lane, MOE_DSCALE); continue; } r -= I_DN;
        { const int mi = r >> 1, it2 = r & 1, l = mi >> 4, gate = (mi >> 3) & 1, g = mi & 7;
          const float* src = (gate ? a.in[6] : a.in[4]) + (size_t)(l * 8 + g) * 4096; tr_plain(src, 64, 64, (bf16*)(ws + WS_LRUW) + (size_t)mi * 4096, scr, it2, F.lane); }
    }
    const float* x = a.in[0]; bf16* XBp = (bf16*)(ws + WS_XB);
    for (int m = gw; m < M; m += NGW) {
        const GAS f32x4* xr = (const GAS f32x4*)(x + (size_t)m * D) + F.lane; GAS unsigned long long* o8 = (GAS unsigned long long*)(XBp + (size_t)m * D) + F.lane;
#pragma unroll
        for (int j = 0; j < 4; ++j) { const f32x4 v = xr[64 * j]; o8[64 * j] = (unsigned long long)pk2(v.x, v.y) | ((unsigned long long)pk2(v.z, v.w) << 32); }
    }
}
struct CvtItem { const float* src; unsigned char* dst; int N, ldt; float scale; };
__device__ __forceinline__ CvtItem moe_cvt_item(const Args& a, int it, int lane) {
    constexpr int I_M = 896, I_E = 3 * I_M;
    const int e = it / I_E; int r = it - e * I_E;
    const int kc = lane & 7, cg = lane >> 3;
    CvtItem c;
    if (r < 2 * I_M) { const int half = r >= I_M ? 1 : 0; r -= half * I_M; const int kb = r / 112, nb = r - kb * 112, k0 = 128 * kb + 16 * kc, n0 = 32 * nb + 4 * cg;
        c.src = (half ? a.in[22] : a.in[21]) + (size_t)e * D * DFE + (size_t)k0 * DFE + n0; c.N = DFE;
        c.dst = a.ws + WS_MGU + (size_t)e * (2 * DFE) * D + (size_t)((n0 >> 7) * 256 + half * 128 + (n0 & 127)) * D + k0; c.ldt = D; c.scale = MOE_WSCALE; }
    else { r -= 2 * I_M; const int kb = r >> 5, nb = r & 31, k0 = 128 * kb + 16 * kc, n0 = 32 * nb + 4 * cg;
        c.src = a.in[23] + (size_t)e * DFE * D + (size_t)k0 * D + n0; c.N = D;
        c.dst = a.ws + WS_MD + (size_t)e * D * DFE + (size_t)n0 * DFE + k0; c.ldt = DFE; c.scale = MOE_DSCALE; }
    return c;
}
#define CVT_LOAD(v_, c_) do { _Pragma("unroll") for (int i_ = 0; i_ < 16; ++i_) v_[i_] = __builtin_nontemporal_load((const GAS f32x4*)((c_).src + (size_t)i_ * (c_).N)); } while (0)
__device__ __forceinline__ void phase_moe_cvt(Frame& F, const Args& a, const int gw, const int NGW) {
    constexpr int TOT = NE * 3 * 896;
    const int l = F.lane;
    if (gw >= TOT) return;
    CvtItem cn = moe_cvt_item(a, gw, l);
    f32x4 vn[16];
    CVT_LOAD(vn, cn);
    for (int it = gw; it < TOT; it += NGW) {
        const CvtItem c = cn; f32x4 v[16];
#pragma unroll
        for (int i = 0; i < 16; ++i) v[i] = vn[i];
        if (it + NGW < TOT) { cn = moe_cvt_item(a, it + NGW, l); CVT_LOAD(vn, cn); }
        unsigned o[4][4];
#pragma unroll
        for (int q = 0; q < 4; ++q) { unsigned d[4];
#pragma unroll
            for (int r = 0; r < 4; ++r) { const f32x4 x = v[4 * q + r] * c.scale; d[r] = pk4_fp8(x.x, x.y, x.z, x.w); }
            const unsigned t0 = __builtin_amdgcn_perm(d[1], d[0], 0x05010400u), t1 = __builtin_amdgcn_perm(d[1], d[0], 0x07030602u);
            const unsigned t2 = __builtin_amdgcn_perm(d[3], d[2], 0x05010400u), t3 = __builtin_amdgcn_perm(d[3], d[2], 0x07030602u);
            o[0][q] = __builtin_amdgcn_perm(t2, t0, 0x05040100u); o[1][q] = __builtin_amdgcn_perm(t2, t0, 0x07060302u);
            o[2][q] = __builtin_amdgcn_perm(t3, t1, 0x05040100u); o[3][q] = __builtin_amdgcn_perm(t3, t1, 0x07060302u); }
#pragma unroll
        for (int j = 0; j < 4; ++j) __builtin_nontemporal_store((v4u){o[j][0], o[j][1], o[j][2], o[j][3]}, (GAS v4u*)(c.dst + (size_t)j * c.ldt));
    }
}
#undef CVT_LOAD
template <bool ROUTE>
__device__ __forceinline__ void phase_ln(Frame& F, bf16* XBp, const float* g, const float* b, const float* rw, int* tok_e, float* tok_p, unsigned char* X8 = nullptr) {
    const int gw = F.vcu * NWAVES + F.wave, NGW = F.G * NWAVES;
    LAS f32x4* rws = (LAS f32x4*)(F.lds + RING_OFF);
    f32x4 wa[16], wb[16];
    if (ROUTE) {
#pragma unroll
        for (int j = 0; j < 4; ++j)
#pragma unroll
            for (int i = 0; i < 4; ++i) { const int c = 8 * F.lane + 512 * (j >> 1) + 4 * (j & 1) + i; wa[4 * j + i] = ((const GAS f32x4*)rw)[2 * c]; wb[4 * j + i] = ((const GAS f32x4*)rw)[2 * c + 1]; }
    }
    f32x4 gv[4], bv[4];
#pragma unroll
    for (int j = 0; j < 2; ++j) { gv[2 * j] = ((const GAS f32x4*)g)[2 * F.lane + 128 * j]; gv[2 * j + 1] = ((const GAS f32x4*)g)[2 * F.lane + 128 * j + 1]; bv[2 * j] = ((const GAS f32x4*)b)[2 * F.lane + 128 * j]; bv[2 * j + 1] = ((const GAS f32x4*)b)[2 * F.lane + 128 * j + 1]; }
    v4u nx[2], ny[2];
    { const GAS v4u* xr = (const GAS v4u*)(XBp + (size_t)(gw < M ? gw : 0) * D) + F.lane; nx[0] = xr[0]; nx[1] = xr[64]; }
    { const int m1 = (gw + NGW < M) ? gw + NGW : 0; const GAS v4u* xr = (const GAS v4u*)(XBp + (size_t)m1 * D) + F.lane; ny[0] = xr[0]; ny[1] = xr[64]; }
    for (int m = gw; m < M; m += NGW) {
        const v4u r0 = nx[0], r1 = nx[1];
        nx[0] = ny[0]; nx[1] = ny[1];
        { const int mn = (m + 2 * NGW < M) ? m + 2 * NGW : m; const GAS v4u* xr = (const GAS v4u*)(XBp + (size_t)mn * D) + F.lane; ny[0] = xr[0]; ny[1] = xr[64]; }
        f32x4 v[4];
        v[0] = (f32x4){bflo(r0.x), bfhi(r0.x), bflo(r0.y), bfhi(r0.y)}; v[1] = (f32x4){bflo(r0.z), bfhi(r0.z), bflo(r0.w), bfhi(r0.w)};
        v[2] = (f32x4){bflo(r1.x), bfhi(r1.x), bflo(r1.y), bfhi(r1.y)}; v[3] = (f32x4){bflo(r1.z), bfhi(r1.z), bflo(r1.w), bfhi(r1.w)};
        float s = 0.f;
#pragma unroll
        for (int j = 0; j < 4; ++j) s += (v[j].x + v[j].y) + (v[j].z + v[j].w);
        const float mean = wave_sum(s) * (1.f / D); float s2 = 0.f;
#pragma unroll
        for (int j = 0; j < 4; ++j) { v[j] = v[j] - mean; s2 += (v[j].x * v[j].x + v[j].y * v[j].y) + (v[j].z * v[j].z + v[j].w * v[j].w); }
        const float rstd = 1.f / sqrtf(wave_sum(s2) * (1.f / D) + LN_EPS);
#pragma unroll
        for (int j = 0; j < 4; ++j) v[j] = v[j] * rstd * gv[j] + bv[j];
        GAS v4u* xw = (GAS v4u*)(XBp + (size_t)m * D) + F.lane;
        xw[0] = (v4u){pk2(v[0].x, v[0].y), pk2(v[0].z, v[0].w), pk2(v[1].x, v[1].y), pk2(v[1].z, v[1].w)};
        xw[64] = (v4u){pk2(v[2].x, v[2].y), pk2(v[2].z, v[2].w), pk2(v[3].x, v[3].y), pk2(v[3].z, v[3].w)};
        if (X8) { GAS v2u* x8 = (GAS v2u*)(X8 + (size_t)m * D) + F.lane;
            x8[0] = (v2u){pk4_fp8(v[0].x, v[0].y, v[0].z, v[0].w), pk4_fp8(v[1].x, v[1].y, v[1].z, v[1].w)}; x8[64] = (v2u){pk4_fp8(v[2].x, v[2].y, v[2].z, v[2].w), pk4_fp8(v[3].x, v[3].y, v[3].z, v[3].w)}; }
        if (ROUTE) {
            f32x4 la = {0.f, 0.f, 0.f, 0.f}, lb = {0.f, 0.f, 0.f, 0.f};
#pragma unroll
            for (int j = 0; j < 4; ++j)
#pragma unroll
                for (int i = 0; i < 4; ++i) { la += wa[4 * j + i] * v[j][i]; lb += wb[4 * j + i] * v[j][i]; }
            float lg[8];
            lg[0] = wave_sum(la.x); lg[1] = wave_sum(la.y); lg[2] = wave_sum(la.z); lg[3] = wave_sum(la.w); lg[4] = wave_sum(lb.x); lg[5] = wave_sum(lb.y); lg[6] = wave_sum(lb.z); lg[7] = wave_sum(lb.w);
            int e0 = 0; float v0 = lg[0];
#pragma unroll
            for (int e = 1; e < 8; ++e) if (lg[e] > v0) { v0 = lg[e]; e0 = e; }
            int e1 = -1; float v1 = -INFINITY;
#pragma unroll
            for (int e = 0; e < 8; ++e) if (e != e0 && lg[e] > v1) { v1 = lg[e]; e1 = e; }
            if (F.lane == 0) { const float p1 = expf(v1 - v0), den = 1.f + p1; tok_e[2 * m] = e0; tok_e[2 * m + 1] = e1; tok_p[2 * m] = 1.f / den; tok_p[2 * m + 1] = p1 / den; }
        }
    }
}
__device__ __forceinline__ void phase_dispatch(Frame& F, const int* tok_e, int* tok_pos, int* segtab, const bf16* XBp, unsigned char* XS8) {
    LAS int* s_tot = (LAS int*)(F.lds + RING_OFF); LAS int* s_bef = s_tot + 8; LAS int* s_w = s_tot + 16; LAS int* s_pos = s_tot + 32;
    for (int tile = blockIdx.x; tile < M / 128; tile += F.G) {
        __syncthreads();
        if (F.tid < 32) s_tot[F.tid] = 0;
        __syncthreads();
        int tot[8], bef[8];
#pragma unroll
        for (int e = 0; e < 8; ++e) { tot[e] = 0; bef[e] = 0; }
        const GAS v4i* te4 = (const GAS v4i*)tok_e;
        for (int i4 = F.tid; i4 < 2 * M / 4; i4 += NWAVES * 64) { const v4i ev = te4[i4]; const int before = (2 * i4 < tile * 128) ? 1 : 0;
#pragma unroll
            for (int e = 0; e < 8; ++e) { const int hit = (ev.x == e) + (ev.y == e) + (ev.z == e) + (ev.w == e); tot[e] += hit; bef[e] += before ? hit : 0; } }
#pragma unroll
        for (int e = 0; e < 8; ++e) { int a = tot[e], b = bef[e];
            a = wave_sum_i(a); b = wave_sum_i(b);
            if (F.lane == 0) { __hip_atomic_fetch_add(&s_tot[e], a, __ATOMIC_RELAXED, __HIP_MEMORY_SCOPE_WORKGROUP); __hip_atomic_fetch_add(&s_bef[e], b, __ATOMIC_RELAXED, __HIP_MEMORY_SCOPE_WORKGROUP); } }
        int e0 = -1, e1 = -1, rk0 = 0, rk1 = 0; const int tok = tile * 128 + F.tid;
        if (F.wave < 2) { e0 = tok_e[2 * tok]; e1 = tok_e[2 * tok + 1];
#pragma unroll
            for (int e = 0; e < 8; ++e) { const bool has = (e0 == e) || (e1 == e); const unsigned long long mask = __ballot(has); const int rk = __popcll(mask & ((1ull << F.lane) - 1ull));
                if (e0 == e) rk0 = rk; if (e1 == e) rk1 = rk; if (F.lane == 0) s_w[F.wave * 8 + e] = __popcll(mask); } }
        LDS_WAIT(); __syncthreads();
        int seg[9]; seg[0] = 0;
#pragma unroll
        for (int e = 0; e < 8; ++e) seg[e + 1] = seg[e] + ((s_tot[e] + 255) & ~255);
        if (F.wave < 2) { int p0 = 0, p1 = 0;
#pragma unroll
            for (int e = 0; e < 8; ++e) { const int wp = (F.wave == 1) ? s_w[e] : 0; if (e0 == e) p0 = seg[e] + s_bef[e] + wp + rk0; if (e1 == e) p1 = seg[e] + s_bef[e] + wp + rk1; }
            tok_pos[2 * tok] = p0; tok_pos[2 * tok + 1] = p1; s_pos[2 * F.tid] = p0; s_pos[2 * F.tid + 1] = p1; }
        if (tile == 0) {
#pragma unroll
            for (int k = 0; k < 9; ++k) if (F.tid == k) segtab[k] = seg[k] >> 8;
        }
        LDS_WAIT(); __syncthreads();
        for (int i0 = F.wave * 16; i0 < F.wave * 16 + 16; i0 += 4) { v4u ra[4], rb[4];
#pragma unroll
            for (int j = 0; j < 4; ++j) { const GAS v4u* src = (const GAS v4u*)(XBp + (size_t)(tile * 128 + i0 + j) * D) + F.lane; ra[j] = src[0]; rb[j] = src[64]; }
#pragma unroll
            for (int j = 0; j < 4; ++j) { const int p0 = s_pos[2 * (i0 + j)], p1 = s_pos[2 * (i0 + j) + 1];
                v2u qa, qb;
                qa.x = pk4_fp8(bflo(ra[j].x), bfhi(ra[j].x), bflo(ra[j].y), bfhi(ra[j].y)); qa.y = pk4_fp8(bflo(ra[j].z), bfhi(ra[j].z), bflo(ra[j].w), bfhi(ra[j].w));
                qb.x = pk4_fp8(bflo(rb[j].x), bfhi(rb[j].x), bflo(rb[j].y), bfhi(rb[j].y)); qb.y = pk4_fp8(bflo(rb[j].z), bfhi(rb[j].z), bflo(rb[j].w), bfhi(rb[j].w));
                GAS v2u* d0 = (GAS v2u*)(XS8 + (size_t)p0 * D) + F.lane; d0[0] = qa; d0[64] = qb;
                GAS v2u* d1 = (GAS v2u*)(XS8 + (size_t)p1 * D) + F.lane; d1[0] = qa; d1[64] = qb; } }
    }
}
__device__ __forceinline__ void phase_combine(Frame& F, const bf16* XBp, float* outp, const bf16* YS, const int* tok_pos, const float* tok_p, const float* g, const float* b, const bf16* PART, const int mode, const int tail_row0, const int gw, const int NGW, const int m_lo = 0, const int m_hi = M) {
    f32x4 gv[4], bv[4];
#pragma unroll
    for (int j = 0; j < 4; ++j) { gv[j] = ((const GAS f32x4*)g)[F.lane + 64 * j]; bv[j] = ((const GAS f32x4*)b)[F.lane + 64 * j]; }
    typedef int v2i_t __attribute__((ext_vector_type(2)));
#define CMB_POS(dst_p, dst_w, m_) do { const int mm_ = (m_) < m_hi ? (m_) : 0; dst_p = ((const GAS v2i_t*)tok_pos)[mm_]; dst_w = ((const GAS f32x2*)tok_p)[mm_]; } while (0)
#define CMB_ROWS(X_, Y0_, Y1_, m_, q0_, q1_) do { const GAS v2u* xr_ = (const GAS v2u*)(XBp + (size_t)(m_) * D) + F.lane; const GAS v2u* a_ = (const GAS v2u*)(YS + (size_t)((q0_) < tail_row0 ? (q0_) : 0) * D) + F.lane; \
        const GAS v2u* c_ = (const GAS v2u*)(YS + (size_t)((q1_) < tail_row0 ? (q1_) : 0) * D) + F.lane; _Pragma("unroll") for (int j = 0; j < 4; ++j) { X_[j] = xr_[64 * j]; Y0_[j] = a_[64 * j]; Y1_[j] = c_[64 * j]; } } while (0)
    typedef float f32x2 __attribute__((ext_vector_type(2)));
    v2i_t pc, pn, pnn; f32x2 wc, wn, wnn;
    v2u xc[4], y0c[4], y1c[4], xn[4], y0n[4], y1n[4];
    CMB_POS(pc, wc, m_lo + gw); CMB_POS(pn, wn, m_lo + gw + NGW);
    { const int q0 = __builtin_amdgcn_readfirstlane(pc.x), q1 = __builtin_amdgcn_readfirstlane(pc.y); const bool tl = (q0 >= tail_row0) || (q1 >= tail_row0);
      if (m_lo + gw < m_hi && !((mode == 1 && tl) || (mode == 2 && !tl))) CMB_ROWS(xc, y0c, y1c, m_lo + gw, q0, q1); }
    for (int m = m_lo + gw; m < m_hi; m += NGW) {
        const int p0 = __builtin_amdgcn_readfirstlane(pc.x), p1 = __builtin_amdgcn_readfirstlane(pc.y);
        const bool in_tail = (p0 >= tail_row0) || (p1 >= tail_row0);
        const bool skip = (mode == 1 && in_tail) || (mode == 2 && !in_tail);
        const float w0 = wc.x, w1 = wc.y;
        const int mn = m + NGW;
        { const int q0 = __builtin_amdgcn_readfirstlane(pn.x), q1 = __builtin_amdgcn_readfirstlane(pn.y); const bool tl = (q0 >= tail_row0) || (q1 >= tail_row0);
          if (mn < m_hi && !((mode == 1 && tl) || (mode == 2 && !tl))) CMB_ROWS(xn, y0n, y1n, mn, q0, q1); }
        CMB_POS(pnn, wnn, m + 2 * NGW);
        if (!skip) {
            f32x4 v[4]; float s = 0.f;
#pragma unroll
            for (int j = 0; j < 4; ++j) { const v2u x = xc[j]; f32x4 ya, yc;
                if (p0 >= tail_row0) { ya = (f32x4){0.f, 0.f, 0.f, 0.f};
#pragma unroll
                    for (int ks = 0; ks < TAIL_NS; ++ks) { const v2u q = ((const GAS v2u*)(PART + ((size_t)ks * TAIL_TILES * 256 + (p0 - tail_row0)) * D) + F.lane)[64 * j]; ya += (f32x4){bflo(q.x), bfhi(q.x), bflo(q.y), bfhi(q.y)}; } }
                else { const v2u q = y0c[j]; ya = (f32x4){bflo(q.x), bfhi(q.x), bflo(q.y), bfhi(q.y)}; }
                if (p1 >= tail_row0) { yc = (f32x4){0.f, 0.f, 0.f, 0.f};
#pragma unroll
                    for (int ks = 0; ks < TAIL_NS; ++ks) { const v2u q = ((const GAS v2u*)(PART + ((size_t)ks * TAIL_TILES * 256 + (p1 - tail_row0)) * D) + F.lane)[64 * j]; yc += (f32x4){bflo(q.x), bfhi(q.x), bflo(q.y), bfhi(q.y)}; } }
                else { const v2u q = y1c[j]; yc = (f32x4){bflo(q.x), bfhi(q.x), bflo(q.y), bfhi(q.y)}; }
                v[j].x = ALPHA * bflo(x.x) + (w0 * ya.x + w1 * yc.x); v[j].y = ALPHA * bfhi(x.x) + (w0 * ya.y + w1 * yc.y);
                v[j].z = ALPHA * bflo(x.y) + (w0 * ya.z + w1 * yc.z); v[j].w = ALPHA * bfhi(x.y) + (w0 * ya.w + w1 * yc.w);
                s += (v[j].x + v[j].y) + (v[j].z + v[j].w); }
            const float mean = wave_sum(s) * (1.f / D); float s2 = 0.f;
#pragma unroll
            for (int j = 0; j < 4; ++j) { v[j] = v[j] - mean; s2 += (v[j].x * v[j].x + v[j].y * v[j].y) + (v[j].z * v[j].z + v[j].w * v[j].w); }
            const float rstd = 1.f / sqrtf(wave_sum(s2) * (1.f / D) + LN_EPS);
            GAS f32x4* ow = (GAS f32x4*)(outp + (size_t)m * D) + F.lane;
#pragma unroll
            for (int j = 0; j < 4; ++j) ow[64 * j] = v[j] * rstd * gv[j] + bv[j];
        }
        pc = pn; wc = wn; pn = pnn; wn = wnn;
#pragma unroll
        for (int j = 0; j < 4; ++j) { xc[j] = xn[j]; y0c[j] = y0n[j]; y1c[j] = y1n[j]; }
    }
#undef CMB_POS
#undef CMB_ROWS
}

namespace att {
typedef float f32x16 __attribute__((ext_vector_type(16)));
typedef short s16x4 __attribute__((ext_vector_type(4)));
constexpr int NTASK = NBATCH * NH * 48;
constexpr int K_PITCH = 144, V_OFF = 384 * K_PITCH, V_DBS = 384 * 64 + 64, BIAS_OFF = V_OFF + 2 * V_DBS, TAB_OFF = BIAS_OFF + 528, NEG_OFF = TAB_OFF + 5 * 4 * 64 * 16, ATT_LDS = NEG_OFF + 4 * 64 * 16;
static_assert(ATT_LDS <= RING_BYTES && (TAB_OFF % 16) == 0, "attention LDS");
__device__ __forceinline__ int t5_bucket(int dist) {
    if (dist < 16) return dist;
    int b = 16;
    b += dist >= 22; b += dist >= 30; b += dist >= 40; b += dist >= 54; b += dist >= 73; b += dist >= 99; b += dist >= 134; b += dist >= 182;
    b += dist >= 246; b += dist >= 332; b += dist >= 450; b += dist >= 609; b += dist >= 825; b += dist >= 1117; b += dist >= 1513;
    return b;
}
__device__ __forceinline__ s16x4 vtr(LAS const unsigned char* p) { typedef short v4i16_t __attribute__((ext_vector_type(4))); return __builtin_bit_cast(s16x4, __builtin_amdgcn_ds_read_tr16_b64_v4i16((LAS v4i16_t*)p)); }
struct Task { int head, p, b, r, k, dil; };
__device__ __forceinline__ Task decode(int n, int head) { Task t; t.head = head; t.p = n >> 7; t.b = (n >> 4) & 7; const int q16 = n & 15, npair = 16 >> (2 * t.p); t.r = q16 / npair; t.k = q16 - t.r * npair; t.dil = 1 << (2 * t.p); return t; }

#define PBR(k) do { if (PROBE_MASK >> 32) { const unsigned long long t_ = rt(); if ((PROBE_MASK >> (k)) & 1ull) F.pacc += t_ - F.pt0; F.pt0 = t_; } } while (0)
__device__ __forceinline__ void attn_phase(Frame& F, const bf16* Qg, const bf16* Kg, const bf16* Vg, const float* rel_bias, bf16* O0, bf16* O1, bf16* O2, float* LSE) {
    LAS unsigned char* lds = F.lds + RING_OFF;
    LAS float* bias_l = (LAS float*)(lds + BIAS_OFF);
    LAS f32x4* tab = (LAS f32x4*)(lds + TAB_OFF);
    const int w = F.wave, l = F.lane, q_rel = l & 31, hh = l >> 5;
    const int head = (int)blockIdx.x & 7, jwg = (int)blockIdx.x >> 3, nwg = (F.G + 7 - head) >> 3;
    const int T0 = jwg, T1 = NTASK / 8;
    v4u kreg[6], vreg[6]; bf16x8 qn[4];
    int cur_hp = -1;
#define ATT_LOAD(T_) do { const Task t_ = decode(T_, head); const size_t rb_ = (size_t)t_.b * SEQ * DA + t_.head * HD; \
        _Pragma("unroll") for (int n = 0; n < 6; ++n) { const int ci = F.tid + 512 * n, kk = ci >> 3, c = ci & 7, li = 256 * t_.k - 128 + kk; \
            const bool ok_ = li >= 0; const size_t off = rb_ + (size_t)((ok_ ? li : 0) * t_.dil + t_.r) * DA + c * 8;     \
            const v4u kx_ = *(const GAS v4u*)(Kg + off), vx_ = *(const GAS v4u*)(Vg + off); kreg[n] = ok_ ? kx_ : (v4u){0u, 0u, 0u, 0u}; vreg[n] = ok_ ? vx_ : (v4u){0u, 0u, 0u, 0u}; } \
        const bf16* qp_ = Qg + rb_ + (size_t)((256 * t_.k + 32 * w + q_rel) * t_.dil + t_.r) * DA + 8 * hh; \
        _Pragma("unroll") for (int s = 0; s < 4; ++s) qn[s] = *(const GAS bf16x8*)(qp_ + 16 * s); } while (0)
    if (T0 < T1) ATT_LOAD(T0);
#pragma unroll
    for (int n = 0; n < 6; ++n) { asm volatile("" : "+v"(kreg[n])); asm volatile("" : "+v"(vreg[n])); }
#pragma unroll
    for (int s4 = 0; s4 < 4; ++s4) asm volatile("" : "+v"(qn[s4]));
    for (int T = T0; T < T1; T += nwg) {
        const Task t = decode(T, head);
        const int hp = t.p;
        if (PROBE_MASK >> 32) F.pt0 = rt();
        LDS_BARRIER();
#pragma unroll
        for (int n = 0; n < 6; ++n) { const int ci = F.tid + 512 * n, kk = ci >> 3, c = ci & 7;
            *(LAS v4u*)(lds + kk * K_PITCH + c * 16) = kreg[n];
            *(LAS v4u*)(lds + V_OFF + (c >> 2) * V_DBS + kk * 64 + (c & 3) * 16) = vreg[n]; }
        bf16x8 qf[4];
#pragma unroll
        for (int s = 0; s < 4; ++s) qf[s] = qn[s];
        if (hp != cur_hp) {
            if (F.tid < 129) bias_l[F.tid] = rel_bias[t5_bucket(F.tid * t.dil) * NH + t.head] * LOG2E;
            LDS_WAIT(); __syncthreads();
            for (int idx = F.tid; idx < 5 * 4 * 64; idx += NWAVES * 64) { const int ln = idx & 63, e4 = (idx >> 6) & 3, i = idx >> 8, qr = ln & 31, h2 = ln >> 5;
                f32x4 tv;
#pragma unroll
                for (int j = 0; j < 4; ++j) { const int k_rel = j + 8 * e4 + 4 * h2; int delta = 128 - 32 * i + qr - k_rel; const bool ok = (i != 0 || k_rel >= qr) && (i != 4 || k_rel <= qr);
                    delta = delta < 0 ? 0 : (delta > 128 ? 128 : delta); tv[j] = ok ? bias_l[delta] : -1e30f; }
                tab[idx] = tv; }
            for (int idx = F.tid; idx < 4 * 64; idx += NWAVES * 64) ((LAS f32x4*)(lds + NEG_OFF))[idx] = (f32x4){-1e30f, -1e30f, -1e30f, -1e30f};
            cur_hp = hp;
        }
        LDS_BARRIER();
        PBR(32);
        if (T + nwg < T1) ATT_LOAD(T + nwg);
        f32x16 st[5];
        const LAS unsigned char* kbase = lds + (32 * w + q_rel) * K_PITCH + 16 * hh;
        const LAS f32x4* negt = (const LAS f32x4*)(lds + NEG_OFF) + l;
        float mx = -1e30f;
        bf16x8 kf[4];
#pragma unroll
        for (int s = 0; s < 4; ++s) kf[s] = *(const LAS bf16x8*)(kbase + s * 32);
#pragma unroll
        for (int i = 0; i < 5; ++i) {
            const LAS f32x4* tp = (t.k == 0 && w + i < 4) ? negt : tab + (i * 4) * 64 + l;
#pragma unroll
            for (int e4 = 0; e4 < 4; ++e4) { const f32x4 tv = tp[e4 * 64];
#pragma unroll
                for (int j = 0; j < 4; ++j) st[i][4 * e4 + j] = tv[j]; }
            bf16x8 kn[4];
#pragma unroll
            for (int s = 0; s < 4; ++s) kn[s] = (i < 4) ? *(const LAS bf16x8*)(kbase + (i + 1) * (32 * K_PITCH) + s * 32) : kf[s];
            __builtin_amdgcn_sched_barrier(0);
#pragma unroll
            for (int s = 0; s < 4; ++s) st[i] = __builtin_amdgcn_mfma_f32_32x32x16_bf16(kf[s], qf[s], st[i], 0, 0, 0);
            __builtin_amdgcn_sched_barrier(0);
#pragma unroll
            for (int s = 0; s < 4; ++s) kf[s] = kn[s];
        }
#pragma unroll
        for (int i = 0; i < 5; ++i)
#pragma unroll
            for (int e = 0; e < 16; ++e) mx = fmaxf(mx, st[i][e]);
        mx = fmaxf(mx, __shfl_xor(mx, 32));
        PBR(33);
        float ls[5];
#pragma unroll
        for (int i = 0; i < 5; ++i) { typedef float f32x2 __attribute__((ext_vector_type(2))); f32x2 a2 = {0.f, 0.f};
#pragma unroll
            for (int e = 0; e < 16; e += 2) { const f32x2 d2 = (f32x2){st[i][e], st[i][e + 1]} - mx; f32x2 p2; p2.x = __builtin_amdgcn_exp2f(d2.x); p2.y = __builtin_amdgcn_exp2f(d2.y); st[i][e] = p2.x; st[i][e + 1] = p2.y; a2 += p2; }
            ls[i] = a2.x + a2.y; }
        float lsum = (ls[0] + ls[1]) + (ls[2] + ls[3]) + ls[4];
        lsum += __shfl_xor(lsum, 32);
        PBR(34);
        f32x16 o[2];
#pragma unroll
        for (int e = 0; e < 16; ++e) { o[0][e] = 0.f; o[1][e] = 0.f; }
        const LAS unsigned char* vb = lds + V_OFF + (32 * w + 4 * hh + ((l & 15) >> 2)) * 64 + (16 * ((l >> 4) & 1) + 4 * (l & 3)) * 2;
#define ATT_LOADV(dst_, q_) do { _Pragma("unroll") for (int db = 0; db < 2; ++db) { const s16x4 lo = vtr(vb + db * V_DBS + (q_) * 1024), hi = vtr(vb + db * V_DBS + (q_) * 1024 + 512); \
            dst_[db] = (bf16x8){lo[0], lo[1], lo[2], lo[3], hi[0], hi[1], hi[2], hi[3]}; } } while (0)
        bf16x8 vf[2];
        ATT_LOADV(vf, 0);
#pragma unroll
        for (int q = 0; q < 10; ++q) { const int i = q >> 1, s2 = q & 1;
                v4u pw; pw.x = pk2(st[i][8 * s2 + 0], st[i][8 * s2 + 1]); pw.y = pk2(st[i][8 * s2 + 2], st[i][8 * s2 + 3]);
                pw.z = pk2(st[i][8 * s2 + 4], st[i][8 * s2 + 5]); pw.w = pk2(st[i][8 * s2 + 6], st[i][8 * s2 + 7]);
                const bf16x8 pf = __builtin_bit_cast(bf16x8, pw);
                bf16x8 vn[2];
                if (q < 9) ATT_LOADV(vn, q + 1); else { vn[0] = vf[0]; vn[1] = vf[1]; }
                __builtin_amdgcn_sched_barrier(0);
                o[0] = __builtin_amdgcn_mfma_f32_32x32x16_bf16(vf[0], pf, o[0], 0, 0, 0);
                o[1] = __builtin_amdgcn_mfma_f32_32x32x16_bf16(vf[1], pf, o[1], 0, 0, 0);
                __builtin_amdgcn_sched_barrier(0);
                vf[0] = vn[0]; vf[1] = vn[1];
            }
#undef ATT_LOADV
        PBR(35);
#pragma unroll
        for (int n = 0; n < 6; ++n) { asm volatile("" : "+v"(kreg[n])); asm volatile("" : "+v"(vreg[n])); }
#pragma unroll
        for (int s4 = 0; s4 < 4; ++s4) asm volatile("" : "+v"(qn[s4]));
        const float inv = 1.0f / lsum;
        const size_t rowbase = (size_t)t.b * SEQ * DA + t.head * HD; const int qtok = (256 * t.k + 32 * w + q_rel) * t.dil + t.r;
        bf16* Op = (t.p == 0) ? O0 : (t.p == 1) ? O1 : O2;
        bf16* orow = Op + rowbase + (size_t)qtok * DA + 8 * hh;
#pragma unroll
        for (int db = 0; db < 2; ++db)
#pragma unroll
            for (int g = 0; g < 4; g += 2) {
                unsigned ax = pk2(o[db][4 * g] * inv, o[db][4 * g + 1] * inv), ay = pk2(o[db][4 * g + 2] * inv, o[db][4 * g + 3] * inv);
                unsigned bx = pk2(o[db][4 * g + 4] * inv, o[db][4 * g + 5] * inv), by = pk2(o[db][4 * g + 6] * inv, o[db][4 * g + 7] * inv);
                { const auto r = __builtin_amdgcn_permlane32_swap(ax, bx, false, false); ax = r[0]; bx = r[1]; }
                { const auto r = __builtin_amdgcn_permlane32_swap(ay, by, false, false); ay = r[0]; by = r[1]; }
                *(GAS v4u*)(orow + 32 * db + 8 * g) = (v4u){ax, ay, bx, by}; }
        if (hh == 0) LSE[((size_t)t.p * M + (size_t)t.b * SEQ + qtok) * NH + t.head] = mx + __builtin_amdgcn_logf(lsum);
        PBR(36);
    }
#undef ATT_LOAD
}
__device__ __forceinline__ void merge_attn_phase(Frame& F, const bf16* O0, const bf16* O1, const bf16* O2, const float* LSE, const float* g_attn, bf16* Y) {
    const int gw = F.vcu * NWAVES + F.wave, NGW = F.G * NWAVES, head = F.lane >> 3;
    const f32x4 g0 = ((const GAS f32x4*)g_attn)[2 * F.lane], g1 = ((const GAS f32x4*)g_attn)[2 * F.lane + 1];
    v4u na, nb, nc; float nl0, nl1, nl2;
#define MRG_LOAD(m_) do { const int mm_ = (m_) < M ? (m_) : 0; na = ((const GAS v4u*)(O0 + (size_t)mm_ * DA))[F.lane]; nb = ((const GAS v4u*)(O1 + (size_t)mm_ * DA))[F.lane]; nc = ((const GAS v4u*)(O2 + (size_t)mm_ * DA))[F.lane]; \
        nl0 = LSE[((size_t)0 * M + mm_) * NH + head]; nl1 = LSE[((size_t)1 * M + mm_) * NH + head]; nl2 = LSE[((size_t)2 * M + mm_) * NH + head]; } while (0)
    MRG_LOAD(gw);
    for (int m = gw; m < M; m += NGW) {
        const v4u a = na, b = nb, c = nc; const float l0 = nl0, l1 = nl1, l2 = nl2;
        MRG_LOAD(m + NGW);
        const float mx = fmaxf(l0, fmaxf(l1, l2));
        float w0 = __builtin_amdgcn_exp2f(l0 - mx), w1 = __builtin_amdgcn_exp2f(l1 - mx), w2 = __builtin_amdgcn_exp2f(l2 - mx);
        const float inv = 1.0f / (w0 + w1 + w2); w0 *= inv; w1 *= inv; w2 *= inv;
        float v[8]; float ss = 0.f;
#pragma unroll
        for (int j = 0; j < 4; ++j) { v[2 * j] = w0 * bflo(a[j]) + w1 * bflo(b[j]) + w2 * bflo(c[j]); v[2 * j + 1] = w0 * bfhi(a[j]) + w1 * bfhi(b[j]) + w2 * bfhi(c[j]); ss += v[2 * j] * v[2 * j] + v[2 * j + 1] * v[2 * j + 1]; }
        const float rs = 1.0f / sqrtf(wave_sum(ss) * (1.0f / DA) + RMS_EPS);
        v4u ov; ov.x = pk2(v[0] * rs * g0.x, v[1] * rs * g0.y); ov.y = pk2(v[2] * rs * g0.z, v[3] * rs * g0.w); ov.z = pk2(v[4] * rs * g1.x, v[5] * rs * g1.y); ov.w = pk2(v[6] * rs * g1.z, v[7] * rs * g1.w);
        ((GAS v4u*)(Y + (size_t)m * D))[F.lane] = ov;
    }
#undef MRG_LOAD
}
}

namespace lru {
constexpr int TAB_OFF = 0, STG_OFF = 10240, STG_WAVE = 16 * 68 * 4, GST_OFF = STG_OFF + NWAVES * STG_WAVE, GST_WAVE = 16 * 64 * 2, VST_OFF = GST_OFF + NWAVES * GST_WAVE, VST_WAVE = 64 * 64 * 2,
              SS_OFF = VST_OFF + NWAVES * VST_WAVE, LRU_LDS = SS_OFF + 2048;
static_assert(LRU_LDS <= RING_BYTES && (SS_OFF % 16) == 0 && (STG_OFF % 16) == 0, "LRU LDS");
constexpr int NUNIT = NBATCH * (SEQ / 64);
constexpr int FT_PITCH = 144, FT_WAVE = 64 * FT_PITCH;
static_assert(NWAVES * FT_WAVE + 2048 <= RING_BYTES, "LRU final LDS");
__device__ __forceinline__ float sigmoidf_fast(float x) { return __builtin_amdgcn_rcpf(1.0f + __builtin_amdgcn_exp2f(-LOG2E * x)); }

template <bool FINAL>
__device__ __forceinline__ void lru_phase(Frame& F, const int layer, const Args& a, const bf16* Ug, const bf16* Gg, float* AGG, bf16* Y, bf16* LAo, bf16* BEo) {
    LAS unsigned char* lds = F.lds + RING_OFF;
    LAS float* convw = (LAS float*)(lds + TAB_OFF);
    LAS float* convb = convw + 2048;
    __syncthreads();
    for (int i = F.tid; i < 2048; i += NWAVES * 64) convw[i] = a.in[2][layer * 2048 + i];
    if (F.tid < 512) convb[F.tid] = a.in[3][layer * 512 + F.tid];
    LDS_WAIT(); __syncthreads();
    const int g = F.wave, l = F.lane, c16 = l & 15, lg = l >> 4;
    float nba[4], nbx[4], c2[4];
#pragma unroll
    for (int t = 0; t < 4; ++t) { const int ch = 64 * g + 16 * t + c16; nba[t] = -LOG2E * a.in[5][layer * 512 + ch]; nbx[t] = -LOG2E * a.in[7][layer * 512 + ch]; c2[t] = -8.0f * LOG2E * log1pf(expf(-a.in[8][layer * 512 + ch])); }
    bf16x8 wf[2][4][2];
    { const bf16* Wbase = (const bf16*)(a.ws + WS_LRUW) + (size_t)(layer * 16 + g) * 4096 + c16 * 64 + 8 * lg;
#pragma unroll
      for (int gate = 0; gate < 2; ++gate)
#pragma unroll
        for (int t = 0; t < 4; ++t)
#pragma unroll
            for (int s = 0; s < 2; ++s) wf[gate][t][s] = *(const GAS bf16x8*)(Wbase + (size_t)gate * 8 * 4096 + t * 16 * 64 + s * 32); }
    LAS float* stg = (LAS float*)(lds + STG_OFF + g * STG_WAVE);
    LAS bf16* gst = (LAS bf16*)(lds + GST_OFF + g * GST_WAVE);
    LAS bf16* vst = (LAS bf16*)(lds + VST_OFF + g * VST_WAVE);
    LAS float* ssl = (LAS float*)(lds + SS_OFF);
    LAS float* stg_c = stg + (4 * lg) * 68 + c16;
    LAS bf16* gst_c = gst + (4 * lg) * 64 + c16;
    LAS bf16* vst_c = vst + (4 * lg) * 64 + c16;
    LAS float* ssl_w = ssl + (4 * lg) * 8 + g;
    for (int unit = blockIdx.x; unit < NUNIT; unit += F.G) {
        const int b = unit >> 6, c = unit & 63; const size_t tok0 = (size_t)b * SEQ + 64 * c;
        v4u un[2][4]; v4u gn[2];
#define LRU_LOAD(ss_) do { const int ts_ = 64 * c + 16 * (ss_) + c16; const size_t row_ = tok0 + 16 * (ss_) + c16; \
            _Pragma("unroll") for (int s = 0; s < 2; ++s) _Pragma("unroll") for (int w = 0; w < 4; ++w) { \
                const bool ok_ = ts_ - 3 + w >= 0; const v4u x_ = *(const GAS v4u*)(Ug + (ok_ ? row_ - 3 + w : row_) * DL + 64 * g + 32 * s + 8 * lg);     \
                un[s][w] = ok_ ? x_ : (v4u){0u, 0u, 0u, 0u}; } \
            if (FINAL) { const bf16* gp_ = Gg + (tok0 + 16 * (ss_) + (l >> 2)) * DL + 64 * g + (l & 3) * 16; gn[0] = *(const GAS v4u*)gp_; gn[1] = *(const GAS v4u*)(gp_ + 8); } } while (0)
        LRU_LOAD(0);
        float hc[4], At[4];
#pragma unroll
        for (int t = 0; t < 4; ++t) { hc[t] = 0.f; At[t] = 1.f; }
        if (FINAL) {
#pragma unroll 4
            for (int cc = 0; cc < c; ++cc) {
#pragma unroll
                for (int t = 0; t < 4; ++t) { const f32x2 ab = *(const GAS f32x2*)(AGG + ((size_t)(b * 64 + cc) * 512 + 64 * g + 16 * t + c16) * 2); hc[t] = ab.x * hc[t] + ab.y; } }
        }
#pragma unroll
        for (int ss = 0; ss < 4; ++ss) {
            if (FINAL) { *(LAS v4u*)(gst + (l >> 2) * 64 + (l & 3) * 16) = gn[0]; *(LAS v4u*)(gst + (l >> 2) * 64 + (l & 3) * 16 + 8) = gn[1]; }
            bf16x8 af[2];
#pragma unroll
            for (int s = 0; s < 2; ++s) { const int cb = 64 * g + 32 * s + 8 * lg;
                f32x4 u0 = *(const LAS f32x4*)(convb + cb), u1 = *(const LAS f32x4*)(convb + cb + 4);
#pragma unroll
                for (int w = 0; w < 4; ++w) { const v4u x = un[s][w];
                    const f32x4 w0 = *(const LAS f32x4*)(convw + w * 512 + cb), w1 = *(const LAS f32x4*)(convw + w * 512 + cb + 4);
                    u0.x += w0.x * bflo(x.x); u0.y += w0.y * bfhi(x.x); u0.z += w0.z * bflo(x.y); u0.w += w0.w * bfhi(x.y);
                    u1.x += w1.x * bflo(x.z); u1.y += w1.y * bfhi(x.z); u1.z += w1.z * bflo(x.w); u1.w += w1.w * bfhi(x.w); }
                *(LAS f32x4*)(stg + c16 * 68 + 32 * s + 8 * lg) = u0; *(LAS f32x4*)(stg + c16 * 68 + 32 * s + 8 * lg + 4) = u1;
                v4u pw; pw.x = pk2(u0.x, u0.y); pw.y = pk2(u0.z, u0.w); pw.z = pk2(u1.x, u1.y); pw.w = pk2(u1.z, u1.w); af[s] = __builtin_bit_cast(bf16x8, pw); }
            if (ss < 3) LRU_LOAD(ss + 1);
            f32x4 acc[2][4];
#pragma unroll
            for (int gate = 0; gate < 2; ++gate)
#pragma unroll
                for (int t = 0; t < 4; ++t) { acc[gate][t] = (f32x4){0.f, 0.f, 0.f, 0.f};
#pragma unroll
                    for (int s = 0; s < 2; ++s) acc[gate][t] = __builtin_amdgcn_mfma_f32_16x16x32_bf16(af[s], wf[gate][t][s], acc[gate][t], 0, 0, 0); }
            float ssq[4] = {0.f, 0.f, 0.f, 0.f};
#pragma unroll
            for (int t = 0; t < 4; ++t) {
                float aj[4], bj[4], l2[4];
#pragma unroll
                for (int r = 0; r < 4; ++r) { const float uu = stg_c[r * 68 + 16 * t];
                    const float rr = __builtin_amdgcn_rcpf(1.0f + __builtin_amdgcn_exp2f(__builtin_fmaf(acc[0][t][r], -LOG2E, nba[t])));
                    const float ig = __builtin_amdgcn_rcpf(1.0f + __builtin_amdgcn_exp2f(__builtin_fmaf(acc[1][t][r], -LOG2E, nbx[t])));
                    l2[r] = rr * c2[t]; aj[r] = __builtin_amdgcn_exp2f(l2[r]);
                    bj[r] = __builtin_amdgcn_sqrtf(__builtin_fmaf(-aj[r], aj[r], 1.0f)) * (ig * uu); }
                if (!FINAL) {
                    const size_t lo = (((((size_t)unit * 8 + g) * 4 + ss) * 4 + t) * 64 + l) * 4;
                    *(GAS v2u*)(LAo + lo) = (v2u){pk2(l2[0], l2[1]), pk2(l2[2], l2[3])}; *(GAS v2u*)(BEo + lo) = (v2u){pk2(bj[0], bj[1]), pk2(bj[2], bj[3])}; }
                float hl[4], cum[4]; hl[0] = bj[0]; cum[0] = aj[0];
#pragma unroll
                for (int r = 1; r < 4; ++r) { hl[r] = aj[r] * hl[r - 1] + bj[r]; cum[r] = cum[r - 1] * aj[r]; }
                float A = cum[3], B = hl[3];
                float pA = __shfl(A, (l + 48) & 63), pB = __shfl(B, (l + 48) & 63);
                if (lg >= 1) { B = A * pB + B; A = A * pA; }
                pA = __shfl(A, (l + 32) & 63); pB = __shfl(B, (l + 32) & 63);
                if (lg >= 2) { B = A * pB + B; A = A * pA; }
                float eA = __shfl(A, (l + 48) & 63), eB = __shfl(B, (l + 48) & 63); if (lg == 0) { eA = 1.0f; eB = 0.0f; }
                const float hin = eA * hc[t] + eB;
                const float tA = __shfl(A, 48 + c16), tB = __shfl(B, 48 + c16);
                hc[t] = tA * hc[t] + tB; At[t] *= tA;
                if (FINAL) {
#pragma unroll
                    for (int r = 0; r < 4; ++r) { const float h = hl[r] + cum[r] * hin; const float gx = bf2f(gst_c[r * 64 + 16 * t]);
                        const float z2 = 1.5957691216057308f * (gx + 0.044715f * gx * gx * gx); const float vv = gx * sigmoidf_fast(z2) * h;
                        vst_c[(16 * ss + r) * 64 + 16 * t] = (bf16)f2bf(vv); ssq[r] += vv * vv; }
                }
            }
            if (FINAL) {
#pragma unroll
                for (int r = 0; r < 4; ++r) { float q = ssq[r]; q += dpp_mov<0xB1>(q); q += dpp_mov<0x4E>(q); q += dpp_mov<0x141>(q); q += dpp_mov<0x140>(q); if (c16 == 0) ssl_w[(16 * ss + r) * 8] = q; }
            }
        }
#undef LRU_LOAD
        if (!FINAL) {
            if (lg == 0) {
#pragma unroll
                for (int t = 0; t < 4; ++t) *(GAS f32x2*)(AGG + ((size_t)(b * 64 + c) * 512 + 64 * g + 16 * t + c16) * 2) = (f32x2){At[t], hc[t]}; }
        } else {
            LDS_WAIT(); __syncthreads();
            f32x4 gq[4];
#pragma unroll
            for (int j = 0; j < 4; ++j) gq[j] = ((const GAS f32x4*)(a.in[11] + layer * 512 + 64 * g + (l & 3) * 16))[j];
#pragma unroll
            for (int ss = 0; ss < 4; ++ss) { const int tl = 16 * ss + (l >> 2);
                const f32x4 s0 = *(const LAS f32x4*)(ssl + tl * 8), s1 = *(const LAS f32x4*)(ssl + tl * 8 + 4);
                const float rs = 1.0f / sqrtf(((s0.x + s0.y) + (s0.z + s0.w) + (s1.x + s1.y) + (s1.z + s1.w)) * (1.0f / DL) + RMS_EPS);
                const v4u y0 = *(const LAS v4u*)(vst + tl * 64 + (l & 3) * 16), y1 = *(const LAS v4u*)(vst + tl * 64 + (l & 3) * 16 + 8);
                v4u o0, o1;
                o0.x = pk2(bflo(y0.x) * rs * gq[0].x, bfhi(y0.x) * rs * gq[0].y); o0.y = pk2(bflo(y0.y) * rs * gq[0].z, bfhi(y0.y) * rs * gq[0].w);
                o0.z = pk2(bflo(y0.z) * rs * gq[1].x, bfhi(y0.z) * rs * gq[1].y); o0.w = pk2(bflo(y0.w) * rs * gq[1].z, bfhi(y0.w) * rs * gq[1].w);
                o1.x = pk2(bflo(y1.x) * rs * gq[2].x, bfhi(y1.x) * rs * gq[2].y); o1.y = pk2(bflo(y1.y) * rs * gq[2].z, bfhi(y1.y) * rs * gq[2].w);
                o1.z = pk2(bflo(y1.z) * rs * gq[3].x, bfhi(y1.z) * rs * gq[3].y); o1.w = pk2(bflo(y1.w) * rs * gq[3].z, bfhi(y1.w) * rs * gq[3].w);
                GAS v4u* dst = (GAS v4u*)(Y + (tok0 + tl) * D + DL + 64 * g + (l & 3) * 16); dst[0] = o0; dst[1] = o1; }
            __syncthreads();
        }
    }
}

__device__ __forceinline__ void lru_final_phase(Frame& F, const int layer, const Args& a, const bf16* Gg, const float* AGG, const bf16* LAi, const bf16* BEi, bf16* Y) {
    LAS unsigned char* lds = F.lds + RING_OFF;
    const int g = F.wave, l = F.lane;
    LAS unsigned char* tile = lds + g * FT_WAVE;
    LAS float* ssl = (LAS float*)(lds + NWAVES * FT_WAVE);
    f32x4 gq[2];
#pragma unroll
    for (int j = 0; j < 2; ++j) gq[j] = ((const GAS f32x4*)(a.in[11] + layer * 512 + 64 * g + (l & 7) * 8))[j];
    __syncthreads();
    for (int u0 = blockIdx.x, it = 0; u0 < NUNIT; u0 += F.G, ++it) {
        const int unit = (it & 1) ? (u0 ^ 63) : u0;
        const int b = unit >> 6, c = unit & 63; const size_t tok0 = (size_t)b * SEQ + 64 * c;
        v4u gr[8];
#pragma unroll
        for (int j = 0; j < 8; ++j) gr[j] = *(const GAS v4u*)(Gg + (tok0 + 8 * j + (l >> 3)) * DL + 64 * g + (l & 7) * 8);
        const GAS v2u* lap = (const GAS v2u*)(LAi + ((((size_t)unit * 8 + g) * 4) * 4 + (l >> 4)) * 256 + (l & 15) * 4); const GAS v2u* bep = (const GAS v2u*)(BEi + ((((size_t)unit * 8 + g) * 4) * 4 + (l >> 4)) * 256 + (l & 15) * 4);
        v2u la8[8], be8[8];
#pragma unroll
        for (int j = 0; j < 8; ++j) { la8[j] = lap[(j >> 2) * 4 * 64 + (j & 3) * 16]; be8[j] = bep[(j >> 2) * 4 * 64 + (j & 3) * 16]; }
        float h = 0.f;
        { const GAS f32x2* ap = (const GAS f32x2*)(AGG + ((size_t)(b * 64) * 512 + 64 * g + l) * 2);
          int cc = 0;
          for (; cc + 16 <= c; cc += 16) { f32x2 ab[16];
#pragma unroll
              for (int j = 0; j < 16; ++j) ab[j] = ap[(size_t)(cc + j) * 512];
#pragma unroll
              for (int j = 0; j < 16; ++j) h = ab[j].x * h + ab[j].y; }
          { f32x2 ab[16];
#pragma unroll
              for (int j = 0; j < 16; ++j) ab[j] = ap[(size_t)((cc + j < c) ? cc + j : 0) * 512];
#pragma unroll
              for (int j = 0; j < 16; ++j) if (cc + j < c) h = ab[j].x * h + ab[j].y; } }
#pragma unroll
        for (int j = 0; j < 8; ++j) *(LAS v4u*)(tile + (8 * j + (l >> 3)) * FT_PITCH + (l & 7) * 16) = gr[j];
        LAS bf16* col = (LAS bf16*)(tile + 2 * l);
#pragma unroll
        for (int half = 0; half < 2; ++half) {
            if (half == 1) {
#pragma unroll
                for (int j = 0; j < 8; ++j) { la8[j] = lap[(2 + (j >> 2)) * 4 * 64 + (j & 3) * 16]; be8[j] = bep[(2 + (j >> 2)) * 4 * 64 + (j & 3) * 16]; } }
#pragma unroll
            for (int j = 0; j < 8; ++j)
#pragma unroll
                for (int e = 0; e < 4; ++e) { const int tt = 32 * half + 4 * j + e; const unsigned lw = la8[j][e >> 1], bw = be8[j][e >> 1];
                    const float l2 = (e & 1) ? bfhi(lw) : bflo(lw), be = (e & 1) ? bfhi(bw) : bflo(bw);
                    h = __builtin_amdgcn_exp2f(l2) * h + be;
                    const float gx = bf2f(col[tt * (FT_PITCH / 2)]);
                    const float z2 = 1.5957691216057308f * (gx + 0.044715f * gx * gx * gx);
                    col[tt * (FT_PITCH / 2)] = (bf16)pk2(gx * sigmoidf_fast(z2) * h, 0.f); }
        }
        { float q = 0.f;
#pragma unroll
          for (int j = 0; j < 8; ++j) { const v4u y = *(const LAS v4u*)(tile + l * FT_PITCH + 16 * j);
#pragma unroll
              for (int e = 0; e < 4; ++e) { const float x0 = bflo(y[e]), x1 = bfhi(y[e]); q += x0 * x0 + x1 * x1; } }
          ssl[l * 8 + g] = q; }
        LDS_WAIT(); __syncthreads();
#pragma unroll
        for (int j = 0; j < 8; ++j) { const int tl = 8 * j + (l >> 3);
            const f32x4 s0 = *(const LAS f32x4*)(ssl + tl * 8), s1 = *(const LAS f32x4*)(ssl + tl * 8 + 4);
            const float rs = 1.0f / sqrtf(((s0.x + s0.y) + (s0.z + s0.w) + (s1.x + s1.y) + (s1.z + s1.w)) * (1.0f / DL) + RMS_EPS);
            const v4u y = *(const LAS v4u*)(tile + tl * FT_PITCH + (l & 7) * 16);
            v4u o; o.x = pk2(bflo(y.x) * rs * gq[0].x, bfhi(y.x) * rs * gq[0].y); o.y = pk2(bflo(y.y) * rs * gq[0].z, bfhi(y.y) * rs * gq[0].w);
            o.z = pk2(bflo(y.z) * rs * gq[1].x, bfhi(y.z) * rs * gq[1].y); o.w = pk2(bflo(y.w) * rs * gq[1].z, bfhi(y.w) * rs * gq[1].w);
            *(GAS v4u*)(Y + (tok0 + tl) * D + DL + 64 * g + (l & 7) * 8) = o; }
        __syncthreads();
    }
}
}

#define PB_BEGIN(k) do { F.lane = fresh_lane(); if (PROBE_MASK && ((PROBE_MASK >> (k)) & 1ull)) F.pt0 = rt(); } while (0)
#define PB_END(k) do { if (PROBE_MASK && ((PROBE_MASK >> (k)) & 1ull)) F.pacc += rt() - F.pt0; } while (0)
#define IN(k) (lo <= (k) && (k) < hi)
#define SEAM(k) do { if (IN(k) && IN((k) + 1)) { if ((PROBE_MASK & (1ull << 37)) && (PROBE_SEAM < 0 || PROBE_SEAM == (k))) { const unsigned long long t_ = rt(); xcd_barrier(bar); F.pacc += rt() - t_; } else xcd_barrier(bar); } } while (0)
template <int layer>
__device__ __forceinline__ void run_layer(Frame& F, const Args& args, const XcdBarrier& bar, const int lo, const int hi) {
    unsigned char* ws = args.ws; bf16* XBp = (bf16*)(ws + WS_XB);
        const int pb = layer ? PH_L1 : PH_L0;
        PB_BEGIN(pb + 0);
        if (IN(pb + 0)) {
            pg8::Gemm g{XBp, (const bf16*)(ws + WS_WIN) + (size_t)layer * DIN * D, M, DIN, D}; pg8::StaticOrder S; S.init(M, DIN, F.G, (int)blockIdx.x);
            pg8::EpiBf16<0> E{(bf16*)(ws + WS_Q), DA, nullptr, DA, (size_t)M * DA, QSCALE};
            pg8::gemm_phase<pg8::EpiBf16<0>, pg8::StaticOrder, true, true>(F.lds + RING_OFF, g, S, E);
        }
        SEAM(pb + 0);
        PB_END(pb + 0);
        PB_BEGIN(pb + 1);
        if (IN(pb + 1)) { PB_BEGIN(27); att::attn_phase(F, (const bf16*)(ws + WS_Q), (const bf16*)(ws + WS_K), (const bf16*)(ws + WS_V), args.in[9], (bf16*)(ws + WS_O0), (bf16*)(ws + WS_O1), (bf16*)(ws + WS_O2), (float*)(ws + WS_LSE)); PB_END(27);
            PB_BEGIN(28); lru::lru_phase<false>(F, layer, args, (const bf16*)(ws + WS_U), (const bf16*)(ws + WS_G), (float*)(ws + WS_AGG), nullptr, (bf16*)(ws + WS_LA), (bf16*)(ws + WS_BE)); PB_END(28); }
        SEAM(pb + 1);
        PB_END(pb + 1);
        PB_BEGIN(pb + 2);
        if (IN(pb + 2)) { PB_BEGIN(29); att::merge_attn_phase(F, (const bf16*)(ws + WS_O0), (const bf16*)(ws + WS_O1), (const bf16*)(ws + WS_O2), (const float*)(ws + WS_LSE), args.in[10] + layer * DA, (bf16*)(ws + WS_Y)); PB_END(29);
            PB_BEGIN(30); lru::lru_final_phase(F, layer, args, (const bf16*)(ws + WS_G), (const float*)(ws + WS_AGG), (const bf16*)(ws + WS_LA), (const bf16*)(ws + WS_BE), (bf16*)(ws + WS_Y)); PB_END(30); }
        SEAM(pb + 2);
        PB_END(pb + 2);
        PB_BEGIN(pb + 3);
        if (IN(pb + 3)) {
            pg8::Gemm g{(const bf16*)(ws + WS_Y), (const bf16*)(ws + WS_WOUT) + (size_t)layer * D * D, M, D, D}; pg8::StaticOrder S; S.init(M, D, F.G, (int)blockIdx.x);
            pg8::EpiResBf16 E{XBp, XBp, D, ALPHA, 1.0f};
            pg8::gemm_phase<pg8::EpiResBf16, pg8::StaticOrder, true, true>(F.lds + RING_OFF, g, S, E);
        }
        SEAM(pb + 3);
        PB_END(pb + 3);
        PB_BEGIN(pb + 4);
        if (IN(pb + 4)) {
            if (layer == 0) phase_ln<false>(F, XBp, args.in[13], args.in[14], nullptr, nullptr, nullptr, ws + WS_X8);
            else phase_ln<true>(F, XBp, args.in[13] + D, args.in[14] + D, args.in[20], (int*)(ws + WS_TOKE), (float*)(ws + WS_TOKP));
        }
        SEAM(pb + 4);
        PB_END(pb + 4);
        if (layer == 0) {
            PB_BEGIN(pb + 5);
            if (IN(pb + 5)) {
                constexpr int CVT_WGS = 64, CVT_ROUNDS = 14;
                const bool split = (F.G == 256);
                pg8::SplitOrder S; S.so.init(M, 2 * DFF, F.G, (int)blockIdx.x); S.ncv = split ? CVT_WGS : 0; S.rskip = split ? CVT_ROUNDS : 0; S.late = split && (int)blockIdx.x >= F.G - CVT_WGS;
                if (S.late || !split) { PB_BEGIN(26);
                    if (split) phase_moe_cvt(F, args, ((int)blockIdx.x - (F.G - CVT_WGS)) * NWAVES + F.wave, CVT_WGS * NWAVES); else phase_moe_cvt(F, args, F.vcu * NWAVES + F.wave, F.G * NWAVES);
                    LDS_WAIT(); __syncthreads(); PB_END(26); }
                pg8::Gemm g{(const bf16*)(ws + WS_X8), (const bf16*)(ws + WS_WGU), M, 2 * DFF, D / 2};
                pg8::EpiSwiGLU8 E{ws + WS_HB, DFF, 1.0f / MOE_WSCALE, MOE_HSCALE};
                pg8::gemm_phase<pg8::EpiSwiGLU8, pg8::SplitOrder, true, true, true>(F.lds + RING_OFF, g, S, E);
            }
            SEAM(pb + 5);
            PB_END(pb + 5);
            PB_BEGIN(pb + 6);
            if (IN(pb + 6)) {
                pg8::Gemm g{(const bf16*)(ws + WS_HB), (const bf16*)(ws + WS_WD), M, D, DFF / 2}; pg8::StaticOrder S; S.init(M, D, F.G, (int)blockIdx.x);
                pg8::EpiResBf16 E{XBp, XBp, D, ALPHA, 1.0f / (MOE_HSCALE * MOE_DSCALE)};
                pg8::gemm_phase<pg8::EpiResBf16, pg8::StaticOrder, true, true, true>(F.lds + RING_OFF, g, S, E);
            }
            SEAM(pb + 6);
            PB_END(pb + 6);
            PB_BEGIN(pb + 7);
            if (IN(pb + 7)) phase_ln<false>(F, XBp, args.in[15], args.in[16], nullptr, nullptr, nullptr);
            SEAM(pb + 7);
            PB_END(pb + 7);
        }
}

__global__ void __launch_bounds__(NWAVES * 64, 2) fwd(Args args) {
    extern __shared__ __attribute__((aligned(16))) unsigned char lds[];
    Frame F;
    F.lds = (LAS unsigned char*)lds;
    F.MISC = (volatile LAS unsigned*)(F.lds + MISC_OFF);
    F.tid = threadIdx.x; F.lane = F.tid & 63; F.wave = __builtin_amdgcn_readfirstlane(F.tid >> 6);
    F.pt0 = 0ull; F.pacc = 0ull;
    F.G = gridDim.x; { const int bx = blockIdx.x; F.vcu = (F.G % 8 == 0) ? (bx % 8) * (F.G / 8) + bx / 8 : bx; }
    unsigned char* ws = args.ws;
    F.ctl = (gu32*)(ws + WS_CTL);
    for (int u = F.tid; u < (LDS_BYTES - LDSCTL_OFF) / 4; u += NWAVES * 64) ((LAS unsigned*)(F.lds + LDSCTL_OFF))[u] = 0u;
    __syncthreads();
    const int lo = args.ph_lo, hi = args.ph_hi;
    const bool use_bar = (hi - lo) > 1;
    XcdBarrier bar; bar.bar = (unsigned*)(F.ctl + CW_BAR) + args.li * XCD_BAR_WORDS; bar.x = 0; bar.st = nullptr;
    if (use_bar) bar = xcd_barrier_post((unsigned*)(F.ctl + CW_BAR) + args.li * XCD_BAR_WORDS, F.MISC + 8);
    float* out = args.out;
    bf16* XBp = (bf16*)(ws + WS_XB);

    PB_BEGIN(PH_PRO);
    if (IN(PH_PRO)) phase_prologue(F, args);
    SEAM(PH_PRO);
    PB_END(PH_PRO);

    run_layer<0>(F, args, bar, lo, hi);
    run_layer<1>(F, args, bar, lo, hi);
    PB_BEGIN(PH_DISPATCH);
    if (IN(PH_DISPATCH)) phase_dispatch(F, (const int*)(ws + WS_TOKE), (int*)(ws + WS_TOKPOS), (int*)(ws + WS_SEG), XBp, ws + WS_XS8);
    SEAM(PH_DISPATCH);
    PB_END(PH_DISPATCH);
    for (int c = 0; c < NCHUNK - 1; ++c) {
        const int pg = PH_MOE0 + 2 * c;
        if (IN(pg) || IN(pg + 1)) {
            pg8::MoeOrder S; S.G = F.G; S.c = (int)blockIdx.x; S.base = c * CHUNK_TILES;
            const GAS int* st = (const GAS int*)(ws + WS_SEG);
#pragma unroll
            for (int k = 0; k < 9; ++k) S.segt[k] = __builtin_amdgcn_readfirstlane(st[k]);
            const int nT = S.segt[8]; S.nrows = nT - S.base; if (S.nrows > CHUNK_TILES) S.nrows = CHUNK_TILES; if (S.nrows < 0) S.nrows = 0;
            unsigned char* HCv = (unsigned char*)out - (size_t)S.base * 256 * DFE;
            S.split_pm = -1; S.adiff = 0;
            PB_BEGIN(pg);
            if (IN(pg)) {
                S.nN = 2 * DFE / 256; S.estride_b = (size_t)2 * DFE * D;
                pg8::Gemm g{(const bf16*)(ws + WS_XS8), (const bf16*)(ws + WS_MGU), SORT_ROWS, 2 * DFE, D / 2};
                pg8::EpiSwiGLU8 E{HCv, DFE, 1.0f / MOE_WSCALE, MOE_HSCALE};
                pg8::gemm_phase<pg8::EpiSwiGLU8, pg8::MoeOrder, true, true, true>(F.lds + RING_OFF, g, S, E);
            }
            SEAM(pg);
            PB_END(pg);
            PB_BEGIN(pg + 1);
            if (IN(pg + 1)) {
                S.nN = D / 256; S.estride_b = (size_t)D * DFE;
                pg8::Gemm g{(const bf16*)HCv, (const bf16*)(ws + WS_MD), SORT_ROWS, D, DFE / 2};
                pg8::EpiBf16S E{(bf16*)(ws + WS_YS), D, 1.0f / (MOE_HSCALE * MOE_DSCALE)};
                pg8::gemm_phase<pg8::EpiBf16S, pg8::MoeOrder, true, true, true>(F.lds + RING_OFF, g, S, E);
            }
            SEAM(pg + 1);
            PB_END(pg + 1);
        }
    }
    {
        constexpr int pg = PH_MOE0 + 2 * (NCHUNK - 1), TAIL_ROW0 = (NCHUNK - 1) * CHUNK_TILES * 256;
        pg8::MoeOrder S; S.G = F.G; S.c = (int)blockIdx.x; S.base = (NCHUNK - 1) * CHUNK_TILES; S.nrows = 0; S.split_pm = -1; S.adiff = 0;
        unsigned char* HCv = ws + WS_HCA - (size_t)S.base * 256 * DFE;
        if (IN(pg) || IN(pg + 1)) {
            const GAS int* st = (const GAS int*)(ws + WS_SEG);
#pragma unroll
            for (int k = 0; k < 9; ++k) S.segt[k] = __builtin_amdgcn_readfirstlane(st[k]);
            S.nrows = S.segt[8] - S.base; if (S.nrows > CHUNK_TILES) S.nrows = CHUNK_TILES; if (S.nrows < 0) S.nrows = 0;
        }
        PB_BEGIN(pg);
        if (IN(pg)) {
            S.nN = 2 * DFE / 256; S.estride_b = (size_t)2 * DFE * D;
            pg8::Gemm g{(const bf16*)(ws + WS_XS8), (const bf16*)(ws + WS_MGU), SORT_ROWS, 2 * DFE, D / 2};
            pg8::EpiSwiGLU8 E{HCv, DFE, 1.0f / MOE_WSCALE, MOE_HSCALE};
            pg8::gemm_phase<pg8::EpiSwiGLU8, pg8::MoeOrder, true, true, true>(F.lds + RING_OFF, g, S, E);
            const int nu = S.nrows * S.nN;
            if ((int)blockIdx.x < nu) {
                if (F.tid == 0) { __builtin_amdgcn_fence(__ATOMIC_RELEASE, "agent"); asm volatile("s_waitcnt vmcnt(0)" ::: "memory"); (void)xb_add((unsigned*)(F.ctl + CW_TAILGU), 1u);
                    unsigned* bw = (unsigned*)(F.ctl + CW_BAR) + args.li * XCD_BAR_WORDS;
                    XB_SPIN(xb_ld((unsigned*)(F.ctl + CW_TAILGU)) < (unsigned)(nu < F.G ? nu : F.G), bw);
                    __builtin_amdgcn_fence(__ATOMIC_ACQUIRE, "agent"); asm volatile("s_waitcnt vmcnt(0)" ::: "memory"); }
                __syncthreads();
            } else phase_combine(F, XBp, out, (const bf16*)(ws + WS_YS), (const int*)(ws + WS_TOKPOS), (const float*)(ws + WS_TOKP), args.in[15] + D, args.in[16] + D, (const bf16*)(ws + WS_PART), 1, TAIL_ROW0,
                                 ((int)blockIdx.x - nu) * NWAVES + F.wave, (F.G - nu) * NWAVES, 0, (int)((long)M * (F.G - nu) * TAIL_HEAD_PCT / (F.G * 100)));
        }
        PB_END(pg);
        PB_BEGIN(pg + 1);
        if (IN(pg + 1)) {
            {
                pg8::MoeSplitK S2; S2.base = S.base; S2.nrows = S.nrows; S2.nN = D / 256; S2.nS = TAIL_NS; S2.KS = TAIL_KS / 2; S2.G = F.G; S2.c = (int)blockIdx.x; S2.estride_b = (size_t)D * DFE;
#pragma unroll
                for (int k2 = 0; k2 < 9; ++k2) S2.segt[k2] = S.segt[k2];
                pg8::Gemm g{(const bf16*)HCv, (const bf16*)(ws + WS_MD), SORT_ROWS, D, TAIL_KS / 2, DFE / 2};
                pg8::EpiPart E{(bf16*)(ws + WS_PART), D, S.base, TAIL_TILES, 1.0f / (MOE_HSCALE * MOE_DSCALE)};
                pg8::gemm_phase<pg8::EpiPart, pg8::MoeSplitK, true, true, true>(F.lds + RING_OFF, g, S2, E);
            }
            const int n_tail_units = S.nrows * (D / 256) * TAIL_NS;
            if ((int)blockIdx.x < n_tail_units && F.tid == 0) {
                __builtin_amdgcn_fence(__ATOMIC_RELEASE, "agent"); asm volatile("s_waitcnt vmcnt(0)" ::: "memory");
                (void)xb_add((unsigned*)(F.ctl + CW_TAILCNT), 1u);
            }
            phase_combine(F, XBp, out, (const bf16*)(ws + WS_YS), (const int*)(ws + WS_TOKPOS), (const float*)(ws + WS_TOKP), args.in[15] + D, args.in[16] + D, (const bf16*)(ws + WS_PART), 1, TAIL_ROW0, F.vcu * NWAVES + F.wave, F.G * NWAVES,
                          (int)((long)M * (F.G - S.nrows * (2 * DFE / 256)) * TAIL_HEAD_PCT / (F.G * 100)), M);
            if (n_tail_units > 0) {
                if (F.tid == 0) { unsigned* bw = (unsigned*)(F.ctl + CW_BAR) + args.li * XCD_BAR_WORDS;
                    XB_SPIN(xb_ld((unsigned*)(F.ctl + CW_TAILCNT)) < (unsigned)(n_tail_units < F.G ? n_tail_units : F.G), bw);
                    __builtin_amdgcn_fence(__ATOMIC_ACQUIRE, "agent"); asm volatile("s_waitcnt vmcnt(0)" ::: "memory"); }
                __syncthreads();
                phase_combine(F, XBp, out, (const bf16*)(ws + WS_YS), (const int*)(ws + WS_TOKPOS), (const float*)(ws + WS_TOKP), args.in[15] + D, args.in[16] + D, (const bf16*)(ws + WS_PART), 2, TAIL_ROW0, F.vcu * NWAVES + F.wave, F.G * NWAVES);
            }
        }
        PB_END(pg + 1);
        if (PROBE_MASK && blockIdx.x == gridDim.x - 1 && F.tid == 0) { const unsigned long long te = rt() + (unsigned long long)PROBE_K * F.pacc; while (rt() < te) __builtin_amdgcn_s_sleep(8); }
    }
#undef IN
#undef SEAM
}

extern "C" void kernel_launch(void* const* d_in, const int* in_sizes, int n_in, void* d_out, int out_size, void* d_ws, size_t ws_size, hipStream_t stream) {
    static int grid = 0;
    if (grid == 0) {
        if (n_in != 24 || in_sizes[0] != M * D || out_size != M * D || ws_size < WS_END) { fprintf(stderr, "kernel_launch: unexpected problem (n_in %d, out %d, ws %zu < %zu)\n", n_in, out_size, ws_size, (size_t)WS_END); grid = -1; return; }
        int dev = 0, cus = 0, per_cu = 0;
        if (hipGetDevice(&dev) != hipSuccess || hipDeviceGetAttribute(&cus, hipDeviceAttributeMultiprocessorCount, dev) != hipSuccess) { grid = -1; return; }
        if (hipFuncSetAttribute((const void*)fwd, hipFuncAttributeMaxDynamicSharedMemorySize, LDS_BYTES) != hipSuccess) { fprintf(stderr, "kernel_launch: hipFuncSetAttribute failed\n"); grid = -1; return; }
        if (hipOccupancyMaxActiveBlocksPerMultiprocessor(&per_cu, (const void*)fwd, NWAVES * 64, LDS_BYTES) != hipSuccess || per_cu < 1) fprintf(stderr, "kernel_launch: occupancy query says %d\n", per_cu);
        (void)hipGetLastError();
        grid = cus;
    }
    if (grid < 0) return;
    (void)hipMemsetAsync((char*)d_ws + WS_CTL, 0, CTL_ZERO_BYTES, stream);
    Args a{};
    for (int i = 0; i < 24; ++i) a.in[i] = (const float*)d_in[i];
    a.out = (float*)d_out; a.ws = (unsigned char*)d_ws;
    int li = 0;
    auto launch = [&](int lo, int hi) { a.ph_lo = lo; a.ph_hi = hi; a.li = li++; hipLaunchKernelGGL(fwd, dim3(grid), dim3(NWAVES * 64), LDS_BYTES, stream, a); };
    auto each = [&](int lo, int hi) { for (int p = lo; p < hi; ++p) launch(p, p + 1); };
#if defined(MK_PER_PHASE)
    each(PH_PRO, NPH);
#else
    launch(PH_PRO, NPH);
#endif
}
```
